# Optimizing an MI355X kernel written in HIP

```python
import math
import jax, jax.numpy as jnp
from jax import lax
import numpy as np

D_MODEL = 2048
BATCH = 4
SEQ = 8192
DEPTH = 4
DEC_BATCH = 1
DEC_SEQ = 16384
PAST_LEN = 128

N_MIXERS = 3
GRID_W = 64
EPS = 1e-6
POOL_WINDOWS = (2, 4, 8, 16)
N_POOL_GROUPS = len(POOL_WINDOWS)
POOL_GROUP = D_MODEL // N_POOL_GROUPS
HYENA_ORDER = 2
HYENA_EMB = 33
HYENA_BANDS = (HYENA_EMB - 1) // 2
HYENA_HIDDEN = 64
HYENA_FAST_DECAY = 0.3
HYENA_SLOW_DECAY = 1.5
HYENA_TARGET = 1e-2
HYENA_MOD_SHIFT = 0.05
HYENA_MIN_DECAY = math.log(HYENA_TARGET) / HYENA_SLOW_DECAY
HYENA_MAX_DECAY = math.log(HYENA_TARGET) / HYENA_FAST_DECAY
HEAD_DIM = 128
N_HEADS = D_MODEL // HEAD_DIM
N_KV_HEADS = N_HEADS // 4
GQA_GROUP = N_HEADS // N_KV_HEADS
ROPE_AXIS_DIM = HEAD_DIM // 2
ROPE_THETA = 10000.0
Q_BLOCK = 128
D_FF = 5632
N_LAYERS_POOL = (DEPTH + 2) // 3
N_LAYERS_HYENA = (DEPTH + 1) // 3
N_LAYERS_ATTN = DEPTH // 3

kernel_name = 'hybrid_pool_hyena_axialgqa_encoder'


def rms_norm(x, g):
    xf = x.astype(jnp.float32)
    y = xf * lax.rsqrt(jnp.mean(xf * xf, axis=-1, keepdims=True) + EPS)
    return (y * g.astype(jnp.float32)).astype(x.dtype)


def dwconv3(u, w, b):
    up = jnp.pad(u, ((0, 0), (1, 1), (0, 0)))
    return up[:, :-2] * w[0] + up[:, 1:-1] * w[1] + up[:, 2:] * w[2] + b


def pool_mixer(h, w, scale):
    B, L, D = h.shape
    hg = h.reshape(B, L, N_POOL_GROUPS, POOL_GROUP).astype(jnp.float32)
    t = jnp.arange(L)
    zeros = jnp.zeros((B, 1, POOL_GROUP), jnp.float32)
    outs = []
    for g, win in enumerate(POOL_WINDOWS):
        half = win // 2
        lo = jnp.clip(t - half, 0, L - 1)
        hi = jnp.clip(t + win - half - 1, 0, L - 1)
        xg = hg[:, :, g]
        cs = jnp.concatenate([zeros, jnp.cumsum(xg, axis=1)], axis=1)
        s = jnp.take(cs, hi + 1, axis=1) - jnp.take(cs, lo, axis=1)
        cnt = (hi - lo + 1).astype(jnp.float32)[None, :, None]
        outs.append(s / cnt - xg)
    p = jnp.stack(outs, axis=2)
    y = jnp.einsum('blgc,gcd->blgd', p, w.astype(jnp.float32))
    return (y.reshape(B, L, D) * scale).astype(h.dtype)


def hyena_pos_features(L):
    t = jnp.linspace(0.0, 1.0, L, dtype=jnp.float32)[:, None]
    w = 2.0 * math.pi * jnp.arange(L, dtype=jnp.float32)[:, None] / L
    f = jnp.linspace(1e-4, HYENA_BANDS - 1, HYENA_BANDS, dtype=jnp.float32)[None, :]
    z = jnp.concatenate([t, jnp.cos(f * w), -jnp.sin(f * w)], axis=-1)
    deltas = jnp.abs(jnp.linspace(HYENA_MIN_DECAY, HYENA_MAX_DECAY, D_MODEL, dtype=jnp.float32))
    decay = jnp.exp(-t * deltas[None, :]) + HYENA_MOD_SHIFT
    return z, decay


def hyena_mixer(h, z, decay, w_in, b_in, conv_w, conv_b, f_w1, f_b1, f_w2, f_b2, f_w3, f_freq, skip, w_out):
    B, L, D = h.shape
    u = dwconv3(h @ w_in + b_in, conv_w, conv_b)
    v, x1, x2 = jnp.split(u.astype(jnp.float32), 3, axis=-1)
    a = jnp.sin(f_freq * (z @ f_w1 + f_b1))
    a = jnp.sin(f_freq * (a @ f_w2 + f_b2))
    filt = (a @ f_w3).reshape(L, HYENA_ORDER, 2, D) * decay[:, None, None, :]
    n = 2 * L
    zz = v
    for o, gate in enumerate((x1, x2)):
        k = jnp.concatenate([filt[:, o, 0], jnp.zeros((1, D), jnp.float32), filt[:0:-1, o, 1]], axis=0)
        kf = jnp.fft.rfft(k.astype(jnp.float32), n=n, axis=0)
        zf = jnp.fft.rfft(zz, n=n, axis=1)
        conv = jnp.fft.irfft(zf * kf[None], n=n, axis=1)[:, :L]
        zz = gate * (conv + zz * skip[o])
    return zz.astype(h.dtype) @ w_out


def axial_rope_tables(L):
    rows = L // GRID_W
    row = jnp.repeat(jnp.arange(rows, dtype=jnp.float32), GRID_W)
    col = jnp.tile(jnp.arange(GRID_W, dtype=jnp.float32), rows)
    inv = ROPE_THETA ** (-jnp.arange(0, ROPE_AXIS_DIM, 2, dtype=jnp.float32) / ROPE_AXIS_DIM)
    ang = jnp.stack([row[:, None] * inv, col[:, None] * inv], axis=1)
    return jnp.cos(ang), jnp.sin(ang)


def apply_rope(x, cos, sin):
    B, L, H, _ = x.shape
    xr = x.astype(jnp.float32).reshape(B, L, H, 2, 2, ROPE_AXIS_DIM // 2)
    x1 = xr[..., 0, :]
    x2 = xr[..., 1, :]
    c = cos[None, :, None]
    s = sin[None, :, None]
    out = jnp.stack([x1 * c - x2 * s, x2 * c + x1 * s], axis=-2)
    return out.reshape(B, L, H, HEAD_DIM).astype(x.dtype)


def attention_mixer(h, cos, sin, w_qkv, q_gain, k_gain, w_o):
    B, L, D = h.shape
    qkv = h @ w_qkv
    q, k, v = jnp.split(qkv, [N_HEADS * HEAD_DIM, (N_HEADS + N_KV_HEADS) * HEAD_DIM], axis=-1)
    q = apply_rope(rms_norm(q.reshape(B, L, N_HEADS, HEAD_DIM), q_gain), cos, sin)
    k = apply_rope(rms_norm(k.reshape(B, L, N_KV_HEADS, HEAD_DIM), k_gain), cos, sin)
    v = v.reshape(B, L, N_KV_HEADS, HEAD_DIM)
    nb = L // Q_BLOCK
    qb = q.reshape(B, nb, Q_BLOCK, N_KV_HEADS, GQA_GROUP, HEAD_DIM).transpose(1, 0, 3, 4, 2, 5)
    kt = k.transpose(0, 2, 1, 3)
    vt = v.transpose(0, 2, 1, 3)
    scale = HEAD_DIM ** -0.5

    def block(qblk):
        s = jnp.einsum('bkgqd,bksd->bkgqs', qblk, kt).astype(jnp.float32) * scale
        p = jax.nn.softmax(s, axis=-1)
        return jnp.einsum('bkgqs,bksd->bkgqd', p.astype(vt.dtype), vt)

    o = lax.map(block, qb)
    o = o.transpose(1, 0, 4, 2, 3, 5).reshape(B, L, D)
    return o @ w_o


def conv_glu(h, w_up, conv_w, conv_b, w_down):
    a, b = jnp.split(h @ w_up, 2, axis=-1)
    a = dwconv3(a, conv_w, conv_b)
    return (jax.nn.gelu(a, approximate=True) * b) @ w_down


def encoder_trunk(x, c, mod_w, mod_b, norm_mix_pre, norm_mix_post, norm_ffn_pre, norm_ffn_post,
                  ffn_w_up, ffn_conv_w, ffn_conv_b, ffn_w_down, pool_w, pool_scale,
                  hy_w_in, hy_b_in, hy_conv_w, hy_conv_b, hy_f_w1, hy_f_b1, hy_f_w2, hy_f_b2,
                  hy_f_w3, hy_f_freq, hy_skip, hy_w_out, at_w_qkv, at_q_gain, at_k_gain, at_w_o):
    L = x.shape[1]
    z, decay = hyena_pos_features(L)
    cos, sin = axial_rope_tables(L)
    cact = jax.nn.silu(c.astype(jnp.float32))
    for i in range(DEPTH):
        mod = (cact @ mod_w[i] + mod_b[i])[:, None, :]
        sh1, sc1, g1, sh2, sc2, g2 = jnp.split(mod, 6, axis=-1)
        h = (rms_norm(x, norm_mix_pre[i]) * (1.0 + sc1) + sh1).astype(x.dtype)
        kind, j = i % N_MIXERS, i // N_MIXERS
        if kind == 0:
            m = pool_mixer(h, pool_w[j], pool_scale[j])
        elif kind == 1:
            m = hyena_mixer(h, z, decay, hy_w_in[j], hy_b_in[j], hy_conv_w[j], hy_conv_b[j],
                            hy_f_w1[j], hy_f_b1[j], hy_f_w2[j], hy_f_b2[j], hy_f_w3[j], hy_f_freq[j],
                            hy_skip[j], hy_w_out[j])
        else:
            m = attention_mixer(h, cos, sin, at_w_qkv[j], at_q_gain[j], at_k_gain[j], at_w_o[j])
        x = x + (g1 * rms_norm(m, norm_mix_post[i])).astype(x.dtype)
        h = (rms_norm(x, norm_ffn_pre[i]) * (1.0 + sc2) + sh2).astype(x.dtype)
        f = conv_glu(h, ffn_w_up[i], ffn_conv_w[i], ffn_conv_b[i], ffn_w_down[i])
        x = x + (g2 * rms_norm(f, norm_ffn_post[i])).astype(x.dtype)
    return x


def setup_inputs(seed: int = 0) -> dict:
    key = jax.random.key(seed)
    ks = iter(jax.random.split(key, 40))
    D = D_MODEL

    def nrm(shape, scale):
        return jax.random.normal(next(ks), shape, jnp.float32) * scale

    def gain(shape, s=0.05):
        return 1.0 + nrm(shape, s)

    qkv_out = (N_HEADS + 2 * N_KV_HEADS) * HEAD_DIM
    return {
        'x_prompt': nrm((BATCH, SEQ, D), 1.0),
        'x_sample': nrm((DEC_BATCH, DEC_SEQ, D), 1.0),
        'c_prompt': nrm((BATCH, D), 1.0),
        'c_sample': nrm((DEC_BATCH, D), 1.0),
        'mod_w': nrm((DEPTH, D, 6 * D), 0.5 * D ** -0.5),
        'mod_b': nrm((DEPTH, 6 * D), 0.02),
        'norm_mix_pre': gain((DEPTH, D)),
        'norm_mix_post': gain((DEPTH, D)),
        'norm_ffn_pre': gain((DEPTH, D)),
        'norm_ffn_post': gain((DEPTH, D)),
        'ffn_w_up': nrm((DEPTH, D, 2 * D_FF), D ** -0.5),
        'ffn_conv_w': nrm((DEPTH, 3, D_FF), 3 ** -0.5),
        'ffn_conv_b': nrm((DEPTH, D_FF), 0.02),
        'ffn_w_down': nrm((DEPTH, D_FF, D), D_FF ** -0.5),
        'pool_w': nrm((N_LAYERS_POOL, N_POOL_GROUPS, POOL_GROUP, POOL_GROUP), POOL_GROUP ** -0.5),
        'pool_scale': gain((N_LAYERS_POOL, D), 0.1),
        'hy_w_in': nrm((N_LAYERS_HYENA, D, 3 * D), D ** -0.5),
        'hy_b_in': nrm((N_LAYERS_HYENA, 3 * D), 0.02),
        'hy_conv_w': nrm((N_LAYERS_HYENA, 3, 3 * D), 3 ** -0.5),
        'hy_conv_b': nrm((N_LAYERS_HYENA, 3 * D), 0.02),
        'hy_f_w1': nrm((N_LAYERS_HYENA, HYENA_EMB, HYENA_HIDDEN), HYENA_EMB ** -0.5),
        'hy_f_b1': nrm((N_LAYERS_HYENA, HYENA_HIDDEN), 0.1),
        'hy_f_w2': nrm((N_LAYERS_HYENA, HYENA_HIDDEN, HYENA_HIDDEN), HYENA_HIDDEN ** -0.5),
        'hy_f_b2': nrm((N_LAYERS_HYENA, HYENA_HIDDEN), 0.1),
        'hy_f_w3': nrm((N_LAYERS_HYENA, HYENA_HIDDEN, HYENA_ORDER * 2 * D), HYENA_HIDDEN ** -0.5),
        'hy_f_freq': gain((N_LAYERS_HYENA, HYENA_HIDDEN)),
        'hy_skip': nrm((N_LAYERS_HYENA, HYENA_ORDER, D), 0.5),
        'hy_w_out': nrm((N_LAYERS_HYENA, D, D), D ** -0.5),
        'at_w_qkv': nrm((N_LAYERS_ATTN, D, qkv_out), D ** -0.5),
        'at_q_gain': gain((N_LAYERS_ATTN, HEAD_DIM)),
        'at_k_gain': gain((N_LAYERS_ATTN, HEAD_DIM)),
        'at_w_o': nrm((N_LAYERS_ATTN, D, D), D ** -0.5),
    }


def reference(x_prompt, x_sample, c_prompt, c_sample, mod_w, mod_b, norm_mix_pre, norm_mix_post,
              norm_ffn_pre, norm_ffn_post, ffn_w_up, ffn_conv_w, ffn_conv_b, ffn_w_down,
              pool_w, pool_scale, hy_w_in, hy_b_in, hy_conv_w, hy_conv_b, hy_f_w1, hy_f_b1,
              hy_f_w2, hy_f_b2, hy_f_w3, hy_f_freq, hy_skip, hy_w_out,
              at_w_qkv, at_q_gain, at_k_gain, at_w_o):
    y_prompt = encoder_trunk(x_prompt, c_prompt, mod_w, mod_b, norm_mix_pre, norm_mix_post,
                             norm_ffn_pre, norm_ffn_post, ffn_w_up, ffn_conv_w, ffn_conv_b, ffn_w_down,
                             pool_w, pool_scale, hy_w_in, hy_b_in, hy_conv_w, hy_conv_b, hy_f_w1, hy_f_b1,
                             hy_f_w2, hy_f_b2, hy_f_w3, hy_f_freq, hy_skip, hy_w_out,
                             at_w_qkv, at_q_gain, at_k_gain, at_w_o)
    y_sample = encoder_trunk(x_sample, c_sample, mod_w, mod_b, norm_mix_pre, norm_mix_post,
                             norm_ffn_pre, norm_ffn_post, ffn_w_up, ffn_conv_w, ffn_conv_b, ffn_w_down,
                             pool_w, pool_scale, hy_w_in, hy_b_in, hy_conv_w, hy_conv_b, hy_f_w1, hy_f_b1,
                             hy_f_w2, hy_f_b2, hy_f_w3, hy_f_freq, hy_skip, hy_w_out,
                             at_w_qkv, at_q_gain, at_k_gain, at_w_o)
    return (y_prompt, y_sample)
```

```cpp
#include <hip/hip_runtime.h>
#include <cstdio>
#include <cstdint>

#define LAS __attribute__((address_space(3)))
#define GAS __attribute__((address_space(1)))
typedef unsigned short bf16_t;
typedef short bf16x8 __attribute__((ext_vector_type(8)));
typedef short s16x4 __attribute__((ext_vector_type(4)));
typedef float f32x2 __attribute__((ext_vector_type(2)));
typedef float f32x4 __attribute__((ext_vector_type(4)));
typedef float f32x16 __attribute__((ext_vector_type(16)));
typedef unsigned u32x2 __attribute__((ext_vector_type(2)));
typedef unsigned u32x4 __attribute__((ext_vector_type(4)));

constexpr int D = 2048, T = 49152, DFF = 5632, NLAYER = 4, NB = 5;
constexpr int LP = 8192, LS = 16384, TP = 32768;
constexpr float EPS = 1e-6f;
__device__ __forceinline__ int seq_of_row(int r) { return r < TP ? (r >> 13) : 4; }
__device__ __forceinline__ int seq_start(int s) { return s << 13; }
__device__ __forceinline__ int seq_len(int s) { return s < 4 ? LP : LS; }

__device__ __forceinline__ unsigned cvt_pk_bf16(float lo, float hi) { unsigned r; asm volatile("v_cvt_pk_bf16_f32 %0, %1, %2" : "=v"(r) : "v"(lo), "v"(hi)); return r; }
__device__ __forceinline__ float bf_lo(unsigned w) { return __uint_as_float(w << 16); }
__device__ __forceinline__ float bf_hi(unsigned w) { return __uint_as_float(w & 0xffff0000u); }
__device__ __forceinline__ float bf1(bf16_t h) { return __uint_as_float(((unsigned)h) << 16); }
__device__ __forceinline__ bf16_t f2bf(float f) { return (bf16_t)(cvt_pk_bf16(f, 0.f) & 0xffffu); }
__device__ __forceinline__ float wave_sum(float v) {
#pragma unroll
    for (int o = 1; o < 64; o <<= 1) v += __shfl_xor(v, o);
    return v;
}

namespace pg8 {
constexpr int BM = 256, BK = 64, HALF = 128, HTB = HALF * BK * 2, STAGE_BYTES = 8 * HTB, NXCD = 8, WGM = 8;
__host__ __device__ __forceinline__ int lds_byte(int r, int c) { const int st = (r >> 4) * 2 + (c >> 5), rr = r & 15, cc = c & 31, ob = rr * 64 + cc * 2; return st * 1024 + (ob ^ (((ob >> 9) & 1) << 5)); }
__host__ __device__ __forceinline__ void stage_rc(int b, int& R, int& C) { const int st = b / 1024, sb = b % 1024, swz = sb ^ (((sb >> 9) & 1) << 5); R = (st >> 1) * 16 + swz / 64; C = (st & 1) * 32 + (swz % 64) / 2; }
__host__ __device__ __forceinline__ int perm32(int rho) { const int n = rho >> 4, i = rho & 15; return 8 * (i >> 2) + 4 * n + (i & 3); }

struct Unit { int pm, pn; };
struct Gemm { const bf16_t* A; const bf16_t* Bt; int lda, ldb, K, agrp; };

struct StaticOrder {
    int nM, nN, nwg, G, c;
    __device__ void init(int M, int N, int G_, int c_) { nM = M / BM; nN = N / BM; nwg = nM * nN; G = G_; c = c_; }
    __device__ bool next(int i, Unit& u) const {
        const long L = (long)i * G + c; if (L >= nwg) return false;
        int wgid = (int)L; { const int q = nwg / NXCD, r = nwg % NXCD, xcd = wgid % NXCD, off = wgid / NXCD; wgid = (xcd < r ? xcd * (q + 1) : r * (q + 1) + (xcd - r) * q) + off; }
        const int nig = WGM * nN, gid = wgid / nig, fm = gid * WGM, gsz = (nM - fm) < WGM ? (nM - fm) : WGM;
        u.pm = fm + ((wgid % nig) % gsz); u.pn = (wgid % nig) / gsz; return true;
    }
};

struct EpiBf16 {
    static constexpr int NVM = 16;
    bf16_t* O; int ldc; const float* bias; const float* scale;
    __device__ __forceinline__ void prefetch(LAS unsigned char*, const Unit&, int, int) const {}
    __device__ __forceinline__ void operator()(const f32x4 (&acc)[2][2][4][2], const Unit& u, int wr, int wc, int fr, int fq, const LAS unsigned char*) const {
        asm volatile("" ::: "memory");
        const int row0 = u.pm * BM + wr * 64 + fr, col0 = u.pn * BM + wc * 32 + 8 * fq;
        f32x4 bv[2][2], sv[2][2];
#pragma unroll
        for (int bj = 0; bj < 2; ++bj)
#pragma unroll
            for (int n = 0; n < 2; ++n) {
                bv[bj][n] = bias ? *(const f32x4*)(bias + col0 + bj * HALF + 4 * n) : (f32x4){0.f, 0.f, 0.f, 0.f};
                sv[bj][n] = scale ? *(const f32x4*)(scale + col0 + bj * HALF + 4 * n) : (f32x4){1.f, 1.f, 1.f, 1.f}; }
#pragma unroll
        for (int ai = 0; ai < 2; ++ai)
#pragma unroll
            for (int m = 0; m < 4; ++m) { bf16_t* rowp = O + (size_t)(row0 + ai * HALF + m * 16) * ldc + col0;
#pragma unroll
                for (int bj = 0; bj < 2; ++bj) { f32x4 v0 = acc[ai][bj][m][0], v1 = acc[ai][bj][m][1];
                    if (bias) { v0 += bv[bj][0]; v1 += bv[bj][1]; }
                    if (scale) { v0 *= sv[bj][0]; v1 *= sv[bj][1]; }
                    u32x4 w; w.x = cvt_pk_bf16(v0[0], v0[1]); w.y = cvt_pk_bf16(v0[2], v0[3]); w.z = cvt_pk_bf16(v1[0], v1[1]); w.w = cvt_pk_bf16(v1[2], v1[3]);
                    *(u32x4*)(rowp + bj * HALF) = w; } }
    }
};

__device__ __forceinline__ float gelu_tanh_f(float x) {
    const float arg = x * __builtin_fmaf(x * x, -0.10294323970f, -2.30220819814f);
    return x * __builtin_amdgcn_rcpf(1.0f + __builtin_amdgcn_exp2f(arg));
}
__device__ __forceinline__ f32x2 gelu_tanh_2(f32x2 x) {
    const f32x2 arg = x * __builtin_elementwise_fma(x * x, (f32x2){-0.10294323970f, -0.10294323970f}, (f32x2){-2.30220819814f, -2.30220819814f});
    const f32x2 d = (f32x2){__builtin_amdgcn_exp2f(arg.x), __builtin_amdgcn_exp2f(arg.y)} + (f32x2){1.0f, 1.0f};
    return x * (f32x2){__builtin_amdgcn_rcpf(d.x), __builtin_amdgcn_rcpf(d.y)};
}
__device__ __forceinline__ float dpp_shr1(float v) { return __int_as_float(__builtin_amdgcn_update_dpp(0, __float_as_int(v), 0x111, 0xf, 0xf, false)); }
__device__ __forceinline__ float dpp_shl1(float v) { return __int_as_float(__builtin_amdgcn_update_dpp(0, __float_as_int(v), 0x101, 0xf, 0xf, false)); }
__device__ __forceinline__ u32x4 pack8(const f32x4 a, const f32x4 b) { u32x4 w; w.x = cvt_pk_bf16(a[0], a[1]); w.y = cvt_pk_bf16(a[2], a[3]); w.z = cvt_pk_bf16(b[0], b[1]); w.w = cvt_pk_bf16(b[2], b[3]); return w; }
struct EpiGlu {
    static constexpr int NVM = 2 + 8 + 6;
    bf16_t* U; bf16_t* EA; bf16_t* EB; const float* cw; const float* cb; int dff;
    __device__ __forceinline__ void prefetch(LAS unsigned char* wslot, const Unit& u, int wc, int lane) const {
        const int chw = u.pn * HALF + wc * 32 + (lane & 31);
        const float* g0 = (lane < 32) ? cw + chw : cw + dff + chw;
        const float* g1 = (lane < 32) ? cw + 2 * dff + chw : cb + chw;
        __builtin_amdgcn_global_load_lds((const unsigned*)g0, (LAS unsigned*)wslot, 4, 0, 0);
        __builtin_amdgcn_global_load_lds((const unsigned*)g1, (LAS unsigned*)(wslot + 256), 4, 0, 0);
    }
    __device__ __forceinline__ void operator()(const f32x4 (&acc)[2][2][4][2], const Unit& u, int wr, int wc, int fr, int fq, const LAS unsigned char* wslot) const {
        asm volatile("" ::: "memory");
        const int ch0 = u.pn * HALF + wc * 32 + 8 * fq;
        f32x4 w0[2], w1[2], w2[2], bb[2], pv[2], nx[2];
        const LAS float* wsl = (const LAS float*)wslot + 8 * fq;
#pragma unroll
        for (int n = 0; n < 2; ++n) { w0[n] = *(const LAS f32x4*)(wsl + 4 * n); w1[n] = *(const LAS f32x4*)(wsl + 32 + 4 * n); w2[n] = *(const LAS f32x4*)(wsl + 64 + 4 * n); bb[n] = *(const LAS f32x4*)(wsl + 96 + 4 * n);
#pragma unroll
            for (int j = 0; j < 4; ++j) { pv[n][j] = dpp_shr1(acc[1][0][3][n][j]); nx[n][j] = dpp_shl1(acc[0][0][0][n][j]); } }
        const size_t tok0 = (size_t)u.pm * BM + 128 * wr + 8 * fr;
#pragma unroll
        for (int k = 0; k < 8; ++k) {
            f32x4 o[2];
            {
                f32x2 y[4], yg[4], tt[4], dd[4], rr[4];
#pragma unroll
                for (int q = 0; q < 4; ++q) { const int n = q >> 1;
                    const f32x4 ap4 = (k == 0) ? pv[n] : acc[(k - 1) >> 2][0][(k - 1) & 3][n], ac4 = acc[k >> 2][0][k & 3][n], an4 = (k == 7) ? nx[n] : acc[(k + 1) >> 2][0][(k + 1) & 3][n], gt4 = acc[k >> 2][1][k & 3][n];
                    const f32x2 ap = (q & 1) ? ap4.hi : ap4.lo, ac = (q & 1) ? ac4.hi : ac4.lo, an = (q & 1) ? an4.hi : an4.lo, gt = (q & 1) ? gt4.hi : gt4.lo;
                    const f32x2 c0 = (q & 1) ? w0[n].hi : w0[n].lo, c1 = (q & 1) ? w1[n].hi : w1[n].lo, c2 = (q & 1) ? w2[n].hi : w2[n].lo, cb2 = (q & 1) ? bb[n].hi : bb[n].lo;
                    y[q] = __builtin_elementwise_fma(c2, an, __builtin_elementwise_fma(c1, ac, __builtin_elementwise_fma(c0, ap, cb2)));
                    yg[q] = y[q] * gt; }
#pragma unroll
                for (int q = 0; q < 4; ++q) tt[q] = y[q] * y[q];
#pragma unroll
                for (int q = 0; q < 4; ++q) tt[q] = __builtin_elementwise_fma(tt[q], (f32x2){-0.10294323970f, -0.10294323970f}, (f32x2){-2.30220819814f, -2.30220819814f});
#pragma unroll
                for (int q = 0; q < 4; ++q) tt[q] = y[q] * tt[q];
#pragma unroll
                for (int q = 0; q < 4; ++q) dd[q] = (f32x2){__builtin_amdgcn_exp2f(tt[q].x), __builtin_amdgcn_exp2f(tt[q].y)};
#pragma unroll
                for (int q = 0; q < 4; ++q) dd[q] = dd[q] + (f32x2){1.0f, 1.0f};
#pragma unroll
                for (int q = 0; q < 4; ++q) rr[q] = (f32x2){__builtin_amdgcn_rcpf(dd[q].x), __builtin_amdgcn_rcpf(dd[q].y)};
#pragma unroll
                for (int q = 0; q < 4; ++q) rr[q] = yg[q] * rr[q];
                o[0] = (f32x4){rr[0].x, rr[0].y, rr[1].x, rr[1].y}; o[1] = (f32x4){rr[2].x, rr[2].y, rr[3].x, rr[3].y};
            }
            const bool edge = (k == 0 && fr == 0) || (k == 7 && fr == 15);
            if (!edge) *(u32x4*)(U + (tok0 + k) * dff + ch0) = pack8(o[0], o[1]);
        }
        const size_t hb = (size_t)u.pm * 2 + wr;
        if (fr == 0) { *(u32x4*)(EA + (hb * 4 + 0) * dff + ch0) = pack8(acc[0][0][0][0], acc[0][0][0][1]); *(u32x4*)(EA + (hb * 4 + 1) * dff + ch0) = pack8(acc[0][0][1][0], acc[0][0][1][1]);
                       *(u32x4*)(EB + (hb * 2 + 0) * dff + ch0) = pack8(acc[0][1][0][0], acc[0][1][0][1]); }
        if (fr == 15) { *(u32x4*)(EA + (hb * 4 + 2) * dff + ch0) = pack8(acc[1][0][2][0], acc[1][0][2][1]); *(u32x4*)(EA + (hb * 4 + 3) * dff + ch0) = pack8(acc[1][0][3][0], acc[1][0][3][1]);
                        *(u32x4*)(EB + (hb * 2 + 1) * dff + ch0) = pack8(acc[1][1][3][0], acc[1][1][3][1]); }
    }
};

struct EpiHyT {
    static constexpr int NVM = 5 + 16 + 8;
    bf16_t* UT; bf16_t* EU; const float* bin; const float* cw; const float* cb; int ncol;
    __device__ __forceinline__ void prefetch(LAS unsigned char* wslot, const Unit& u, int wc, int lane) const {
        const int c = u.pn * BM + (lane >> 5) * HALF + wc * 32 + (lane & 31);
        __builtin_amdgcn_global_load_lds((const unsigned*)(bin + c), (LAS unsigned*)wslot, 4, 0, 0);
        __builtin_amdgcn_global_load_lds((const unsigned*)(cw + c), (LAS unsigned*)(wslot + 256), 4, 0, 0);
        __builtin_amdgcn_global_load_lds((const unsigned*)(cw + ncol + c), (LAS unsigned*)(wslot + 512), 4, 0, 0);
        __builtin_amdgcn_global_load_lds((const unsigned*)(cw + 2 * ncol + c), (LAS unsigned*)(wslot + 768), 4, 0, 0);
        __builtin_amdgcn_global_load_lds((const unsigned*)(cb + c), (LAS unsigned*)(wslot + 1024), 4, 0, 0);
    }
    __device__ __forceinline__ void operator()(const f32x4 (&acc)[2][2][4][2], const Unit& u, int wr, int wc, int fr, int fq, const LAS unsigned char* wslot) const {
        asm volatile("" ::: "memory");
        const int row0 = u.pm * BM + 128 * wr, s = seq_of_row(row0), L = seq_len(s), tl0 = row0 - seq_start(s) + 8 * fr;
        bf16_t* base = UT + (size_t)seq_start(s) * ncol + tl0;
        const size_t hb = (size_t)u.pm * 2 + wr;
#pragma unroll
        for (int bj = 0; bj < 2; ++bj)
#pragma unroll
            for (int n = 0; n < 2; ++n) {
                const int c0 = u.pn * BM + bj * HALF + wc * 32 + 8 * fq + 4 * n;
                const LAS float* wsl = (const LAS float*)wslot + bj * 32 + 8 * fq + 4 * n;
                const f32x4 bi = *(const LAS f32x4*)wsl, w0 = *(const LAS f32x4*)(wsl + 64), w1 = *(const LAS f32x4*)(wsl + 128), w2 = *(const LAS f32x4*)(wsl + 192), bb = *(const LAS f32x4*)(wsl + 256);
                f32x4 x[8];
#pragma unroll
                for (int k = 0; k < 8; ++k) x[k] = acc[k >> 2][bj][k & 3][n] + bi;
                f32x4 pv, nx;
#pragma unroll
                for (int j = 0; j < 4; ++j) { pv[j] = dpp_shr1(x[7][j]); nx[j] = dpp_shl1(x[0][j]); }
#pragma unroll
                for (int j = 0; j < 4; ++j) {
                    float y[8];
#pragma unroll
                    for (int k = 0; k < 8; ++k) { const float ap = (k == 0) ? pv[j] : x[k - 1][j], an = (k == 7) ? nx[j] : x[k + 1][j]; y[k] = __builtin_fmaf(w2[j], an, __builtin_fmaf(w1[j], x[k][j], __builtin_fmaf(w0[j], ap, bb[j]))); }
                    u32x4 w; w.x = cvt_pk_bf16(y[0], y[1]); w.y = cvt_pk_bf16(y[2], y[3]); w.z = cvt_pk_bf16(y[4], y[5]); w.w = cvt_pk_bf16(y[6], y[7]);
                    *(u32x4*)(base + (size_t)(c0 + j) * L) = w;
                }
                if (fr == 0) { u32x2 w; w.x = cvt_pk_bf16(x[0][0], x[0][1]); w.y = cvt_pk_bf16(x[0][2], x[0][3]); *(u32x2*)(EU + (hb * 2 + 0) * ncol + c0) = w; }
                if (fr == 15) { u32x2 w; w.x = cvt_pk_bf16(x[7][0], x[7][1]); w.y = cvt_pk_bf16(x[7][2], x[7][3]); *(u32x2*)(EU + (hb * 2 + 1) * ncol + c0) = w; }
            }
    }
};

template <bool ROWPERM, class Epi, class Sched>
__device__ __forceinline__ void gemm_phase(LAS unsigned char* lds, const Gemm g, const Sched& S, const Epi& E) {
    int tid = threadIdx.x; asm volatile("" : "+v"(tid));
    const int wid = __builtin_amdgcn_readfirstlane(tid >> 6), lane = tid & 63, wr = wid >> 2, wc = wid & 3, fr = lane & 15, fq = lane >> 4;
    const int K = g.K, nt = K / BK;
    unsigned voffA[2], voffB[2];
#pragma unroll
    for (int i = 0; i < 2; ++i) { int R, C; stage_rc(tid * 16 + i * 8192, R, C); const int Rb = (R & ~31) + perm32(R & 31);
        const int Ra = ROWPERM ? (128 * (R >> 6) + 8 * (R & 15) + ((R >> 4) & 3)) : R;
        voffA[i] = (unsigned)(Ra * g.lda + C) * 2u; voffB[i] = (unsigned)(Rb * g.ldb + C) * 2u; }
    const size_t kstep = (size_t)(BK * 2);
    const size_t hstepA = (size_t)(ROWPERM ? 4 : HALF) * g.lda * 2, hstepB = (size_t)HALF * g.ldb * 2;
    const unsigned ldsw = (unsigned)wid * 1024u;
    const int aoff = lds_byte(wr * 64 + fr, fq * 8), boff = lds_byte(wc * 32 + fr, fq * 8);
#define PG8_SA(b, h) (((b) * 2 + (h)) * HTB)
#define PG8_SB(b, h) ((4 + (b) * 2 + (h)) * HTB)
#define PG8_STAGE(bufoff, gbase, voff) do { _Pragma("unroll") for (int _i = 0; _i < 2; ++_i) \
        __builtin_amdgcn_global_load_lds((const unsigned*)((const char*)(gbase) + (voff)[_i]), (LAS unsigned*)(lds + (bufoff) + ldsw + _i * 8192), 16, 0, 0); } while (0)
#define PG8_LDA(dst, b, h) do { _Pragma("unroll") for (int m = 0; m < 4; ++m) _Pragma("unroll") for (int k = 0; k < 2; ++k) dst[m][k] = *(const LAS bf16x8*)(lds + PG8_SA(b, h) + aoff + m * 2048 + k * 1024); } while (0)
#define PG8_LDB(dst, b, h) do { _Pragma("unroll") for (int n = 0; n < 2; ++n) _Pragma("unroll") for (int k = 0; k < 2; ++k) dst[n][k] = *(const LAS bf16x8*)(lds + PG8_SB(b, h) + boff + n * 2048 + k * 1024); } while (0)
#define PG8_MMA(ai, bj, At, Bt) do { __builtin_amdgcn_s_setprio(1); _Pragma("unroll") for (int m = 0; m < 4; ++m) _Pragma("unroll") for (int n = 0; n < 2; ++n) _Pragma("unroll") for (int k = 0; k < 2; ++k) \
        acc[ai][bj][m][n] = __builtin_amdgcn_mfma_f32_16x16x32_bf16(Bt[n][k], At[m][k], acc[ai][bj][m][n], 0, 0, 0); __builtin_amdgcn_s_setprio(0); } while (0)
#define PG8_WAIT_V(n) asm volatile("s_waitcnt vmcnt(" #n ")" ::: "memory")
#define PG8_WAIT_SEAM(flag, N) asm volatile("s_cmp_eq_u32 %0, 0\n\ts_cbranch_scc0 1f\n\ts_waitcnt vmcnt(6)\n1:\n\ts_waitcnt vmcnt(%1)" :: "s"(flag), "n"(N) : "memory", "scc")
#define PG8_WAIT_L(n) asm volatile("s_waitcnt lgkmcnt(" #n ")" ::: "memory")
#define PG8_BAR __builtin_amdgcn_s_barrier()
#define PG8_SCHED __builtin_amdgcn_sched_barrier(0)
#define PG8_ABASE(u) ((const char*)g.A + ((size_t)(u).pm * BM * g.lda + (g.agrp ? (size_t)((u).pn / g.agrp) * K : (size_t)0)) * 2)
#define PG8_BBASE(u) ((const char*)g.Bt + (size_t)(u).pn * BM * g.ldb * 2)
    Unit cur, nxt; int ui = 0;
    if (!S.next(0, cur)) return;
    f32x4 acc[2][2][4][2];
#pragma unroll
    for (int a = 0; a < 2; ++a)
#pragma unroll
        for (int b = 0; b < 2; ++b)
#pragma unroll
            for (int m = 0; m < 4; ++m)
#pragma unroll
                for (int n = 0; n < 2; ++n) acc[a][b][m][n] = (f32x4){0.f, 0.f, 0.f, 0.f};
    bf16x8 At[4][2], B0[2][2], B1[2][2];
    const char* cA = PG8_ABASE(cur); const char* cB = PG8_BBASE(cur);
    PG8_STAGE(PG8_SB(0, 0), cB, voffB); PG8_STAGE(PG8_SA(0, 0), cA, voffA); PG8_STAGE(PG8_SB(0, 1), cB + hstepB, voffB); PG8_STAGE(PG8_SA(0, 1), cA + hstepA, voffA);
    if (wr == 1) PG8_BAR;
    PG8_WAIT_V(4); PG8_BAR;
    PG8_STAGE(PG8_SB(1, 0), cB + kstep, voffB); PG8_STAGE(PG8_SA(1, 0), cA + kstep, voffA); PG8_STAGE(PG8_SB(1, 1), cB + hstepB + kstep, voffB);
    PG8_WAIT_V(6); PG8_BAR;
    LAS unsigned char* const wslot = lds + STAGE_BYTES + wid * 1536;
    for (;;) {
        E.prefetch(wslot, cur, wc, lane);
        const bool has_next = S.next(ui + 1, nxt);
        const char* nA = has_next ? PG8_ABASE(nxt) : cA; const char* nB = has_next ? PG8_BBASE(nxt) : cB;
        int seam = __builtin_amdgcn_readfirstlane(ui > 0 ? 1 : 0); asm volatile("" : "+s"(seam));
        for (int t = 0; t < nt; t += 2) {
            const bool last = (t == nt - 2);
            const char* a1 = cA + (size_t)(t + 1) * kstep;
            const char* a2 = last ? nA : cA + (size_t)(t + 2) * kstep; const char* b2 = last ? nB : cB + (size_t)(t + 2) * kstep;
            const char* a3 = a2 + kstep; const char* b3 = b2 + kstep;

            PG8_LDB(B0, 0, 0); PG8_SCHED; PG8_LDA(At, 0, 0); PG8_STAGE(PG8_SA(1, 1), a1 + hstepA, voffA);
            PG8_WAIT_L(8); PG8_BAR; PG8_WAIT_L(0); PG8_MMA(0, 0, At, B0); PG8_BAR; PG8_SCHED;
            PG8_LDB(B1, 0, 1); PG8_STAGE(PG8_SB(0, 0), b2, voffB);
            PG8_BAR; PG8_WAIT_L(0); PG8_MMA(0, 1, At, B1); PG8_BAR;
            PG8_LDA(At, 0, 1); PG8_STAGE(PG8_SA(0, 0), a2, voffA);
            PG8_BAR; PG8_WAIT_L(0); PG8_MMA(1, 0, At, B0); PG8_BAR; PG8_SCHED;
            PG8_STAGE(PG8_SB(0, 1), b2 + hstepB, voffB);
            PG8_WAIT_SEAM(seam, 8 + Epi::NVM);
            PG8_BAR; PG8_MMA(1, 1, At, B1); PG8_BAR;
            PG8_LDB(B0, 1, 0); PG8_SCHED; PG8_LDA(At, 1, 0); PG8_STAGE(PG8_SA(0, 1), a2 + hstepA, voffA);
            PG8_WAIT_L(8); PG8_BAR; PG8_WAIT_L(0); PG8_MMA(0, 0, At, B0); PG8_BAR; PG8_SCHED;
            PG8_LDB(B1, 1, 1); PG8_STAGE(PG8_SB(1, 0), b3, voffB);
            PG8_BAR; PG8_WAIT_L(0); PG8_MMA(0, 1, At, B1); PG8_BAR;
            PG8_LDA(At, 1, 1); PG8_STAGE(PG8_SA(1, 0), a3, voffA);
            PG8_BAR; PG8_WAIT_L(0); PG8_MMA(1, 0, At, B0); PG8_BAR; PG8_SCHED;
            PG8_STAGE(PG8_SB(1, 1), b3 + hstepB, voffB);
            PG8_WAIT_V(6); PG8_BAR; PG8_MMA(1, 1, At, B1); PG8_BAR;
            asm volatile("s_mov_b32 %0, 0" : "=s"(seam));
        }
        if (has_next) PG8_STAGE(PG8_SA(1, 1), nA + kstep + hstepA, voffA);
        E(acc, cur, wr, wc, fr, fq, wslot);
        if (!has_next) break;
#pragma unroll
        for (int a = 0; a < 2; ++a)
#pragma unroll
            for (int b = 0; b < 2; ++b)
#pragma unroll
                for (int m = 0; m < 4; ++m)
#pragma unroll
                    for (int n = 0; n < 2; ++n) acc[a][b][m][n] = (f32x4){0.f, 0.f, 0.f, 0.f};
        cur = nxt; cA = nA; cB = nB; ++ui;
    }
    PG8_WAIT_V(0);
    if (wr == 0) PG8_BAR;
    PG8_BAR;
#undef PG8_SA
#undef PG8_SB
#undef PG8_STAGE
#undef PG8_LDA
#undef PG8_LDB
#undef PG8_MMA
#undef PG8_WAIT_V
#undef PG8_WAIT_L
#undef PG8_WAIT_SEAM
#undef PG8_BAR
#undef PG8_SCHED
#undef PG8_ABASE
#undef PG8_BBASE
}
}
namespace att {
constexpr int HD = 128, NW = 8, QBLK = 32, KVBLK = 64;
constexpr float SCALE = 0.088388347648318440f;
constexpr float THR = 8.f;
constexpr int LDQ = 3072, LDK = 3072, LDO = 2048;
constexpr int SHM_V = KVBLK * HD * 2, SHM_K = KVBLK * HD * 2, SHM_ATTN = 2 * SHM_V + 2 * SHM_K + NW * 64 * 4;
#define KSWZ(row, colB) ((row) * 256 + ((colB) ^ (((row) & 7) << 4)))
#define SBAR() __builtin_amdgcn_sched_barrier(0)
__device__ __forceinline__ int crow(int r, int hi) { return (r & 3) + 8 * (r >> 2) + 4 * hi; }

__device__ __forceinline__ void partialSM(f32x16& p0, f32x16& p1, float& m_reg, float& mn, float& alpha) {
  constexpr float C = SCALE * 1.4426950408889634f;
  float pmax = p0[0];
#pragma unroll
  for (int r = 1; r < 16; ++r) pmax = fmaxf(pmax, p0[r]);
#pragma unroll
  for (int r = 0; r < 16; ++r) pmax = fmaxf(pmax, p1[r]);
  { auto rr = __builtin_amdgcn_permlane32_swap(__float_as_uint(pmax), __float_as_uint(pmax), false, false);
    pmax = fmaxf(__uint_as_float(rr[0]), __uint_as_float(rr[1])); }
  if (__builtin_expect(__all(pmax - m_reg <= THR / SCALE), 1)) { mn = m_reg; alpha = 1.f; }
  else { mn = fmaxf(m_reg, pmax); alpha = __builtin_amdgcn_exp2f((m_reg - mn) * C); m_reg = mn; }
  float mnC = -mn * C;
#pragma unroll
  for (int r = 0; r < 16; ++r) p0[r] = fmaf(p0[r], C, mnC);
#pragma unroll
  for (int r = 0; r < 16; ++r) p1[r] = fmaf(p1[r], C, mnC);
#pragma unroll
  for (int r = 0; r < 16; ++r) p0[r] = __builtin_amdgcn_exp2f(p0[r]);
}
__device__ __forceinline__ void finishSM(f32x16& p0, f32x16& p1, float alpha, float& l_reg, bf16x8& pa0, bf16x8& pa1, bf16x8& pa2, bf16x8& pa3) {
#pragma unroll
  for (int r = 0; r < 16; ++r) p1[r] = __builtin_amdgcn_exp2f(p1[r]);
  float ps = 0;
#pragma unroll
  for (int r = 0; r < 16; ++r) ps += p0[r];
#pragma unroll
  for (int r = 0; r < 16; ++r) ps += p1[r];
  { auto rr = __builtin_amdgcn_permlane32_swap(__float_as_uint(ps), __float_as_uint(ps), false, false);
    ps = __uint_as_float(rr[0]) + __uint_as_float(rr[1]); }
  l_reg = l_reg * alpha + ps;
#define PK4(P, BASE, OUT) do { unsigned a0 = cvt_pk_bf16(P[BASE + 0], P[BASE + 1]), a1 = cvt_pk_bf16(P[BASE + 2], P[BASE + 3]);   \
    unsigned b0 = cvt_pk_bf16(P[BASE + 4], P[BASE + 5]), b1 = cvt_pk_bf16(P[BASE + 6], P[BASE + 7]);                              \
    auto r0 = __builtin_amdgcn_permlane32_swap(a0, b0, false, false); auto r1 = __builtin_amdgcn_permlane32_swap(a1, b1, false, false); \
    u32x4 w = {r0[0], r1[0], r0[1], r1[1]}; OUT = *reinterpret_cast<bf16x8*>(&w); } while (0)
  PK4(p0, 0, pa0); PK4(p0, 8, pa1); PK4(p1, 0, pa2); PK4(p1, 8, pa3);
#undef PK4
}
__device__ __forceinline__ void qkt(f32x16& p0, f32x16& p1, const bf16_t* Ks, const bf16x8* qr, int r32, int hi) {
  p0 = f32x16{}; p1 = f32x16{};
#pragma unroll
  for (int d0 = 0; d0 < 8; ++d0) { int cb = (d0 * 16 + hi * 8) * 2;
    bf16x8 b0 = *reinterpret_cast<const bf16x8*>((const char*)Ks + KSWZ(r32, cb));
    bf16x8 b1 = *reinterpret_cast<const bf16x8*>((const char*)Ks + KSWZ(32 + r32, cb));
    p0 = __builtin_amdgcn_mfma_f32_32x32x16_bf16(b0, qr[d0], p0, 0, 0, 0);
    p1 = __builtin_amdgcn_mfma_f32_32x32x16_bf16(b1, qr[d0], p1, 0, 0, 0); }
}
__device__ __forceinline__ int v_st(int k, int c) { const int kk = (k & ~0xC) | ((k & 4) << 1) | ((k & 8) >> 1); return ((kk >> 3) * 4 + (c >> 5)) * 512 + ((kk & 7) * 32 + (c & 31)) * 2; }
__device__ __forceinline__ int v_rd_base(int lane) { return ((lane & 3) << 3) | (((lane >> 2) & 3) << 6) | (((lane >> 4) & 1) << 5) | (((lane >> 5) & 1) << 8); }
constexpr int v_rd_off(int d0, int ks, int half) { return d0 * 512 + ks * 4096 + half * 2048; }
template <int OFF> __device__ __forceinline__ s16x4 tr_read(int vb) {
  s16x4 r; asm volatile("ds_read_b64_tr_b16 %0, %1 offset:%2" : "=&v"(r) : "v"(vb), "i"(OFF) : "memory"); return r;
}
template <int D0> __device__ __forceinline__ void pv_one(f32x16& od, int vb, bf16x8 pa0, bf16x8 pa1, bf16x8 pa2, bf16x8 pa3) {
  const s16x4 l0 = tr_read<v_rd_off(D0, 0, 0)>(vb), h0 = tr_read<v_rd_off(D0, 0, 1)>(vb), l1 = tr_read<v_rd_off(D0, 1, 0)>(vb), h1 = tr_read<v_rd_off(D0, 1, 1)>(vb);
  const s16x4 l2 = tr_read<v_rd_off(D0, 2, 0)>(vb), h2 = tr_read<v_rd_off(D0, 2, 1)>(vb), l3 = tr_read<v_rd_off(D0, 3, 0)>(vb), h3 = tr_read<v_rd_off(D0, 3, 1)>(vb);
  asm volatile("s_waitcnt lgkmcnt(0)" ::: "memory"); SBAR();
#define PK(L, H) (bf16x8){L[0], L[1], L[2], L[3], H[0], H[1], H[2], H[3]}
  od = __builtin_amdgcn_mfma_f32_32x32x16_bf16(PK(l0, h0), pa0, od, 0, 0, 0);
  od = __builtin_amdgcn_mfma_f32_32x32x16_bf16(PK(l1, h1), pa1, od, 0, 0, 0);
  od = __builtin_amdgcn_mfma_f32_32x32x16_bf16(PK(l2, h2), pa2, od, 0, 0, 0);
  od = __builtin_amdgcn_mfma_f32_32x32x16_bf16(PK(l3, h3), pa3, od, 0, 0, 0);
#undef PK
}
__device__ __forceinline__ void pv_d0(f32x16* o, int vb, bf16x8 pa0, bf16x8 pa1, bf16x8 pa2, bf16x8 pa3) {
  pv_one<0>(o[0], vb, pa0, pa1, pa2, pa3); pv_one<1>(o[1], vb, pa0, pa1, pa2, pa3); pv_one<2>(o[2], vb, pa0, pa1, pa2, pa3); pv_one<3>(o[3], vb, pa0, pa1, pa2, pa3);
}

__device__ __forceinline__ void attn_dense_body(const bf16_t* __restrict__ Qb, const bf16_t* __restrict__ Kh, const bf16_t* __restrict__ Vh,
                                                bf16_t* __restrict__ Ob, int seq, char* lds) {
  int tid = threadIdx.x; asm volatile("" : "+v"(tid));
  const int wid = tid >> 6, lane = tid & 63, r32 = lane & 31, hi = lane >> 5;
  bf16_t* V_lds = (bf16_t*)lds; bf16_t* K_lds = (bf16_t*)(lds + 2 * SHM_V);
  float* ws = (float*)(lds + 2 * SHM_V + 2 * SHM_K) + wid * 64; float* li_l = ws; float* al_l = ws + 32;
  float m_reg = -1e30f, l_reg = 0; f32x16 o[4] = {}; bf16x8 qr[8];
  const bf16_t* Qw = Qb + (long)(wid * QBLK + r32) * LDQ + hi * 8;
#pragma unroll
  for (int d0 = 0; d0 < 8; ++d0) qr[d0] = *reinterpret_cast<const bf16x8*>(Qw + d0 * 16);
  const int sr = tid >> 4, sc = (tid & 15) * 8, vst0 = v_st(sr, sc), vst1 = v_st(32 + sr, sc);
  const int vb0 = (int)(uintptr_t)V_lds + v_rd_base(lane);
  struct { bf16x8 vs0, vs1, ks0, ks1; } sr_[2];
#define SLOAD(i, k0) do { sr_[i].vs0 = *reinterpret_cast<const bf16x8*>(&Vh[(long)((k0) + sr) * LDK + sc]); sr_[i].vs1 = *reinterpret_cast<const bf16x8*>(&Vh[(long)((k0) + 32 + sr) * LDK + sc]); \
    sr_[i].ks0 = *reinterpret_cast<const bf16x8*>(&Kh[(long)((k0) + sr) * LDK + sc]); sr_[i].ks1 = *reinterpret_cast<const bf16x8*>(&Kh[(long)((k0) + 32 + sr) * LDK + sc]); } while (0)
#define SWRITE(b, i) do { *(bf16x8*)((char*)V_lds + (b) * SHM_V + vst0) = sr_[i].vs0;          \
    *(bf16x8*)((char*)V_lds + (b) * SHM_V + vst1) = sr_[i].vs1; int kc = sc * 2;               \
    *(bf16x8*)((char*)K_lds + (b) * SHM_K + KSWZ(sr, kc)) = sr_[i].ks0;                       \
    *(bf16x8*)((char*)K_lds + (b) * SHM_K + KSWZ(32 + sr, kc)) = sr_[i].ks1; } while (0)
#define SWAIT() asm volatile("s_waitcnt vmcnt(4)" ::: "memory")
#define RESC(a) do { if (__any((a) < 1.f)) { const float _al = (a); \
    _Pragma("unroll") for (int d = 0; d < 4; ++d) _Pragma("unroll") for (int r = 0; r < 16; ++r) o[d][r] *= _al; } } while (0)
  f32x16 pA0, pA1, pB0, pB1; float mnA, mnB, alA, alB; bf16x8 pa0, pa1, pa2, pa3; const int NT = seq / KVBLK;
  constexpr int SE = 0, SO = 1;
  SLOAD(SE, 0); asm volatile("s_waitcnt vmcnt(0)" ::: "memory"); SWRITE(0, SE); __syncthreads();
  qkt(pA0, pA1, K_lds, qr, r32, hi); partialSM(pA0, pA1, m_reg, mnA, alA);
  SLOAD(SO, KVBLK); if (2 < NT) SLOAD(SE, 2 * KVBLK);
  SWAIT(); SWRITE(1, SO); __syncthreads();
  for (int j = 1; j + 1 < NT; j += 2) {
    SBAR(); qkt(pB0, pB1, (bf16_t*)((char*)K_lds + SHM_K), qr, r32, hi);
    finishSM(pA0, pA1, alA, l_reg, pa0, pa1, pa2, pa3); SBAR();
    SLOAD(SO, (j + 2) * KVBLK); SBAR();
    pv_d0(o, vb0, pa0, pa1, pa2, pa3); partialSM(pB0, pB1, m_reg, mnB, alB);
    __syncthreads(); SWAIT(); SWRITE(0, SE);
    RESC(alB); __syncthreads();
    SBAR(); qkt(pA0, pA1, K_lds, qr, r32, hi);
    finishSM(pB0, pB1, alB, l_reg, pa0, pa1, pa2, pa3); SBAR();
    if (j + 3 < NT) SLOAD(SE, (j + 3) * KVBLK); SBAR();
    pv_d0(o, vb0 + (int)SHM_V, pa0, pa1, pa2, pa3); partialSM(pA0, pA1, m_reg, mnA, alA);
    __syncthreads(); SWAIT(); SWRITE(1, SO);
    RESC(alA); __syncthreads();
  }
  SBAR(); qkt(pB0, pB1, (bf16_t*)((char*)K_lds + SHM_K), qr, r32, hi);
  finishSM(pA0, pA1, alA, l_reg, pa0, pa1, pa2, pa3); SBAR();
  pv_d0(o, vb0, pa0, pa1, pa2, pa3); partialSM(pB0, pB1, m_reg, mnB, alB);
  __syncthreads(); RESC(alB);
  finishSM(pB0, pB1, alB, l_reg, pa0, pa1, pa2, pa3); SBAR();
  pv_d0(o, vb0 + (int)SHM_V, pa0, pa1, pa2, pa3);
  const float rl = __builtin_amdgcn_rcpf(l_reg);
  bf16_t* Ow = Ob + (long)(wid * QBLK + r32) * LDO + hi * 8;
#pragma unroll
  for (int d0 = 0; d0 < 4; ++d0)
#pragma unroll
    for (int g = 0; g < 4; g += 2) {
      unsigned ax = cvt_pk_bf16(o[d0][4 * g + 0] * rl, o[d0][4 * g + 1] * rl), ay = cvt_pk_bf16(o[d0][4 * g + 2] * rl, o[d0][4 * g + 3] * rl);
      unsigned bx = cvt_pk_bf16(o[d0][4 * g + 4] * rl, o[d0][4 * g + 5] * rl), by = cvt_pk_bf16(o[d0][4 * g + 6] * rl, o[d0][4 * g + 7] * rl);
      { auto r0 = __builtin_amdgcn_permlane32_swap(ax, bx, false, false); ax = r0[0]; bx = r0[1]; }
      { auto r1 = __builtin_amdgcn_permlane32_swap(ay, by, false, false); ay = r1[0]; by = r1[1]; }
      u32x4 w = {ax, ay, bx, by};
      *reinterpret_cast<u32x4*>(Ow + d0 * 32 + 8 * g) = w;
    }
#undef SLOAD
#undef SWRITE
#undef SWAIT
#undef RESC
}
#undef KSWZ
#undef SBAR
}
#define XB_TMO      128
#define XB_XCNT(j)  (256  + 64 * (j))
#define XB_XSUB(j)  (1280 + 64 * (j))
#define XB_XGEN(j)  (2304 + 64 * (j))
#define XB_TOP      3328
#define XB_TOPGEN   3392
#define XCD_BAR_WORDS 3456
#define XB_SPIN_CAP (1u << 22)

__device__ __forceinline__ unsigned xb_ld(unsigned* p)              { return __hip_atomic_load(p, __ATOMIC_RELAXED, __HIP_MEMORY_SCOPE_AGENT); }
__device__ __forceinline__ unsigned xb_add(unsigned* p, unsigned v) { return __hip_atomic_fetch_add(p, v, __ATOMIC_RELAXED, __HIP_MEMORY_SCOPE_AGENT); }
__device__ __forceinline__ unsigned xb_xcc_id() { return (unsigned)__builtin_amdgcn_s_getreg((3 << 11) | 20) & 0xFu; }
#define XB_SPIN(cond, bar) do { unsigned _sp = 0; while (cond) { __builtin_amdgcn_s_sleep(1); \
    if ((++_sp & 255u) == 0u) { if (xb_ld(&(bar)[XB_TMO])) break; if (_sp > XB_SPIN_CAP) { atomicAdd(&(bar)[XB_TMO], 1u); break; } } } } while (0)

struct XcdBarrier { unsigned* bar; unsigned x; volatile LAS unsigned* st; };

__device__ __forceinline__ XcdBarrier xcd_barrier_post(unsigned* bar, volatile LAS unsigned* st) {
    XcdBarrier b; b.bar = bar; b.x = xb_xcc_id(); b.st = st;
    if (threadIdx.x == 0) (void)xb_add(&bar[XB_XCNT(b.x)], 1u);
    return b;
}
__device__ __forceinline__ void xcd_barrier_complete(unsigned* bar, unsigned x, unsigned& nloc, unsigned& nx) {
    const unsigned G = gridDim.x * gridDim.y * gridDim.z;
    unsigned sum, cnt, mine, sp = 0u;
    for (;;) {
        sum = 0u; cnt = 0u; mine = 0u;
#pragma unroll
        for (unsigned j = 0; j < 16; ++j) { const unsigned c = xb_ld(&bar[XB_XCNT(j)]); sum += c; cnt += (c > 0u) ? 1u : 0u; mine = (j == x) ? c : mine; }
        if (sum == G) break;
        __builtin_amdgcn_s_sleep(1);
        if ((++sp & 255u) == 0u) { if (xb_ld(&bar[XB_TMO])) break; if (sp > XB_SPIN_CAP) { atomicAdd(&bar[XB_TMO], 1u); break; } }
    }
    nloc = mine > 0u ? mine : 1u; nx = cnt > 0u ? cnt : 1u;
}
__device__ __forceinline__ void xcd_barrier(const XcdBarrier& b) {
    asm volatile("s_waitcnt vmcnt(0)" ::: "memory");
    __syncthreads();
    if (threadIdx.x == 0) {
        unsigned* bar = b.bar;
        __builtin_amdgcn_s_waitcnt(0);
        unsigned nloc = b.st[0], nx = b.st[1];
        if (nloc == 0u) { xcd_barrier_complete(bar, b.x, nloc, nx); b.st[0] = nloc; b.st[1] = nx; }
        const unsigned old = xb_add(&bar[XB_XSUB(b.x)], 1u);
        const unsigned gen = old / nloc;
        if (old + 1u == (gen + 1u) * nloc) {
            __builtin_amdgcn_fence(__ATOMIC_RELEASE, "agent");
            asm volatile("s_waitcnt vmcnt(0)" ::: "memory");
            const unsigned og = xb_add(&bar[XB_TOP], 1u);
            const unsigned tg = og / nx;
            if (og + 1u == (tg + 1u) * nx) xb_add(&bar[XB_TOPGEN], 1u);
            else XB_SPIN(xb_ld(&bar[XB_TOPGEN]) == tg, bar);
            __builtin_amdgcn_fence(__ATOMIC_ACQUIRE, "agent");
            xb_add(&bar[XB_XGEN(b.x)], 1u);
            asm volatile("s_waitcnt vmcnt(0)" ::: "memory");
        } else {
            XB_SPIN(xb_ld(&bar[XB_XGEN(b.x)]) == gen, bar);
            __builtin_amdgcn_fence(__ATOMIC_ACQUIRE, "agent");
            asm volatile("s_waitcnt vmcnt(0)" ::: "memory");
        }
    }
    __syncthreads();
}
#define LDS_WAIT() asm volatile("s_waitcnt lgkmcnt(0)" ::: "memory")
#define VM_WAIT() asm volatile("s_waitcnt vmcnt(0)" ::: "memory")
constexpr int NWAVES = 8, NTHREADS = 512;
constexpr int LDS_BYTES = 147456;
constexpr int MISC_OFF = 140 * 1024;

struct Args { const float* in[32]; float* out; unsigned char* ws; int ph_lo, ph_hi, li, pad; };
struct Frame { LAS unsigned char* lds; int tid, lane, wave, vcu, G, gw, NGW; };

enum { I_XP = 0, I_XS, I_CP, I_CS, I_MODW, I_MODB, I_NMPRE, I_NMPOST, I_NFPRE, I_NFPOST, I_FUP, I_FCW, I_FCB, I_FDN, I_POOLW, I_POOLS,
       I_HWIN, I_HBIN, I_HCW, I_HCB, I_HFW1, I_HFB1, I_HFW2, I_HFB2, I_HFW3, I_HFREQ, I_HSKIP, I_HWOUT, I_AQKV, I_AQG, I_AKG, I_AWO };

constexpr size_t MiB = 1u << 20;
constexpr size_t WS_CTL = 0, CTL_ZERO_BYTES = 1 * MiB;
constexpr size_t WS_MOD = 1 * MiB;
constexpr size_t WS_A2 = 2 * MiB;
constexpr size_t WS_W3T = 5 * MiB;
constexpr size_t WS_POOLW = 6 * MiB;
constexpr size_t WS_HYWIN = 10 * MiB;
constexpr size_t WS_HYWOUT = 34 * MiB;
constexpr size_t WS_ATQKV = 42 * MiB;
constexpr size_t WS_ATWO = 54 * MiB;
constexpr size_t WS_WUP = 62 * MiB;
constexpr size_t WS_WDN = 106 * MiB;
constexpr size_t WS_H = 128 * MiB;
constexpr size_t WS_M1 = 320 * MiB;
constexpr size_t WS_BIG = 512 * MiB;
constexpr size_t WS_U = WS_BIG, WS_EA = WS_BIG + 528 * MiB, WS_EB = WS_BIG + 548 * MiB;
constexpr size_t WS_QKV = WS_BIG, WS_O = WS_BIG + 288 * MiB;
constexpr size_t WS_P = WS_BIG;
constexpr size_t WS_UT = 320 * MiB;
constexpr size_t WS_EU = 896 * MiB;
constexpr size_t WS_FK = 906 * MiB;
constexpr size_t WS_ZT = 1099 * MiB;
constexpr size_t WS_M1H = WS_M1;
constexpr size_t WS_XB = 1147 * MiB;
constexpr size_t WS_END = 1339 * MiB;
constexpr int FK_PITCH_P = 2 * LP + 32, FK_PITCH_S = 2 * LS + 32;
constexpr size_t FK_SAMPLE_OFF = (size_t)2 * 512 * FK_PITCH_P;

__device__ __forceinline__ unsigned pk2(float lo, float hi) { return cvt_pk_bf16(lo, hi); }
template <bool GLUMAP = false>
__device__ __forceinline__ void transpose_item(const float* W, int N, bf16_t* WT, int ldk, LAS float* scr, int item, int lane) {
    const int nblk = N / 32, kb = item / nblk, nb = item % nblk, k0 = 64 * kb, n0 = 32 * nb;
    const int d0 = GLUMAP ? (((n0 % DFF) / 128) * 256 + (n0 / DFF) * 128 + (n0 % 128)) : n0;
    { f32x4 v[8]; const int kr = lane >> 3, ch = (lane & 7) * 4;
#pragma unroll
      for (int i = 0; i < 8; ++i) v[i] = *(const f32x4*)(W + (size_t)(k0 + kr + 8 * i) * N + n0 + ch);
#pragma unroll
      for (int i = 0; i < 8; ++i) { LAS float* d = scr + (kr + 8 * i) * 33 + ch; d[0] = v[i].x; d[1] = v[i].y; d[2] = v[i].z; d[3] = v[i].w; } }
    LDS_WAIT();
    const int c = lane & 7;
#pragma unroll
    for (int j = 0; j < 4; ++j) { const int n = (lane >> 3) + 8 * j; const LAS float* s = scr + (8 * c) * 33 + n;
        u32x4 o; o.x = pk2(s[0 * 33], s[1 * 33]); o.y = pk2(s[2 * 33], s[3 * 33]); o.z = pk2(s[4 * 33], s[5 * 33]); o.w = pk2(s[6 * 33], s[7 * 33]);
        *(u32x4*)(WT + (size_t)(d0 + n) * ldk + k0 + 8 * c) = o; }
    LDS_WAIT();
}
template <bool GLUMAP = false>
__device__ __forceinline__ void prep_matrix(const Frame& F, const float* W, int K, int N, bf16_t* WT) {
    LAS float* scr = (LAS float*)(F.lds + F.wave * 8448);
    const int nitems = (K / 64) * (N / 32);
    for (int it = F.gw; it < nitems; it += F.NGW) transpose_item<GLUMAP>(W, N, WT, K, scr, it, F.lane);
}
__device__ __forceinline__ void prep_ffn_weights(const Frame& F, const Args& a, int layer) {
    prep_matrix<true>(F, a.in[I_FUP] + (size_t)layer * D * 2 * DFF, D, 2 * DFF, (bf16_t*)(a.ws + WS_WUP));
    prep_matrix(F, a.in[I_FDN] + (size_t)layer * DFF * D, DFF, D, (bf16_t*)(a.ws + WS_WDN));
}

__device__ __forceinline__ void mod_phase(const Frame& F, const Args& a) {
    LAS float* cact = (LAS float*)F.lds;
    LAS float* red = (LAS float*)(F.lds + 40960);
    for (int i = F.tid; i < NB * D; i += NTHREADS) { const int b = i / D, k = i % D; const float c = b < 4 ? a.in[I_CP][b * D + k] : a.in[I_CS][k]; cact[i] = c / (1.0f + __expf(-c)); }
    __syncthreads();
    const int rg = F.tid >> 4, cl = F.tid & 15;
    for (int u = F.vcu; u < NLAYER * 192; u += F.G) {
        const int layer = u / 192, col0 = (u % 192) * 64;
        const float* W = a.in[I_MODW] + (size_t)layer * D * 6 * D + col0 + cl * 4;
        f32x4 acc[NB];
#pragma unroll
        for (int b = 0; b < NB; ++b) acc[b] = (f32x4){0.f, 0.f, 0.f, 0.f};
#pragma unroll 8
        for (int k = rg; k < D; k += 32) { const f32x4 w = *(const f32x4*)(W + (size_t)k * 6 * D);
#pragma unroll
            for (int b = 0; b < NB; ++b) acc[b] += w * cact[b * D + k]; }
#pragma unroll
        for (int b = 0; b < NB; ++b) *(LAS f32x4*)(red + (rg * NB + b) * 64 + cl * 4) = acc[b];
        __syncthreads();
        if (F.tid < NB * 64) { const int b = F.tid >> 6, c = F.tid & 63; float s = 0.f;
            for (int r = 0; r < 32; ++r) s += red[(r * NB + b) * 64 + c];
            ((float*)(a.ws + WS_MOD))[((size_t)layer * NB + b) * 6 * D + col0 + c] = s + a.in[I_MODB][(size_t)layer * 6 * D + col0 + c]; }
        __syncthreads();
    }
}

__device__ __forceinline__ void hyena_features(const Frame& F, const Args& a) {
    const float* w1 = a.in[I_HFW1]; const float* b1 = a.in[I_HFB1]; const float* w2 = a.in[I_HFW2]; const float* b2 = a.in[I_HFB2]; const float* fr = a.in[I_HFREQ];
    bf16_t* A2 = (bf16_t*)(a.ws + WS_A2);
    const int lane = F.lane; const float freq = fr[lane], bb1 = b1[lane], bb2 = b2[lane];
    for (int t = F.gw; t < LP + LS; t += F.NGW) {
        const int ls = t >= LP, n = ls ? t - LP : t, L = ls ? LS : LP;
        const float tn = (float)n / (float)(L - 1), w = 6.283185307179586f * (float)n / (float)L;
        float z = 0.f;
        if (lane == 0) z = tn;
        else if (lane <= 32) { const int k = (lane - 1) & 15; const float f = 1e-4f + (float)k * ((15.0f - 1e-4f) / 15.0f); const float ang = f * w; z = lane <= 16 ? cosf(ang) : -sinf(ang); }
        float s1 = bb1;
#pragma unroll
        for (int i = 0; i < 33; ++i) s1 += __shfl(z, i) * w1[i * 64 + lane];
        const float a1 = sinf(freq * s1);
        float s2 = bb2;
#pragma unroll 16
        for (int i = 0; i < 64; ++i) s2 += __shfl(a1, i) * w2[i * 64 + lane];
        A2[(size_t)t * 64 + lane] = f2bf(sinf(freq * s2));
    }
}

__device__ __forceinline__ void prologue_phase(const Frame& F, const Args& a) {
    prep_matrix(F, a.in[I_HWIN], D, 3 * D, (bf16_t*)(a.ws + WS_HYWIN));
    prep_matrix(F, a.in[I_HWOUT], D, D, (bf16_t*)(a.ws + WS_HYWOUT));
    prep_matrix(F, a.in[I_AQKV], D, 3072, (bf16_t*)(a.ws + WS_ATQKV));
    prep_matrix(F, a.in[I_AWO], D, D, (bf16_t*)(a.ws + WS_ATWO));
    prep_matrix(F, a.in[I_HFW3], 64, 8192, (bf16_t*)(a.ws + WS_W3T));
    for (int jg = 0; jg < 8; ++jg)
        prep_matrix(F, a.in[I_POOLW] + (size_t)jg * 512 * 512, 512, 512, (bf16_t*)(a.ws + WS_POOLW) + (size_t)jg * 512 * 512);
    __syncthreads();
    hyena_features(F, a);
    __syncthreads();
    mod_phase(F, a);
}

struct NormP { const float* xp; const float* xs; const bf16_t* xb; float* xout; bf16_t* xbout; const bf16_t* m; const float* modg; int gate_off; const float* gpost;
               const float* modh; int sc_off, sh_off; const float* gpre; bf16_t* H; };
__device__ __forceinline__ void norm_load_row(const NormP& p, int r, int lane, f32x4 (&xn)[8], u32x4 (&xh)[4], u32x4 (&mn)[4]) {
    if (p.xb) {
#pragma unroll
        for (int j = 0; j < 4; ++j) xh[j] = *(const u32x4*)(p.xb + (size_t)r * D + lane * 8 + 512 * j);
    } else { const float* xr = r < TP ? p.xp + (size_t)r * D : p.xs + (size_t)(r - TP) * D;
#pragma unroll
        for (int j = 0; j < 4; ++j) { xn[2 * j] = *(const f32x4*)(xr + lane * 8 + 512 * j); xn[2 * j + 1] = *(const f32x4*)(xr + lane * 8 + 512 * j + 4); } }
    if (p.m) {
#pragma unroll
        for (int j = 0; j < 4; ++j) mn[j] = *(const u32x4*)(p.m + (size_t)r * D + lane * 8 + 512 * j); }
}
__device__ __forceinline__ void unpack4x2(const u32x4 w, f32x4& a, f32x4& b) { a = (f32x4){bf_lo(w.x), bf_hi(w.x), bf_lo(w.y), bf_hi(w.y)}; b = (f32x4){bf_lo(w.z), bf_hi(w.z), bf_lo(w.w), bf_hi(w.w)}; }
__device__ __forceinline__ u32x4 pack4x2(const f32x4 a, const f32x4 b) { u32x4 w; w.x = pk2(a.x, a.y); w.y = pk2(a.z, a.w); w.z = pk2(b.x, b.y); w.w = pk2(b.z, b.w); return w; }
__device__ __forceinline__ void norm_phase(const Frame& F, const NormP p) {
    LAS float* va = (LAS float*)F.lds; LAS float* vb = va + D; LAS float* vc = vb + D;
    const int lane = F.lane;
    for (int blk = F.vcu; blk < T / 64; blk += F.G) {
        const int r0 = blk * 64, b = seq_of_row(r0);
        f32x4 xn[2][8]; u32x4 xh[2][4], mn[2][4];
#pragma unroll
        for (int q = 0; q < 2; ++q) {
#pragma unroll
            for (int j = 0; j < 8; ++j) xn[q][j] = (f32x4){0.f, 0.f, 0.f, 0.f};
#pragma unroll
            for (int j = 0; j < 4; ++j) { xh[q][j] = (u32x4){0u, 0u, 0u, 0u}; mn[q][j] = (u32x4){0u, 0u, 0u, 0u}; }
            norm_load_row(p, r0 + F.wave * 8 + q, lane, xn[q], xh[q], mn[q]); }
        __syncthreads();
        for (int c = F.tid; c < D; c += NTHREADS) {
            if (p.m) va[c] = p.modg[(size_t)b * 6 * D + p.gate_off + c] * p.gpost[c];
            if (p.H) { vb[c] = p.gpre[c] * (1.0f + p.modh[(size_t)b * 6 * D + p.sc_off + c]); vc[c] = p.modh[(size_t)b * 6 * D + p.sh_off + c]; }
        }
        __syncthreads();
#pragma unroll
        for (int i = 0; i < 8; ++i) {
            const int r = r0 + F.wave * 8 + i, q = i & 1;
            f32x4 x[8]; u32x4 mw[4];
#pragma unroll
            for (int j = 0; j < 4; ++j) { if (p.xb) unpack4x2(xh[q][j], x[2 * j], x[2 * j + 1]); else { x[2 * j] = xn[q][2 * j]; x[2 * j + 1] = xn[q][2 * j + 1]; } mw[j] = mn[q][j]; }
            if (i < 6) norm_load_row(p, r + 2, lane, xn[q], xh[q], mn[q]);
            if (p.m) {
                f32x4 mv[8]; float ss = 0.f;
#pragma unroll
                for (int j = 0; j < 4; ++j) unpack4x2(mw[j], mv[2 * j], mv[2 * j + 1]);
#pragma unroll
                for (int j = 0; j < 8; ++j) ss += (mv[j].x * mv[j].x + mv[j].y * mv[j].y) + (mv[j].z * mv[j].z + mv[j].w * mv[j].w);
                const float rstd = 1.0f / sqrtf(wave_sum(ss) * (1.0f / D) + EPS);
#pragma unroll
                for (int j = 0; j < 8; ++j) { const f32x4 g = *(const LAS f32x4*)(va + lane * 8 + 512 * (j >> 1) + 4 * (j & 1)); x[j] += g * (mv[j] * rstd); }
                if (p.xout) { float* xo = p.xout + (size_t)r * D;
#pragma unroll
                    for (int j = 0; j < 8; ++j) *(f32x4*)(xo + lane * 8 + 512 * (j >> 1) + 4 * (j & 1)) = x[j]; }
                if (p.xbout) { bf16_t* xo = p.xbout + (size_t)r * D;
#pragma unroll
                    for (int j = 0; j < 4; ++j) *(u32x4*)(xo + lane * 8 + 512 * j) = pack4x2(x[2 * j], x[2 * j + 1]); }
            }
            if (p.H) {
                float ss = 0.f;
#pragma unroll
                for (int j = 0; j < 8; ++j) ss += (x[j].x * x[j].x + x[j].y * x[j].y) + (x[j].z * x[j].z + x[j].w * x[j].w);
                const float rstd = 1.0f / sqrtf(wave_sum(ss) * (1.0f / D) + EPS);
                bf16_t* hr = p.H + (size_t)r * D;
#pragma unroll
                for (int j = 0; j < 4; ++j) { f32x4 h[2];
#pragma unroll
                    for (int e = 0; e < 2; ++e) { const int off = lane * 8 + 512 * j + 4 * e; const f32x4 g = *(const LAS f32x4*)(vb + off), s = *(const LAS f32x4*)(vc + off); h[e] = (x[2 * j + e] * rstd) * g + s; }
                    *(u32x4*)(hr + lane * 8 + 512 * j) = pack4x2(h[0], h[1]); }
            }
        }
    }
    __syncthreads();
}

__device__ __forceinline__ void acc8(float (&acc)[8], const u32x4 w, float sg) {
    acc[0] += sg * bf_lo(w.x); acc[1] += sg * bf_hi(w.x); acc[2] += sg * bf_lo(w.y); acc[3] += sg * bf_hi(w.y); acc[4] += sg * bf_lo(w.z); acc[5] += sg * bf_hi(w.z); acc[6] += sg * bf_lo(w.w); acc[7] += sg * bf_hi(w.w); }
__device__ __forceinline__ void pool_phase(const Frame& F, const bf16_t* H, bf16_t* P) {
    const int lane = F.lane;
    for (int u = F.gw; u < (T / 32) * 4; u += F.NGW) {
        const int g = u & 3, seg = u >> 2, t0 = seg * 32, s = seq_of_row(t0), st = seq_start(s), L = seq_len(s);
        const int win = 2 << g, half = win >> 1, col = g * 512 + lane * 8;
        const bf16_t* Hs = H + (size_t)st * D + col;
        float acc[8];
#pragma unroll
        for (int e = 0; e < 8; ++e) acc[e] = 0.f;
        const int tl0 = t0 - st;
        { int lo = tl0 - half; lo = lo < 0 ? 0 : lo; int hi = tl0 + win - half - 1; hi = hi > L - 1 ? L - 1 : hi;
          u32x4 w[16];
#pragma unroll
          for (int k = 0; k < 16; ++k) { const int r = lo + k; w[k] = (r <= hi) ? *(const u32x4*)(Hs + (size_t)r * D) : (u32x4){0u, 0u, 0u, 0u}; }
#pragma unroll
          for (int k = 0; k < 16; ++k) acc8(acc, w[k], 1.0f); }
        for (int i0 = 0; i0 < 32; i0 += 8) {
            u32x4 cen[8], inn[8], outt[8];
#pragma unroll
            for (int k = 0; k < 8; ++k) { const int tl = tl0 + i0 + k;
                cen[k] = *(const u32x4*)(Hs + (size_t)tl * D);
                const int ri = tl + win - half, ro = tl - half;
                inn[k] = (ri < L) ? *(const u32x4*)(Hs + (size_t)ri * D) : (u32x4){0u, 0u, 0u, 0u};
                outt[k] = (ro >= 0) ? *(const u32x4*)(Hs + (size_t)ro * D) : (u32x4){0u, 0u, 0u, 0u}; }
#pragma unroll
            for (int k = 0; k < 8; ++k) { const int tl = tl0 + i0 + k; int lo = tl - half; lo = lo < 0 ? 0 : lo; int hi = tl + win - half - 1; hi = hi > L - 1 ? L - 1 : hi;
                const float inv = 1.0f / (float)(hi - lo + 1); const u32x4 c = cen[k];
                u32x4 o; o.x = pk2(acc[0] * inv - bf_lo(c.x), acc[1] * inv - bf_hi(c.x)); o.y = pk2(acc[2] * inv - bf_lo(c.y), acc[3] * inv - bf_hi(c.y));
                o.z = pk2(acc[4] * inv - bf_lo(c.z), acc[5] * inv - bf_hi(c.z)); o.w = pk2(acc[6] * inv - bf_lo(c.w), acc[7] * inv - bf_hi(c.w));
                *(u32x4*)(P + (size_t)(st + tl) * D + col) = o;
                acc8(acc, inn[k], 1.0f); acc8(acc, outt[k], -1.0f); }
        }
    }
}

__device__ __forceinline__ float gelu_tanh(float x) { return pg8::gelu_tanh_f(x); }
__device__ __forceinline__ void unpack8(const u32x4 w, float (&v)[8]) { v[0] = bf_lo(w.x); v[1] = bf_hi(w.x); v[2] = bf_lo(w.y); v[3] = bf_hi(w.y); v[4] = bf_lo(w.z); v[5] = bf_hi(w.z); v[6] = bf_lo(w.w); v[7] = bf_hi(w.w); }
__device__ __forceinline__ void ffn_fix_phase(const Frame& F, const bf16_t* EA, const bf16_t* EB, bf16_t* U, const float* cw, const float* cb) {
    const int lane = F.lane;
    for (int it = F.gw; it < 384 * 2 * 11; it += F.NGW) {
        const int cbk = it % 11, e = (it / 11) & 1, hb = it / 22, c0 = cbk * 512 + lane * 8;
        const int row = hb * 128 + (e ? 127 : 0), s = seq_of_row(row), pos = row - seq_start(s), L = seq_len(s);
        const u32x4 z4 = (u32x4){0u, 0u, 0u, 0u};
        u32x4 rp, rc, rn, rg;
        if (e == 0) { rp = pos > 0 ? *(const u32x4*)(EA + ((size_t)(hb - 1) * 4 + 3) * DFF + c0) : z4; rc = *(const u32x4*)(EA + ((size_t)hb * 4 + 0) * DFF + c0); rn = *(const u32x4*)(EA + ((size_t)hb * 4 + 1) * DFF + c0);
                      rg = *(const u32x4*)(EB + ((size_t)hb * 2 + 0) * DFF + c0); }
        else { rp = *(const u32x4*)(EA + ((size_t)hb * 4 + 2) * DFF + c0); rc = *(const u32x4*)(EA + ((size_t)hb * 4 + 3) * DFF + c0); rn = pos < L - 1 ? *(const u32x4*)(EA + ((size_t)(hb + 1) * 4 + 0) * DFF + c0) : z4;
               rg = *(const u32x4*)(EB + ((size_t)hb * 2 + 1) * DFF + c0); }
        float prev[8], cur[8], nxt[8], gv[8], o[8];
        unpack8(rp, prev); unpack8(rc, cur); unpack8(rn, nxt); unpack8(rg, gv);
#pragma unroll
        for (int k = 0; k < 8; ++k) { const float y = cw[c0 + k] * prev[k] + cw[DFF + c0 + k] * cur[k] + cw[2 * DFF + c0 + k] * nxt[k] + cb[c0 + k]; o[k] = gelu_tanh(y) * gv[k]; }
        u32x4 w; w.x = pk2(o[0], o[1]); w.y = pk2(o[2], o[3]); w.z = pk2(o[4], o[5]); w.w = pk2(o[6], o[7]);
        *(u32x4*)(U + (size_t)row * DFF + c0) = w;
    }
}

__device__ __forceinline__ void qk_norm_rope_phase(const Frame& F, bf16_t* QKV, const float* qg, const float* kg) {
    const int lane = F.lane, l16 = lane & 15, axis = l16 >> 3, half = (l16 >> 2) & 1, sub = lane >> 4;
    float gq[8], gk[8], inv[8];
#pragma unroll
    for (int j = 0; j < 8; ++j) { gq[j] = qg[l16 * 8 + j]; gk[j] = kg[l16 * 8 + j]; const int i = (l16 & 3) * 8 + j; inv[j] = expf(-9.210340371976184f * (float)(2 * i) / 64.0f) * 0.15915494309189535f; }
    u32x4 raw[5], nxt[5];
#pragma unroll
    for (int st = 0; st < 5; ++st) { raw[st] = (u32x4){0u, 0u, 0u, 0u}; nxt[st] = (u32x4){0u, 0u, 0u, 0u}; }
    if (F.gw < T) {
#pragma unroll
        for (int st = 0; st < 5; ++st) raw[st] = *(const u32x4*)(QKV + (size_t)F.gw * 3072 + (st * 4 + sub) * 128 + l16 * 8); }
    for (int t = F.gw; t < T; t += F.NGW) {
        if (t + F.NGW < T) {
#pragma unroll
            for (int st = 0; st < 5; ++st) nxt[st] = *(const u32x4*)(QKV + (size_t)(t + F.NGW) * 3072 + (st * 4 + sub) * 128 + l16 * 8); }
        const int s = seq_of_row(t), tl = t - seq_start(s); const float pos = (float)(axis == 0 ? (tl >> 6) : (tl & 63));
        float cs[8], sn[8];
#pragma unroll
        for (int j = 0; j < 8; ++j) { const float rev = pos * inv[j]; cs[j] = __builtin_amdgcn_cosf(rev); sn[j] = __builtin_amdgcn_sinf(rev); }
#pragma unroll
        for (int st = 0; st < 5; ++st) {
            const int hh = st * 4 + sub; bf16_t* p = QKV + (size_t)t * 3072 + hh * 128 + l16 * 8;
            float v[8]; unpack8(raw[st], v);
            float ss = 0.f;
#pragma unroll
            for (int j = 0; j < 8; ++j) ss += v[j] * v[j];
            ss += __shfl_xor(ss, 1); ss += __shfl_xor(ss, 2); ss += __shfl_xor(ss, 4); ss += __shfl_xor(ss, 8);
            const float rstd = 1.0f / sqrtf(ss * (1.0f / 128.0f) + EPS);
            float o[8];
#pragma unroll
            for (int j = 0; j < 8; ++j) { const float y = v[j] * rstd * (hh < 16 ? gq[j] : gk[j]); const float pr = __shfl_xor(y, 4);
                o[j] = half == 0 ? (y * cs[j] - pr * sn[j]) : (y * cs[j] + pr * sn[j]); }
            u32x4 w; w.x = pk2(o[0], o[1]); w.y = pk2(o[2], o[3]); w.z = pk2(o[4], o[5]); w.w = pk2(o[6], o[7]);
            *(u32x4*)p = w;
        }
#pragma unroll
        for (int st = 0; st < 5; ++st) raw[st] = nxt[st];
    }
}

__device__ __forceinline__ void attn_unit(const Frame& F, const bf16_t* QKV, bf16_t* O, int s, int head, int qb) {
    const int st = seq_start(s), L = seq_len(s), kvh = head >> 2;
    const bf16_t* Qb = QKV + (size_t)(st + qb * 256) * 3072 + head * 128;
    const bf16_t* Kh = QKV + (size_t)st * 3072 + 2048 + kvh * 128;
    const bf16_t* Vh = QKV + (size_t)st * 3072 + 2560 + kvh * 128;
    bf16_t* Ob = O + (size_t)(st + qb * 256) * D + head * 128;
    __syncthreads();
    att::attn_dense_body(Qb, Kh, Vh, Ob, L, (char*)F.lds);
}
__device__ __forceinline__ void attn_phase(const Frame& F, const bf16_t* QKV, bf16_t* O) {
    const int per = F.G / 8;
    if (F.G == 256) {
        const int xg = F.vcu / per, r = F.vcu % per;
        for (int j = 0; j < 4; ++j) {
            const int kvh = xg >> 1, idx = (xg & 1) * 128 + j * 32 + r, hg = idx >> 6, qb = idx & 63;
            attn_unit(F, QKV, O, 4, kvh * 4 + hg, qb);
        }
        for (int i = 0; i < 8; ++i) {
            const int grp = xg * 2 + (i >> 2), s = grp >> 2, kvh = grp & 3, idx = (i & 3) * 32 + r, hg = idx >> 5, qb = idx & 31;
            attn_unit(F, QKV, O, s, kvh * 4 + hg, qb);
        }
    } else {
        for (int u = F.vcu; u < 64 * 16 + 4 * 32 * 16; u += F.G) {
            if (u < 1024) attn_unit(F, QKV, O, 4, u >> 6, u & 63);
            else { const int v = u - 1024; attn_unit(F, QKV, O, v >> 9, (v >> 5) & 15, v & 31); }
        }
    }
    __syncthreads();
}
namespace hy {
__device__ constexpr float TWC[16] = {1.0f, 0.98078528040323043f, 0.92387953251128674f, 0.83146961230254524f, 0.70710678118654752f, 0.55557023301960218f, 0.38268343236508977f, 0.19509032201612825f,
                                      0.0f, -0.19509032201612825f, -0.38268343236508977f, -0.55557023301960218f, -0.70710678118654752f, -0.83146961230254524f, -0.92387953251128674f, -0.98078528040323043f};
__device__ constexpr float TWS[16] = {0.0f, 0.19509032201612825f, 0.38268343236508977f, 0.55557023301960218f, 0.70710678118654752f, 0.83146961230254524f, 0.92387953251128674f, 0.98078528040323043f,
                                      1.0f, 0.98078528040323043f, 0.92387953251128674f, 0.83146961230254524f, 0.70710678118654752f, 0.55557023301960218f, 0.38268343236508977f, 0.19509032201612825f};
__device__ __forceinline__ f32x2 cmul(f32x2 a, f32x2 b) {
    f32x2 r;
    asm("v_pk_mul_f32 %0, %1, %2 op_sel:[0,0] op_sel_hi:[0,1]\n\t"
        "v_pk_fma_f32 %0, %1, %2, %0 op_sel:[1,1,0] op_sel_hi:[1,0,1] neg_lo:[1,0,0]"
        : "=&v"(r) : "v"(a), "v"(b));
    return r;
}
__device__ __forceinline__ f32x2 cmulc(f32x2 a, f32x2 b) {
    f32x2 r;
    asm("v_pk_mul_f32 %0, %1, %2 op_sel:[0,0] op_sel_hi:[0,1] neg_hi:[0,1]\n\t"
        "v_pk_fma_f32 %0, %1, %2, %0 op_sel:[1,1,0] op_sel_hi:[1,0,1]"
        : "=&v"(r) : "v"(a), "v"(b));
    return r;
}
__device__ __forceinline__ f32x2 pk_add_pm(f32x2 a, f32x2 b) { f32x2 r; asm("v_pk_add_f32 %0, %1, %2 neg_hi:[0,1]" : "=v"(r) : "v"(a), "v"(b)); return r; }
__device__ __forceinline__ f32x2 pk_add_mp(f32x2 a, f32x2 b) { f32x2 r; asm("v_pk_add_f32 %0, %1, %2 neg_lo:[0,1]" : "=v"(r) : "v"(a), "v"(b)); return r; }
__device__ __forceinline__ f32x2 pk_addc(f32x2 a, f32x2 b)   { f32x2 r; asm("v_pk_add_f32 %0, %1, %2 neg_hi:[1,1]" : "=v"(r) : "v"(a), "v"(b)); return r; }
__device__ __forceinline__ f32x2 cconj(f32x2 a) { return (f32x2){a.x, -a.y}; }
__device__ __forceinline__ f32x2 twid(float rev) {
    float c = __builtin_amdgcn_cosf(rev), s = __builtin_amdgcn_sinf(rev);
    asm volatile("s_nop 1" : "+v"(c), "+v"(s));
    return (f32x2){c, -s};
}
__device__ __forceinline__ f32x2 twid_sc(float rev) {
    float c = __builtin_amdgcn_cosf(rev), s = __builtin_amdgcn_sinf(rev);
    asm volatile("s_nop 1" : "+v"(c), "+v"(s));
    return (f32x2){s, c};
}

template <int R, bool INV> __device__ __forceinline__ void dft(f32x2 (&v)[R]) {
    if constexpr (R == 2) { const f32x2 a = v[0], b = v[1]; v[0] = a + b; v[1] = a - b; }
    else {
        constexpr int H = R / 2; f32x2 u[H], w[H];
#pragma unroll
        for (int j = 0; j < H; ++j) { const f32x2 a = v[j], b = v[j + H]; u[j] = a + b; const f32x2 t = a - b;
            const int k = j * (32 / R);
            if (j == 0) w[j] = t;
            else if (4 * j == R) w[j] = INV ? (f32x2){-t.y, t.x} : (f32x2){t.y, -t.x};
            else w[j] = INV ? (f32x2){t.x * TWC[k] - t.y * TWS[k], t.y * TWC[k] + t.x * TWS[k]} : (f32x2){t.x * TWC[k] + t.y * TWS[k], t.y * TWC[k] - t.x * TWS[k]}; }
        dft<H, INV>(u); dft<H, INV>(w);
#pragma unroll
        for (int p = 0; p < H; ++p) { v[2 * p] = u[p]; v[2 * p + 1] = w[p]; }
    }
}
__device__ __forceinline__ int PADI(int p) { return p + (p >> 5) + (p >> 9); }
__device__ __forceinline__ unsigned PADI(unsigned p) { return p + (p >> 5) + (p >> 9); }

__host__ __device__ constexpr int POFF(int x) { return x + (x >> 5) + (x >> 9); }
template <int LOGM> __host__ __device__ constexpr int ZS() { return POFF(1 << LOGM); }
template <int R> __device__ __forceinline__ void twid_powers(f32x2 w1, f32x2 (&w)[R]) {
    w[1] = w1;
#pragma unroll
    for (int p = 2; p < R; ++p) w[p] = (p & 1) ? cmul(w[p - 1], w1) : cmul(w[p >> 1], w[p >> 1]);
}
template <int LOGM, int LOGNS, int LOGR, bool INV, int NZ, bool HALF = false> __device__ __forceinline__ void fft_stage(LAS f32x2* Z, int tid) {
    asm volatile("" : "+v"(tid));
    constexpr int R = 1 << LOGR, LOGSUB = LOGNS - LOGR, SUB = 1 << LOGSUB, NBF = 1 << (LOGM - LOGR);
    constexpr float INVNS = 1.0f / (float)(1 << LOGNS);
#pragma unroll 1
    for (int bf = tid; bf < NBF; bf += NTHREADS) {
        const int j = bf & (SUB - 1), blk = bf >> LOGSUB, base = (blk << LOGNS) + j;
        LAS f32x2* Zb = Z + PADI(base);
        f32x2 v[NZ][R];
#pragma unroll
        for (int z = 0; z < NZ; ++z)
#pragma unroll
            for (int q = 0; q < R; ++q) v[z][q] = (HALF && !INV && q >= R / 2) ? (f32x2){0.f, 0.f} : Zb[z * ZS<LOGM>() + POFF(q << LOGSUB)];
        f32x2 w[R];
        if constexpr (LOGSUB > 0) { const f32x2 t = twid((float)j * INVNS); twid_powers<R>(INV ? cconj(t) : t, w); }
#pragma unroll
        for (int z = 0; z < NZ; ++z) {
            if constexpr (!INV) {
                dft<R, false>(v[z]);
                if constexpr (LOGSUB > 0) {
#pragma unroll
                    for (int p = 1; p < R; ++p) v[z][p] = cmul(v[z][p], w[p]);
                }
            } else {
                if constexpr (LOGSUB > 0) {
#pragma unroll
                    for (int p = 1; p < R; ++p) v[z][p] = cmul(v[z][p], w[p]);
                }
                dft<R, true>(v[z]);
            }
#pragma unroll
            for (int q = 0; q < R; ++q) if (!(HALF && INV && q >= R / 2)) Zb[z * ZS<LOGM>() + POFF(q << LOGSUB)] = v[z][q];
        }
    }
    __syncthreads();
}
template <int LOGM> struct Cfg;
template <> struct Cfg<13> { static constexpr int L1 = 3, L2 = 3, L3 = 3, L4 = 4; };
template <> struct Cfg<14> { static constexpr int L1 = 3, L2 = 3, L3 = 4, L4 = 4; };
template <int LOGM, int NZ, bool PADDED = false> __device__ __forceinline__ void fft_fwd(LAS f32x2* Z, int tid) {
    using C = Cfg<LOGM>;
    fft_stage<LOGM, LOGM, C::L1, false, NZ, PADDED>(Z, tid);
    fft_stage<LOGM, LOGM - C::L1, C::L2, false, NZ>(Z, tid);
    fft_stage<LOGM, LOGM - C::L1 - C::L2, C::L3, false, NZ>(Z, tid);
    fft_stage<LOGM, C::L4, C::L4, false, NZ>(Z, tid);
}
template <int LOGM, int NZ, bool PADDED = false> __device__ __forceinline__ void fft_inv(LAS f32x2* Z, int tid) {
    using C = Cfg<LOGM>;
    fft_stage<LOGM, C::L4, C::L4, true, NZ>(Z, tid);
    fft_stage<LOGM, LOGM - C::L1 - C::L2, C::L3, true, NZ>(Z, tid);
    fft_stage<LOGM, LOGM - C::L1, C::L2, true, NZ>(Z, tid);
    fft_stage<LOGM, LOGM, C::L1, true, NZ, PADDED>(Z, tid);
}
template <int LOGM> __host__ __device__ constexpr int drev(int k) {
    using C = Cfg<LOGM>;
    const int k1 = k & ((1 << C::L1) - 1), k2 = (k >> C::L1) & ((1 << C::L2) - 1), k3 = (k >> (C::L1 + C::L2)) & ((1 << C::L3) - 1), k4 = k >> (C::L1 + C::L2 + C::L3);
    return (k1 << (C::L2 + C::L3 + C::L4)) | (k2 << (C::L3 + C::L4)) | (k3 << C::L4) | k4;
}

template <int LOGM, int NZ> __device__ __forceinline__ void kernel_fft_unit(const Frame& F, float* row0, size_t rstride) {
    constexpr int M = 1 << LOGM, NC = M / 2 / NTHREADS; LAS f32x2* Z = (LAS f32x2*)F.lds; int tid = threadIdx.x; asm volatile("" : "+v"(tid));
    __syncthreads();
#pragma unroll
    for (int z = 0; z < NZ; ++z) { const float* row = row0 + z * rstride; unsigned t0 = (unsigned)tid; asm volatile("" : "+v"(t0)); f32x2 lo[NC]; float re[NC], im[NC];
#pragma unroll
      for (int c = 0; c < NC; ++c) { const unsigned n = t0 + NTHREADS * c; lo[c] = ((const f32x2*)row)[n];
          const unsigned n2 = n + M / 2;
          re[c] = (n2 == (unsigned)(M / 2)) ? 0.f : row[M + (2 * M - 2 * n2)]; im[c] = row[M + (2 * M - 2 * n2 - 1)]; }
#pragma unroll
      for (int c = 0; c < NC; ++c) { LAS f32x2* Zi = Z + PADI(t0);
          Zi[z * ZS<LOGM>() + POFF(NTHREADS * c)] = lo[c]; Zi[z * ZS<LOGM>() + POFF(NTHREADS * c + M / 2)] = (f32x2){re[c], im[c]}; } }
    __syncthreads();
    fft_fwd<LOGM, NZ>(Z, tid);
    { unsigned tk = (unsigned)tid; asm volatile("" : "+v"(tk));
      constexpr int CS = 4 / NZ, TOP = M / 512 - 1;
      const int pmAi = PADI(drev<LOGM>(512 - (int)tk));
      const LAS f32x2* Zk = Z + PADI(drev<LOGM>((int)tk));
      const LAS f32x2* ZmO = Z + pmAi;
      const LAS f32x2* ZmE = Z + ((LOGM == 14 && tk == 0u) ? pmAi - 263 : pmAi);
      const LAS f32x2* Zm0 = Z + ((tk == 0u) ? 0 : pmAi + POFF(drev<LOGM>(512 * TOP)));
      const float a0 = (float)tk * (1.0f / (float)(2 * M));
#pragma unroll
      for (int c0 = 0; c0 < NC; c0 += CS) {
          f32x2 A[4], B[4], V[4], E2[4], D2[4], P[4];
#pragma unroll
          for (int cc = 0; cc < CS; ++cc) { const int c = c0 + cc; const f32x2 v = twid_sc(a0 + (float)c * (512.0f / (float)(2 * M)));
              const LAS f32x2* Zm = (c == 0) ? Zm0 : (((c & 1) || LOGM == 13) ? ZmO : ZmE); const int dm = (c == 0) ? 0 : POFF(drev<LOGM>(512 * (TOP - c)));
#pragma unroll
              for (int z = 0; z < NZ; ++z) { const int sl = cc * NZ + z; V[sl] = v; A[sl] = Zk[z * ZS<LOGM>() + POFF(drev<LOGM>(512 * c))]; B[sl] = Zm[z * ZS<LOGM>() + dm]; } }
#pragma unroll
          for (int sl = 0; sl < 4; ++sl) E2[sl] = pk_add_pm(A[sl], B[sl]);
#pragma unroll
          for (int sl = 0; sl < 4; ++sl) D2[sl] = pk_add_mp(A[sl], B[sl]);
#pragma unroll
          for (int sl = 0; sl < 4; ++sl) P[sl] = cmul(V[sl], D2[sl]);
#pragma unroll
          for (int sl = 0; sl < 4; ++sl) A[sl] = E2[sl] - P[sl];
#pragma unroll
          for (int sl = 0; sl < 4; ++sl) B[sl] = pk_addc(E2[sl], P[sl]);
#pragma unroll
          for (int cc = 0; cc < CS; ++cc) { const unsigned k = tk + NTHREADS * (unsigned)(c0 + cc);
#pragma unroll
              for (int z = 0; z < NZ; ++z) { float* row = row0 + z * rstride; const int sl = cc * NZ + z;
                  *(f32x2*)(row + 2u * k) = A[sl]; *(f32x2*)(row + 2u * ((unsigned)M - k)) = B[sl]; } }
      }
      if (tid == 0) {
          const f32x2 v = twid_sc(0.25f);
#pragma unroll
          for (int z = 0; z < NZ; ++z) { float* row = row0 + z * rstride; const f32x2 a = Z[z * ZS<LOGM>() + PADI(drev<LOGM>(M / 2))];
              const f32x2 e2 = pk_add_pm(a, a), d2 = pk_add_mp(a, a), pp = cmul(v, d2);
              *(f32x2*)(row + M) = pk_addc(e2, pp); }
      }
    }
}

template <int LOGM, int NZ> __device__ __forceinline__ void conv_unit(const Frame& F, const bf16_t* vrow, const bf16_t* g0row, const bf16_t* g1row, size_t sstride, const float* k0row, const float* k1row,
                                                                      float skip0, float skip1, bf16_t* orow, size_t ostride) {
    constexpr int M = 1 << LOGM, NC = M / 2 / NTHREADS; LAS f32x2* Z = (LAS f32x2*)F.lds; int tid = threadIdx.x; asm volatile("" : "+v"(tid));
    float zz[NZ][2 * NC];
    __syncthreads();
#pragma unroll
    for (int z = 0; z < NZ; ++z) { unsigned t0 = (unsigned)tid; asm volatile("" : "+v"(t0)); const unsigned* vp = (const unsigned*)(vrow + z * sstride);
#pragma unroll
      for (int c = 0; c < NC; ++c) { const unsigned n = t0 + NTHREADS * c; const unsigned w = vp[n]; zz[z][2 * c] = bf_lo(w); zz[z][2 * c + 1] = bf_hi(w);
          (Z + PADI(t0))[z * ZS<LOGM>() + POFF(NTHREADS * c)] = (f32x2){zz[z][2 * c], zz[z][2 * c + 1]}; } }
    __syncthreads();
#pragma unroll
    for (int o = 0; o < 2; ++o) {
        const float* kf = o ? k1row : k0row; const bf16_t* grow = o ? g1row : g0row; const float skip = o ? skip1 : skip0;
        f32x2 Kk[NC], Km[NC]; const f32x2 Kh = ((const f32x2*)kf)[M / 2];
        { unsigned tk = (unsigned)tid; asm volatile("" : "+v"(tk));
#pragma unroll
          for (int c = 0; c < NC; ++c) { const unsigned k = tk + NTHREADS * c; Kk[c] = ((const f32x2*)kf)[k]; Km[c] = ((const f32x2*)kf)[(unsigned)M - k]; } }
        unsigned gwv[NZ][NC];
#pragma unroll
        for (int z = 0; z < NZ; ++z) { unsigned t1 = (unsigned)tid; asm volatile("" : "+v"(t1)); const unsigned* gp = (const unsigned*)(grow + z * sstride);
#pragma unroll
          for (int c = 0; c < NC; ++c) gwv[z][c] = gp[t1 + NTHREADS * c]; }
        fft_fwd<LOGM, NZ, true>(Z, tid);
        { unsigned tk = (unsigned)tid; asm volatile("" : "+v"(tk));
          constexpr int CS = 4 / NZ, TOP = M / 512 - 1;
          const int pmAi = PADI(drev<LOGM>(512 - (int)tk));
          LAS f32x2* Zk = Z + PADI(drev<LOGM>((int)tk));
          LAS f32x2* ZmO = Z + pmAi;
          LAS f32x2* ZmE = Z + ((LOGM == 14 && tk == 0u) ? pmAi - 263 : pmAi);
          LAS f32x2* Zm0 = Z + ((tk == 0u) ? 0 : pmAi + POFF(drev<LOGM>(512 * TOP)));
          const float a0 = (float)tk * (1.0f / (float)(2 * M));
#pragma unroll
          for (int c0 = 0; c0 < NC; c0 += CS) {
              f32x2 A[4], B[4], V[4], KK[4], KM[4], E[4], Dm[4], P[4], X1[4], X2[4], Yk[4], Ym[4];
#pragma unroll
              for (int cc = 0; cc < CS; ++cc) { const int c = c0 + cc; const f32x2 v = twid_sc(a0 + (float)c * (512.0f / (float)(2 * M)));
                  LAS f32x2* Zm = (c == 0) ? Zm0 : (((c & 1) || LOGM == 13) ? ZmO : ZmE); const int dm = (c == 0) ? 0 : POFF(drev<LOGM>(512 * (TOP - c)));
#pragma unroll
                  for (int z = 0; z < NZ; ++z) { const int sl = cc * NZ + z; V[sl] = v; KK[sl] = Kk[c]; KM[sl] = Km[c]; A[sl] = Zk[z * ZS<LOGM>() + POFF(drev<LOGM>(512 * c))]; B[sl] = Zm[z * ZS<LOGM>() + dm]; } }
#pragma unroll
              for (int sl = 0; sl < 4; ++sl) E[sl] = pk_add_pm(A[sl], B[sl]);
#pragma unroll
              for (int sl = 0; sl < 4; ++sl) Dm[sl] = pk_add_mp(A[sl], B[sl]);
#pragma unroll
              for (int sl = 0; sl < 4; ++sl) P[sl] = cmul(V[sl], Dm[sl]);
#pragma unroll
              for (int sl = 0; sl < 4; ++sl) X1[sl] = E[sl] - P[sl];
#pragma unroll
              for (int sl = 0; sl < 4; ++sl) X2[sl] = E[sl] + P[sl];
#pragma unroll
              for (int sl = 0; sl < 4; ++sl) Yk[sl] = cmul(X1[sl], KK[sl]);
#pragma unroll
              for (int sl = 0; sl < 4; ++sl) Ym[sl] = cmulc(X2[sl], KM[sl]);
#pragma unroll
              for (int sl = 0; sl < 4; ++sl) E[sl] = Yk[sl] + Ym[sl];
#pragma unroll
              for (int sl = 0; sl < 4; ++sl) Dm[sl] = Yk[sl] - Ym[sl];
#pragma unroll
              for (int sl = 0; sl < 4; ++sl) P[sl] = cmulc(Dm[sl], V[sl]);
#pragma unroll
              for (int sl = 0; sl < 4; ++sl) A[sl] = E[sl] - P[sl];
#pragma unroll
              for (int sl = 0; sl < 4; ++sl) B[sl] = pk_addc(E[sl], P[sl]);
#pragma unroll
              for (int cc = 0; cc < CS; ++cc) { const int c = c0 + cc;
                  LAS f32x2* Zm = (c == 0) ? Zm0 : (((c & 1) || LOGM == 13) ? ZmO : ZmE); const int dm = (c == 0) ? 0 : POFF(drev<LOGM>(512 * (TOP - c)));
#pragma unroll
                  for (int z = 0; z < NZ; ++z) { const int sl = cc * NZ + z; Zm[z * ZS<LOGM>() + dm] = B[sl]; Zk[z * ZS<LOGM>() + POFF(drev<LOGM>(512 * c))] = A[sl]; } }
          }
          if (tid == 0) {
              const f32x2 v = twid_sc(0.25f);
#pragma unroll
              for (int z = 0; z < NZ; ++z) { LAS f32x2* zp = Z + z * ZS<LOGM>() + PADI(drev<LOGM>(M / 2)); const f32x2 a = *zp;
                  const f32x2 e = pk_add_pm(a, a), dm = pk_add_mp(a, a), pp = cmul(v, dm), yk = cmul(e - pp, Kh), ym = cmulc(e + pp, Kh);
                  const f32x2 ye = yk + ym, qq = cmulc(yk - ym, v);
                  *zp = ye - qq; }
          } }
        __syncthreads();
        fft_inv<LOGM, NZ, true>(Z, tid);
        constexpr float SC = 0.125f / (float)M;
#pragma unroll
        for (int z = 0; z < NZ; ++z) { unsigned t1 = (unsigned)tid; asm volatile("" : "+v"(t1)); unsigned* op = (unsigned*)(orow + z * ostride);
#pragma unroll
          for (int c = 0; c < NC; ++c) { const unsigned n = t1 + NTHREADS * c; LAS f32x2* Zo = Z + PADI(t1) + z * ZS<LOGM>() + POFF(NTHREADS * c); const f32x2 y = *Zo; const unsigned gw = gwv[z][c];
            zz[z][2 * c] = bf_lo(gw) * (y.x * SC + zz[z][2 * c] * skip); zz[z][2 * c + 1] = bf_hi(gw) * (y.y * SC + zz[z][2 * c + 1] * skip);
            if (o == 0) *Zo = (f32x2){zz[z][2 * c], zz[z][2 * c + 1]};
            else op[n] = pk2(zz[z][2 * c], zz[z][2 * c + 1]); } }
        __syncthreads();
    }
}
}

__device__ __forceinline__ void hy_fix_phase(const Frame& F, const Args& a) {
    bf16_t* UT = (bf16_t*)(a.ws + WS_UT); const bf16_t* EU = (const bf16_t*)(a.ws + WS_EU); const float* cw = a.in[I_HCW];
    for (int it = F.gw; it < 383 * 96; it += F.NGW) {
        const int hb = it / 96, col = (it % 96) * 64 + F.lane, rl = hb * 128 + 127, s = seq_of_row(rl);
        if (seq_of_row(rl + 1) != s) continue;
        const int L = seq_len(s), tl = rl - seq_start(s);
        const float ul = bf1(EU[((size_t)hb * 2 + 1) * (3 * D) + col]), uf = bf1(EU[((size_t)(hb + 1) * 2 + 0) * (3 * D) + col]);
        bf16_t* p = UT + (size_t)seq_start(s) * (3 * D) + (size_t)col * L + tl;
        p[0] = f2bf(bf1(p[0]) + cw[2 * 3 * D + col] * uf);
        p[1] = f2bf(bf1(p[1]) + cw[col] * ul);
    }
}
__device__ __forceinline__ void hy_transpose_back_item(const Frame& F, const Args& a, int q, int item, LAS float* tile) {
    const bf16_t* ZT = (const bf16_t*)(a.ws + WS_ZT); bf16_t* ZZ = (bf16_t*)(a.ws + WS_H);
    const int lane = F.lane, cb8 = item & 7, rb = item >> 3, t0 = rb * 64, s = seq_of_row(t0), tl0 = t0 - seq_start(s), L = seq_len(s);
    const bf16_t* src = ZT + (size_t)seq_start(s) * 512 + (size_t)(cb8 * 64) * L + tl0;
    LDS_WAIT();
#pragma unroll
    for (int it = 0; it < 8; ++it) { const int ch = it * 8 + (lane >> 3), tk = (lane & 7) * 8; float v[8]; unpack8(*(const u32x4*)(src + (size_t)ch * L + tk), v);
#pragma unroll
        for (int e = 0; e < 8; ++e) tile[ch * 65 + tk + e] = v[e]; }
    LDS_WAIT();
#pragma unroll
    for (int it = 0; it < 8; ++it) { const int tk = it * 8 + (lane >> 3), c0 = (lane & 7) * 8; float v[8];
#pragma unroll
        for (int e = 0; e < 8; ++e) v[e] = tile[(c0 + e) * 65 + tk];
        u32x4 w; w.x = pk2(v[0], v[1]); w.y = pk2(v[2], v[3]); w.z = pk2(v[4], v[5]); w.w = pk2(v[6], v[7]);
        *(u32x4*)(ZZ + (size_t)(t0 + tk) * D + q * 512 + cb8 * 64 + c0) = w; }
}
__device__ __forceinline__ void hy_filter_item(const Frame& F, const Args& a, int q, int item) {
    const bf16_t* W3T = (const bf16_t*)(a.ws + WS_W3T); const bf16_t* A2 = (const bf16_t*)(a.ws + WS_A2); float* FK = (float*)(a.ws + WS_FK);
    const int lane = F.lane, r32 = lane & 31, hi = lane >> 5, cb = item & 63, tg = item >> 6, od = cb >> 4, cblk = cb & 15, o = od >> 1, dir = od & 1;
    const int wcol0 = od * D + q * 512 + cblk * 32;
    bf16x8 afr[4];
#pragma unroll
    for (int s = 0; s < 4; ++s) afr[s] = *(const bf16x8*)(W3T + (size_t)(wcol0 + r32) * 64 + 16 * s + 8 * hi);
    float delta[16];
#pragma unroll
    for (int r = 0; r < 16; ++r) { const int d = q * 512 + cblk * 32 + att::crow(r, hi); delta[r] = 3.0701134573253945f + (float)d * (12.280453829301578f / 2047.0f); }
    bf16x8 bfa[8][4];
#pragma unroll
    for (int i = 0; i < 8; ++i)
#pragma unroll
        for (int s = 0; s < 4; ++s) bfa[i][s] = *(const bf16x8*)(A2 + (size_t)((tg * 8 + i) * 32 + r32) * 64 + 16 * s + 8 * hi);
#pragma unroll
    for (int i = 0; i < 8; ++i) {
        const int tt0 = (tg * 8 + i) * 32, ls = tt0 >= LP, n = tt0 - (ls ? LP : 0) + r32, L = ls ? LS : LP;
        f32x16 acc = {};
#pragma unroll
        for (int s = 0; s < 4; ++s) acc = __builtin_amdgcn_mfma_f32_32x32x16_bf16(afr[s], bfa[i][s], acc, 0, 0, 0);
        const float tn = (float)n / (float)(L - 1);
        float* base = FK + (ls ? FK_SAMPLE_OFF : (size_t)0) + (size_t)dir * L + n;
        const size_t pitch = ls ? FK_PITCH_S : FK_PITCH_P;
#pragma unroll
        for (int r = 0; r < 16; ++r) { const int c = cblk * 32 + att::crow(r, hi);
            base[(size_t)(o * 512 + c) * pitch] = acc[r] * (__expf(-tn * delta[r]) + 0.05f); }
    }
}
__device__ __forceinline__ void hy_phase_a(const Frame& F, const Args& a, int q, bool do_back = true) {
    LAS float* tile = (LAS float*)(F.lds + F.wave * 17408);
    if (q < 4) for (int it = F.gw; it < 64 * 96; it += F.NGW) hy_filter_item(F, a, q, it);
    if (q > 0 && do_back) for (int it = F.gw; it < 768 * 8; it += F.NGW) hy_transpose_back_item(F, a, q - 1, it, tile);
}
__device__ __forceinline__ void hy_phase_c(const Frame& F, const Args& a, int q) {
    const bf16_t* UT = (const bf16_t*)(a.ws + WS_UT); float* FK = (float*)(a.ws + WS_FK); bf16_t* ZT = (bf16_t*)(a.ws + WS_ZT);
    const float* skip = a.in[I_HSKIP];
    for (int c = F.vcu; c < 512; c += F.G) {
        hy::kernel_fft_unit<14, 1>(F, FK + FK_SAMPLE_OFF + (size_t)c * FK_PITCH_S, 0);
        hy::kernel_fft_unit<14, 1>(F, FK + FK_SAMPLE_OFF + (size_t)(512 + c) * FK_PITCH_S, 0);
        hy::kernel_fft_unit<13, 2>(F, FK + (size_t)c * FK_PITCH_P, (size_t)512 * FK_PITCH_P);
        VM_WAIT(); __syncthreads();
        if (F.wave == 0) { __builtin_amdgcn_fence(__ATOMIC_ACQUIRE, "agent"); VM_WAIT(); }
        __syncthreads();
        const int d = q * 512 + c; const float s0 = skip[d], s1 = skip[D + d];
        { const bf16_t* ub = UT + (size_t)seq_start(4) * (3 * D);
          hy::conv_unit<14, 1>(F, ub + (size_t)d * LS, ub + (size_t)(D + d) * LS, ub + (size_t)(2 * D + d) * LS, 0,
                               FK + FK_SAMPLE_OFF + (size_t)c * FK_PITCH_S, FK + FK_SAMPLE_OFF + (size_t)(512 + c) * FK_PITCH_S, s0, s1, ZT + (size_t)seq_start(4) * 512 + (size_t)c * LS, 0); }
#pragma unroll 1
        for (int s = 0; s < 4; s += 2) { const bf16_t* ub = UT + (size_t)seq_start(s) * (3 * D);
          hy::conv_unit<13, 2>(F, ub + (size_t)d * LP, ub + (size_t)(D + d) * LP, ub + (size_t)(2 * D + d) * LP, (size_t)LP * (3 * D),
                               FK + (size_t)c * FK_PITCH_P, FK + (size_t)(512 + c) * FK_PITCH_P, s0, s1, ZT + (size_t)seq_start(s) * 512 + (size_t)c * LP, (size_t)LP * 512); }
    }
    __syncthreads();
}
#ifndef MK_MULTI_LAUNCH
#define MK_MULTI_LAUNCH 0
#endif
#ifndef PROBE
#define PROBE 0
#endif
#ifndef EN_MASK
#define EN_MASK 0xff
#endif
#define EN_GEMM ((EN_MASK) & 1)
#define EN_ATT  ((EN_MASK) & 2)
#define EN_HYA  ((EN_MASK) & 4)
#define EN_HYB  ((EN_MASK) & 8)
#define EN_HYC  ((EN_MASK) & 16)
#define EN_MISC ((EN_MASK) & 32)
constexpr int NPH = 41;
constexpr int CW_BAR = 4096;

__device__ __forceinline__ const float* modrow(const Args& a, int layer) { return (const float*)(a.ws + WS_MOD) + (size_t)layer * NB * 6 * D; }

__global__ void __launch_bounds__(NTHREADS, 2) fwd_kernel(Args a) {
    extern __shared__ __attribute__((aligned(16))) unsigned char lds_raw[];
    Frame F0;
    Frame& F = F0;
    F.lds = (LAS unsigned char*)lds_raw;
    F.tid = threadIdx.x; F.lane = F.tid & 63; F.wave = __builtin_amdgcn_readfirstlane(F.tid >> 6);
    F.G = gridDim.x; { const int bx = blockIdx.x; F.vcu = (F.G % 8 == 0) ? (bx % 8) * (F.G / 8) + bx / 8 : bx; }
    F.gw = F.vcu * NWAVES + F.wave; F.NGW = F.G * NWAVES;
    volatile LAS unsigned* MISC = (volatile LAS unsigned*)(F.lds + MISC_OFF);
    if (F.tid < 64) MISC[F.tid] = 0u;
    __syncthreads();
    unsigned* ctl = (unsigned*)(a.ws + WS_CTL);
    const int lo = a.ph_lo, hi = a.ph_hi;
    XcdBarrier bar; bar.bar = ctl + CW_BAR + a.li * XCD_BAR_WORDS; bar.x = 0; bar.st = MISC + 8;
    if (hi - lo > 1) bar = xcd_barrier_post(ctl + CW_BAR + a.li * XCD_BAR_WORDS, MISC + 8);
    int ph = 0;
#define PH_BEGIN if (ph >= lo && ph < hi) { Frame F = F0; { int t_ = threadIdx.x; asm volatile("" : "+v"(t_)); F.tid = t_; F.lane = t_ & 63; }
#define PH_END   if (ph + 1 < hi) { xcd_barrier(bar); if (PROBE == 9) xcd_barrier(bar); } } ++ph;

    bf16_t* const H = (bf16_t*)(a.ws + WS_H); bf16_t* const M1 = (bf16_t*)(a.ws + WS_M1);
    float* const out = a.out;
    const int bx = (int)blockIdx.x;

    bf16_t* const XB = (bf16_t*)(a.ws + WS_XB);
#define NORM_N1(layer) do { NormP p{a.in[I_XP], a.in[I_XS], nullptr, nullptr, nullptr, nullptr, nullptr, 0, nullptr, modrow(a, layer), D, 0, a.in[I_NMPRE] + (layer) * D, H}; if (EN_MISC) norm_phase(F, p); } while (0)
#define NORM_N2(layer, MPTR) do { NormP p{a.in[I_XP], a.in[I_XS], (layer) == 0 ? nullptr : XB, nullptr, XB, MPTR, modrow(a, layer), 2 * D, a.in[I_NMPOST] + (layer) * D, modrow(a, layer), 4 * D, 3 * D, a.in[I_NFPRE] + (layer) * D, H}; \
        if (EN_MISC) norm_phase(F, p); if (PROBE == 4) { NormP p2 = p; p2.xbout = (bf16_t*)(a.ws + 512 * MiB); p2.H = (bf16_t*)(a.ws + 704 * MiB); norm_phase(F, p2); } } while (0)
#define NORM_N3(layer) do { NormP p{nullptr, nullptr, XB, (layer) + 1 < NLAYER ? nullptr : out, (layer) + 1 < NLAYER ? XB : nullptr, M1, modrow(a, layer), 5 * D, a.in[I_NFPOST] + (layer) * D, modrow(a, (layer) + 1 < NLAYER ? (layer) + 1 : (layer)), D, 0, \
        a.in[I_NMPRE] + ((layer) + 1 < NLAYER ? (layer) + 1 : (layer)) * D, (layer) + 1 < NLAYER ? H : nullptr}; if (EN_MISC) norm_phase(F, p); \
        if (PROBE == 4 && (layer) + 1 < NLAYER) { NormP p2 = p; p2.xbout = (bf16_t*)(a.ws + 512 * MiB); p2.H = (bf16_t*)(a.ws + 704 * MiB); norm_phase(F, p2); } } while (0)
#define GEMM_PHASE(Aptr, Bptr, LDA, LDB, KK, AGRP, MM, NN, Optr, LDC, BIAS, SCALE) do { pg8::Gemm g{Aptr, Bptr, LDA, LDB, KK, AGRP}; pg8::StaticOrder S; S.init(MM, NN, F.G, bx); \
        pg8::EpiBf16 E{Optr, LDC, BIAS, SCALE}; for (int rep8 = 0; rep8 < ((PROBE == 8 && (KK) != DFF) ? 2 : 1); ++rep8) { if (EN_GEMM) pg8::gemm_phase<false, pg8::EpiBf16, pg8::StaticOrder>(F.lds, g, S, E); } } while (0)
#define FFN_LAYER(layer) do { \
        PH_BEGIN for (int rep = 0; rep < (PROBE == 1 ? 2 : 1); ++rep) { pg8::Gemm g{H, (const bf16_t*)(a.ws + WS_WUP), D, D, D, 0}; pg8::StaticOrder S; S.init(T, 2 * DFF, F.G, bx); \
            pg8::EpiGlu E{(bf16_t*)(a.ws + WS_U), (bf16_t*)(a.ws + WS_EA), (bf16_t*)(a.ws + WS_EB), a.in[I_FCW] + (size_t)(layer) * 3 * DFF, a.in[I_FCB] + (size_t)(layer) * DFF, DFF}; \
            if (EN_GEMM) pg8::gemm_phase<true, pg8::EpiGlu, pg8::StaticOrder>(F.lds, g, S, E); } PH_END \
        PH_BEGIN if (EN_MISC) ffn_fix_phase(F, (const bf16_t*)(a.ws + WS_EA), (const bf16_t*)(a.ws + WS_EB), (bf16_t*)(a.ws + WS_U), a.in[I_FCW] + (size_t)(layer) * 3 * DFF, a.in[I_FCB] + (size_t)(layer) * DFF); PH_END \
        PH_BEGIN for (int rep = 0; rep < (PROBE == 1 ? 2 : 1); ++rep) { GEMM_PHASE((const bf16_t*)(a.ws + WS_U), (const bf16_t*)(a.ws + WS_WDN), DFF, DFF, DFF, 0, T, D, M1, D, nullptr, nullptr); } PH_END \
        PH_BEGIN NORM_N3(layer); if ((layer) + 1 < NLAYER) { __syncthreads(); prep_ffn_weights(F, a, (layer) + 1); if (PROBE == 7) prep_ffn_weights(F, a, (layer) + 1); } PH_END \
    } while (0)
#define POOL_LAYER(layer, j) do { \
        PH_BEGIN for (int rep = 0; rep < ((PROBE == 4 || PROBE == 11) ? 2 : 1); ++rep) { if (EN_MISC) pool_phase(F, H, (bf16_t*)(a.ws + WS_P)); } PH_END \
        PH_BEGIN GEMM_PHASE((const bf16_t*)(a.ws + WS_P), (const bf16_t*)(a.ws + WS_POOLW) + (size_t)(j) * D * 512, D, 512, 512, 2, T, D, M1, D, nullptr, a.in[I_POOLS] + (j) * D); PH_END \
    } while (0)

    PH_BEGIN for (int rep = 0; rep < (PROBE == 7 ? 2 : 1); ++rep) { if (EN_MISC) prologue_phase(F, a); __syncthreads(); } PH_END

    PH_BEGIN NORM_N1(0); __syncthreads(); prep_ffn_weights(F, a, 0); if (PROBE == 7) prep_ffn_weights(F, a, 0); PH_END
    POOL_LAYER(0, 0);
    PH_BEGIN NORM_N2(0, M1); PH_END
    FFN_LAYER(0);

    PH_BEGIN { pg8::Gemm g{H, (const bf16_t*)(a.ws + WS_HYWIN), D, D, D, 0}; pg8::StaticOrder S; S.init(T, 3 * D, F.G, bx);
        pg8::EpiHyT E{(bf16_t*)(a.ws + WS_UT), (bf16_t*)(a.ws + WS_EU), a.in[I_HBIN], a.in[I_HCW], a.in[I_HCB], 3 * D};
        for (int rep8 = 0; rep8 < (PROBE == 8 ? 2 : 1); ++rep8) { if (EN_GEMM) pg8::gemm_phase<true, pg8::EpiHyT, pg8::StaticOrder>(F.lds, g, S, E); } } PH_END
    for (int q = 0; q < 4; ++q) {
        PH_BEGIN if (EN_HYA) { if (q == 0) hy_fix_phase(F, a); hy_phase_a(F, a, q); } PH_END
        PH_BEGIN if (EN_HYC) hy_phase_c(F, a, q); PH_END
    }
    PH_BEGIN if (EN_HYA) hy_phase_a(F, a, 4); PH_END
    PH_BEGIN GEMM_PHASE(H, (const bf16_t*)(a.ws + WS_HYWOUT), D, D, D, 0, T, D, (bf16_t*)(a.ws + WS_M1H), D, nullptr, nullptr); PH_END
    PH_BEGIN NORM_N2(1, (const bf16_t*)(a.ws + WS_M1H)); PH_END
    FFN_LAYER(1);

    PH_BEGIN GEMM_PHASE(H, (const bf16_t*)(a.ws + WS_ATQKV), D, D, D, 0, T, 3072, (bf16_t*)(a.ws + WS_QKV), 3072, nullptr, nullptr); PH_END
    PH_BEGIN if (EN_MISC) qk_norm_rope_phase(F, (bf16_t*)(a.ws + WS_QKV), a.in[I_AQG], a.in[I_AKG]); PH_END
    PH_BEGIN for (int rep = 0; rep < (PROBE == 2 ? 2 : 1); ++rep) { if (EN_ATT) attn_phase(F, (const bf16_t*)(a.ws + WS_QKV), (bf16_t*)(a.ws + WS_O)); } PH_END
    PH_BEGIN GEMM_PHASE((const bf16_t*)(a.ws + WS_O), (const bf16_t*)(a.ws + WS_ATWO), D, D, D, 0, T, D, M1, D, nullptr, nullptr); PH_END
    PH_BEGIN NORM_N2(2, M1); PH_END
    FFN_LAYER(2);

    POOL_LAYER(3, 1);
    PH_BEGIN NORM_N2(3, M1); PH_END
    FFN_LAYER(3);
}

__global__ void k_fail_fill(float* out, size_t n) { for (size_t i = (size_t)blockIdx.x * blockDim.x + threadIdx.x; i < n; i += (size_t)gridDim.x * blockDim.x) out[i] = __builtin_nanf(""); }

extern "C" void kernel_launch(void* const* d_in, const int* in_sizes, int n_in, void* d_out, int out_size, void* d_ws, size_t ws_size, hipStream_t stream) {
    static int grid = 0;
    if (grid == 0) {
        int dev = 0, cus = 0, per_cu = 0;
        if (n_in != 32 || out_size != T * D || ws_size < WS_END) {
            fprintf(stderr, "kernel_launch: shape/workspace mismatch: n_in %d out %d ws %zu (need %zu)\n", n_in, out_size, ws_size, (size_t)WS_END); grid = -1; }
        else if (hipGetDevice(&dev) != hipSuccess || hipDeviceGetAttribute(&cus, hipDeviceAttributeMultiprocessorCount, dev) != hipSuccess) grid = -1;
        else if (hipFuncSetAttribute((const void*)fwd_kernel, hipFuncAttributeMaxDynamicSharedMemorySize, LDS_BYTES) != hipSuccess) grid = -1;
        else {
            if (hipOccupancyMaxActiveBlocksPerMultiprocessor(&per_cu, (const void*)fwd_kernel, NTHREADS, LDS_BYTES) != hipSuccess || per_cu < 1)
                fprintf(stderr, "kernel_launch: occupancy query reports %d workgroups per CU\n", per_cu);
            (void)hipGetLastError();
            grid = cus;
        }
    }
    if (grid < 0) { hipLaunchKernelGGL(k_fail_fill, dim3(1024), dim3(256), 0, stream, (float*)d_out, (size_t)out_size); return; }
    (void)hipMemsetAsync((char*)d_ws + WS_CTL, 0, CTL_ZERO_BYTES, stream);
    Args a{};
    for (int i = 0; i < 32; ++i) a.in[i] = (const float*)d_in[i];
    a.out = (float*)d_out; a.ws = (unsigned char*)d_ws;
#if MK_MULTI_LAUNCH
    for (int k = 0; k < NPH; ++k) { a.ph_lo = k; a.ph_hi = k + 1; a.li = k; a.pad = 0;
        hipLaunchKernelGGL(fwd_kernel, dim3(grid), dim3(NTHREADS), LDS_BYTES, stream, a); }
#else
    a.ph_lo = 0; a.ph_hi = NPH; a.li = 0; a.pad = 0;
    hipLaunchKernelGGL(fwd_kernel, dim3(grid), dim3(NTHREADS), LDS_BYTES, stream, a);
#endif
    const hipError_t le = hipPeekAtLastError();
    if (le != hipSuccess) fprintf(stderr, "kernel_launch: launch failed: %s\n", hipGetErrorName(le));
}
```

```cpp
#include <hip/hip_runtime.h>
#include <cstdio>
#include <cstdint>

#define LAS __attribute__((address_space(3)))
#define GAS __attribute__((address_space(1)))
typedef unsigned short bf16_t;
typedef short bf16x8 __attribute__((ext_vector_type(8)));
typedef short s16x4 __attribute__((ext_vector_type(4)));
typedef float f32x2 __attribute__((ext_vector_type(2)));
typedef float f32x4 __attribute__((ext_vector_type(4)));
typedef float f32x16 __attribute__((ext_vector_type(16)));
typedef unsigned u32x2 __attribute__((ext_vector_type(2)));
typedef unsigned u32x4 __attribute__((ext_vector_type(4)));

constexpr int D = 2048, T = 49152, DFF = 5632, NLAYER = 4, NB = 5;
constexpr int LP = 8192, LS = 16384, TP = 32768;
constexpr float EPS = 1e-6f;
__device__ __forceinline__ int seq_of_row(int r) { return r < TP ? (r >> 13) : 4; }
__device__ __forceinline__ int seq_start(int s) { return s << 13; }
__device__ __forceinline__ int seq_len(int s) { return s < 4 ? LP : LS; }

__device__ __forceinline__ unsigned cvt_pk_bf16(float lo, float hi) { unsigned r; asm volatile("v_cvt_pk_bf16_f32 %0, %1, %2" : "=v"(r) : "v"(lo), "v"(hi)); return r; }
__device__ __forceinline__ float bf_lo(unsigned w) { return __uint_as_float(w << 16); }
__device__ __forceinline__ float bf_hi(unsigned w) { return __uint_as_float(w & 0xffff0000u); }
__device__ __forceinline__ float bf1(bf16_t h) { return __uint_as_float(((unsigned)h) << 16); }
__device__ __forceinline__ bf16_t f2bf(float f) { return (bf16_t)(cvt_pk_bf16(f, 0.f) & 0xffffu); }
__device__ __forceinline__ float wave_sum(float v) {
#pragma unroll
    for (int o = 1; o < 64; o <<= 1) v += __shfl_xor(v, o);
    return v;
}

namespace pg8 {
constexpr int BM = 256, BK = 64, HALF = 128, HTB = HALF * BK * 2, STAGE_BYTES = 8 * HTB, NXCD = 8, WGM = 8;
__host__ __device__ __forceinline__ int lds_byte(int r, int c) { const int st = (r >> 4) * 2 + (c >> 5), rr = r & 15, cc = c & 31, ob = rr * 64 + cc * 2; return st * 1024 + (ob ^ (((ob >> 9) & 1) << 5)); }
__host__ __device__ __forceinline__ void stage_rc(int b, int& R, int& C) { const int st = b / 1024, sb = b % 1024, swz = sb ^ (((sb >> 9) & 1) << 5); R = (st >> 1) * 16 + swz / 64; C = (st & 1) * 32 + (swz % 64) / 2; }
__host__ __device__ __forceinline__ int perm32(int rho) { const int n = rho >> 4, i = rho & 15; return 8 * (i >> 2) + 4 * n + (i & 3); }

struct Unit { int pm, pn; };
struct Gemm { const bf16_t* A; const bf16_t* Bt; int lda, ldb, K, agrp; };

struct StaticOrder {
    int nM, nN, nwg, G, c;
    __device__ void init(int M, int N, int G_, int c_) { nM = M / BM; nN = N / BM; nwg = nM * nN; G = G_; c = c_; }
    __device__ bool next(int i, Unit& u) const {
        const long L = (long)i * G + c; if (L >= nwg) return false;
        int wgid = (int)L; { const int q = nwg / NXCD, r = nwg % NXCD, xcd = wgid % NXCD, off = wgid / NXCD; wgid = (xcd < r ? xcd * (q + 1) : r * (q + 1) + (xcd - r) * q) + off; }
        const int nig = WGM * nN, gid = wgid / nig, fm = gid * WGM, gsz = (nM - fm) < WGM ? (nM - fm) : WGM;
        u.pm = fm + ((wgid % nig) % gsz); u.pn = (wgid % nig) / gsz; return true;
    }
};

struct EpiBf16 {
    bf16_t* O; int ldc; const float* bias; const float* scale;
    __device__ __forceinline__ void prefetch(LAS unsigned char*, const Unit&, int, int) const {}
    __device__ __forceinline__ void operator()(const f32x4 (&acc)[2][2][4][2], const Unit& u, int wr, int wc, int fr, int fq, const LAS unsigned char*) const {
        asm volatile("" ::: "memory");
        const int row0 = u.pm * BM + wr * 64 + fr, col0 = u.pn * BM + wc * 32 + 8 * fq;
        f32x4 bv[2][2], sv[2][2];
#pragma unroll
        for (int bj = 0; bj < 2; ++bj)
#pragma unroll
            for (int n = 0; n < 2; ++n) {
                bv[bj][n] = bias ? *(const f32x4*)(bias + col0 + bj * HALF + 4 * n) : (f32x4){0.f, 0.f, 0.f, 0.f};
                sv[bj][n] = scale ? *(const f32x4*)(scale + col0 + bj * HALF + 4 * n) : (f32x4){1.f, 1.f, 1.f, 1.f}; }
#pragma unroll
        for (int ai = 0; ai < 2; ++ai)
#pragma unroll
            for (int m = 0; m < 4; ++m) { bf16_t* rowp = O + (size_t)(row0 + ai * HALF + m * 16) * ldc + col0;
#pragma unroll
                for (int bj = 0; bj < 2; ++bj) { f32x4 v0 = acc[ai][bj][m][0], v1 = acc[ai][bj][m][1];
                    if (bias) { v0 += bv[bj][0]; v1 += bv[bj][1]; }
                    if (scale) { v0 *= sv[bj][0]; v1 *= sv[bj][1]; }
                    u32x4 w; w.x = cvt_pk_bf16(v0[0], v0[1]); w.y = cvt_pk_bf16(v0[2], v0[3]); w.z = cvt_pk_bf16(v1[0], v1[1]); w.w = cvt_pk_bf16(v1[2], v1[3]);
                    *(u32x4*)(rowp + bj * HALF) = w; } }
    }
};

__device__ __forceinline__ float gelu_tanh_f(float x) {
    const float arg = x * __builtin_fmaf(x * x, -0.10294323970f, -2.30220819814f);
    return x * __builtin_amdgcn_rcpf(1.0f + __builtin_amdgcn_exp2f(arg));
}
__device__ __forceinline__ f32x2 gelu_tanh_2(f32x2 x) {
    const f32x2 arg = x * __builtin_elementwise_fma(x * x, (f32x2){-0.10294323970f, -0.10294323970f}, (f32x2){-2.30220819814f, -2.30220819814f});
    const f32x2 d = (f32x2){__builtin_amdgcn_exp2f(arg.x), __builtin_amdgcn_exp2f(arg.y)} + (f32x2){1.0f, 1.0f};
    return x * (f32x2){__builtin_amdgcn_rcpf(d.x), __builtin_amdgcn_rcpf(d.y)};
}
__device__ __forceinline__ float dpp_shr1(float v) { return __int_as_float(__builtin_amdgcn_update_dpp(0, __float_as_int(v), 0x111, 0xf, 0xf, false)); }
__device__ __forceinline__ float dpp_shl1(float v) { return __int_as_float(__builtin_amdgcn_update_dpp(0, __float_as_int(v), 0x101, 0xf, 0xf, false)); }
__device__ __forceinline__ u32x4 pack8(const f32x4 a, const f32x4 b) { u32x4 w; w.x = cvt_pk_bf16(a[0], a[1]); w.y = cvt_pk_bf16(a[2], a[3]); w.z = cvt_pk_bf16(b[0], b[1]); w.w = cvt_pk_bf16(b[2], b[3]); return w; }
struct EpiGlu {
    bf16_t* U; bf16_t* EA; bf16_t* EB; const float* cw; const float* cb; int dff;
    __device__ __forceinline__ void prefetch(LAS unsigned char* wslot, const Unit& u, int wc, int lane) const {
        const int chw = u.pn * HALF + wc * 32 + (lane & 31);
        const float* g0 = (lane < 32) ? cw + chw : cw + dff + chw;
        const float* g1 = (lane < 32) ? cw + 2 * dff + chw : cb + chw;
        __builtin_amdgcn_global_load_lds((const unsigned*)g0, (LAS unsigned*)wslot, 4, 0, 0);
        __builtin_amdgcn_global_load_lds((const unsigned*)g1, (LAS unsigned*)(wslot + 256), 4, 0, 0);
    }
    __device__ __forceinline__ void operator()(const f32x4 (&acc)[2][2][4][2], const Unit& u, int wr, int wc, int fr, int fq, const LAS unsigned char* wslot) const {
        asm volatile("" ::: "memory");
        const int ch0 = u.pn * HALF + wc * 32 + 8 * fq;
        f32x4 w0[2], w1[2], w2[2], bb[2], pv[2], nx[2];
        const LAS float* wsl = (const LAS float*)wslot + 8 * fq;
#pragma unroll
        for (int n = 0; n < 2; ++n) { w0[n] = *(const LAS f32x4*)(wsl + 4 * n); w1[n] = *(const LAS f32x4*)(wsl + 32 + 4 * n); w2[n] = *(const LAS f32x4*)(wsl + 64 + 4 * n); bb[n] = *(const LAS f32x4*)(wsl + 96 + 4 * n);
#pragma unroll
            for (int j = 0; j < 4; ++j) { pv[n][j] = dpp_shr1(acc[1][0][3][n][j]); nx[n][j] = dpp_shl1(acc[0][0][0][n][j]); } }
        const size_t tok0 = (size_t)u.pm * BM + 128 * wr + 8 * fr;
#pragma unroll
        for (int k = 0; k < 8; ++k) {
            f32x4 o[2];
            {
                f32x2 y[4], yg[4], tt[4], dd[4], rr[4];
#pragma unroll
                for (int q = 0; q < 4; ++q) { const int n = q >> 1;
                    const f32x4 ap4 = (k == 0) ? pv[n] : acc[(k - 1) >> 2][0][(k - 1) & 3][n], ac4 = acc[k >> 2][0][k & 3][n], an4 = (k == 7) ? nx[n] : acc[(k + 1) >> 2][0][(k + 1) & 3][n], gt4 = acc[k >> 2][1][k & 3][n];
                    const f32x2 ap = (q & 1) ? ap4.hi : ap4.lo, ac = (q & 1) ? ac4.hi : ac4.lo, an = (q & 1) ? an4.hi : an4.lo, gt = (q & 1) ? gt4.hi : gt4.lo;
                    const f32x2 c0 = (q & 1) ? w0[n].hi : w0[n].lo, c1 = (q & 1) ? w1[n].hi : w1[n].lo, c2 = (q & 1) ? w2[n].hi : w2[n].lo, cb2 = (q & 1) ? bb[n].hi : bb[n].lo;
                    y[q] = __builtin_elementwise_fma(c2, an, __builtin_elementwise_fma(c1, ac, __builtin_elementwise_fma(c0, ap, cb2)));
                    yg[q] = y[q] * gt; }
#pragma unroll
                for (int q = 0; q < 4; ++q) tt[q] = y[q] * y[q];
#pragma unroll
                for (int q = 0; q < 4; ++q) tt[q] = __builtin_elementwise_fma(tt[q], (f32x2){-0.10294323970f, -0.10294323970f}, (f32x2){-2.30220819814f, -2.30220819814f});
#pragma unroll
                for (int q = 0; q < 4; ++q) tt[q] = y[q] * tt[q];
#pragma unroll
                for (int q = 0; q < 4; ++q) dd[q] = (f32x2){__builtin_amdgcn_exp2f(tt[q].x), __builtin_amdgcn_exp2f(tt[q].y)};
#pragma unroll
                for (int q = 0; q < 4; ++q) dd[q] = dd[q] + (f32x2){1.0f, 1.0f};
#pragma unroll
                for (int q = 0; q < 4; ++q) rr[q] = (f32x2){__builtin_amdgcn_rcpf(dd[q].x), __builtin_amdgcn_rcpf(dd[q].y)};
#pragma unroll
                for (int q = 0; q < 4; ++q) rr[q] = yg[q] * rr[q];
                o[0] = (f32x4){rr[0].x, rr[0].y, rr[1].x, rr[1].y}; o[1] = (f32x4){rr[2].x, rr[2].y, rr[3].x, rr[3].y};
            }
            const bool edge = (k == 0 && fr == 0) || (k == 7 && fr == 15);
            if (!edge) *(u32x4*)(U + (tok0 + k) * dff + ch0) = pack8(o[0], o[1]);
        }
        const size_t hb = (size_t)u.pm * 2 + wr;
        if (fr == 0) { *(u32x4*)(EA + (hb * 4 + 0) * dff + ch0) = pack8(acc[0][0][0][0], acc[0][0][0][1]); *(u32x4*)(EA + (hb * 4 + 1) * dff + ch0) = pack8(acc[0][0][1][0], acc[0][0][1][1]);
                       *(u32x4*)(EB + (hb * 2 + 0) * dff + ch0) = pack8(acc[0][1][0][0], acc[0][1][0][1]); }
        if (fr == 15) { *(u32x4*)(EA + (hb * 4 + 2) * dff + ch0) = pack8(acc[1][0][2][0], acc[1][0][2][1]); *(u32x4*)(EA + (hb * 4 + 3) * dff + ch0) = pack8(acc[1][0][3][0], acc[1][0][3][1]);
                        *(u32x4*)(EB + (hb * 2 + 1) * dff + ch0) = pack8(acc[1][1][3][0], acc[1][1][3][1]); }
    }
};

struct EpiHyT {
    bf16_t* UT; bf16_t* EU; const float* bin; const float* cw; const float* cb; int ncol;
    __device__ __forceinline__ void prefetch(LAS unsigned char* wslot, const Unit& u, int wc, int lane) const {
        const int c = u.pn * BM + (lane >> 5) * HALF + wc * 32 + (lane & 31);
        __builtin_amdgcn_global_load_lds((const unsigned*)(bin + c), (LAS unsigned*)wslot, 4, 0, 0);
        __builtin_amdgcn_global_load_lds((const unsigned*)(cw + c), (LAS unsigned*)(wslot + 256), 4, 0, 0);
        __builtin_amdgcn_global_load_lds((const unsigned*)(cw + ncol + c), (LAS unsigned*)(wslot + 512), 4, 0, 0);
        __builtin_amdgcn_global_load_lds((const unsigned*)(cw + 2 * ncol + c), (LAS unsigned*)(wslot + 768), 4, 0, 0);
        __builtin_amdgcn_global_load_lds((const unsigned*)(cb + c), (LAS unsigned*)(wslot + 1024), 4, 0, 0);
    }
    __device__ __forceinline__ void operator()(const f32x4 (&acc)[2][2][4][2], const Unit& u, int wr, int wc, int fr, int fq, const LAS unsigned char* wslot) const {
        asm volatile("" ::: "memory");
        const int row0 = u.pm * BM + 128 * wr, s = seq_of_row(row0), L = seq_len(s), tl0 = row0 - seq_start(s) + 8 * fr;
        bf16_t* base = UT + (size_t)seq_start(s) * ncol + tl0;
        const size_t hb = (size_t)u.pm * 2 + wr;
#pragma unroll
        for (int bj = 0; bj < 2; ++bj)
#pragma unroll
            for (int n = 0; n < 2; ++n) {
                const int c0 = u.pn * BM + bj * HALF + wc * 32 + 8 * fq + 4 * n;
                const LAS float* wsl = (const LAS float*)wslot + bj * 32 + 8 * fq + 4 * n;
                const f32x4 bi = *(const LAS f32x4*)wsl, w0 = *(const LAS f32x4*)(wsl + 64), w1 = *(const LAS f32x4*)(wsl + 128), w2 = *(const LAS f32x4*)(wsl + 192), bb = *(const LAS f32x4*)(wsl + 256);
                f32x4 x[8];
#pragma unroll
                for (int k = 0; k < 8; ++k) x[k] = acc[k >> 2][bj][k & 3][n] + bi;
                f32x4 pv, nx;
#pragma unroll
                for (int j = 0; j < 4; ++j) { pv[j] = dpp_shr1(x[7][j]); nx[j] = dpp_shl1(x[0][j]); }
#pragma unroll
                for (int j = 0; j < 4; ++j) {
                    float y[8];
#pragma unroll
                    for (int k = 0; k < 8; ++k) { const float ap = (k == 0) ? pv[j] : x[k - 1][j], an = (k == 7) ? nx[j] : x[k + 1][j]; y[k] = __builtin_fmaf(w2[j], an, __builtin_fmaf(w1[j], x[k][j], __builtin_fmaf(w0[j], ap, bb[j]))); }
                    u32x4 w; w.x = cvt_pk_bf16(y[0], y[1]); w.y = cvt_pk_bf16(y[2], y[3]); w.z = cvt_pk_bf16(y[4], y[5]); w.w = cvt_pk_bf16(y[6], y[7]);
                    *(u32x4*)(base + (size_t)(c0 + j) * L) = w;
                }
                if (fr == 0) { u32x2 w; w.x = cvt_pk_bf16(x[0][0], x[0][1]); w.y = cvt_pk_bf16(x[0][2], x[0][3]); *(u32x2*)(EU + (hb * 2 + 0) * ncol + c0) = w; }
                if (fr == 15) { u32x2 w; w.x = cvt_pk_bf16(x[7][0], x[7][1]); w.y = cvt_pk_bf16(x[7][2], x[7][3]); *(u32x2*)(EU + (hb * 2 + 1) * ncol + c0) = w; }
            }
    }
};

template <bool ROWPERM, class Epi, class Sched>
__device__ __forceinline__ void gemm_phase(LAS unsigned char* lds, const Gemm g, const Sched& S, const Epi& E) {
    int tid = threadIdx.x; asm volatile("" : "+v"(tid));
    const int wid = __builtin_amdgcn_readfirstlane(tid >> 6), lane = tid & 63, wr = wid >> 2, wc = wid & 3, fr = lane & 15, fq = lane >> 4;
    const int K = g.K, nt = K / BK;
    unsigned voffA[2], voffB[2];
#pragma unroll
    for (int i = 0; i < 2; ++i) { int R, C; stage_rc(tid * 16 + i * 8192, R, C); const int Rb = (R & ~31) + perm32(R & 31);
        const int Ra = ROWPERM ? (128 * (R >> 6) + 8 * (R & 15) + ((R >> 4) & 3)) : R;
        voffA[i] = (unsigned)(Ra * g.lda + C) * 2u; voffB[i] = (unsigned)(Rb * g.ldb + C) * 2u; }
    const size_t kstep = (size_t)(BK * 2);
    const size_t hstepA = (size_t)(ROWPERM ? 4 : HALF) * g.lda * 2, hstepB = (size_t)HALF * g.ldb * 2;
    const unsigned ldsw = (unsigned)wid * 1024u;
    const int aoff = lds_byte(wr * 64 + fr, fq * 8), boff = lds_byte(wc * 32 + fr, fq * 8);
#define PG8_SA(b, h) (((b) * 2 + (h)) * HTB)
#define PG8_SB(b, h) ((4 + (b) * 2 + (h)) * HTB)
#define PG8_STAGE(bufoff, gbase, voff) do { _Pragma("unroll") for (int _i = 0; _i < 2; ++_i) \
        __builtin_amdgcn_global_load_lds((const unsigned*)((const char*)(gbase) + (voff)[_i]), (LAS unsigned*)(lds + (bufoff) + ldsw + _i * 8192), 16, 0, 0); } while (0)
#define PG8_LDA(dst, b, h) do { _Pragma("unroll") for (int m = 0; m < 4; ++m) _Pragma("unroll") for (int k = 0; k < 2; ++k) dst[m][k] = *(const LAS bf16x8*)(lds + PG8_SA(b, h) + aoff + m * 2048 + k * 1024); } while (0)
#define PG8_LDB(dst, b, h) do { _Pragma("unroll") for (int n = 0; n < 2; ++n) _Pragma("unroll") for (int k = 0; k < 2; ++k) dst[n][k] = *(const LAS bf16x8*)(lds + PG8_SB(b, h) + boff + n * 2048 + k * 1024); } while (0)
#define PG8_MMA(ai, bj, At, Bt) do { __builtin_amdgcn_s_setprio(1); _Pragma("unroll") for (int m = 0; m < 4; ++m) _Pragma("unroll") for (int n = 0; n < 2; ++n) _Pragma("unroll") for (int k = 0; k < 2; ++k) \
        acc[ai][bj][m][n] = __builtin_amdgcn_mfma_f32_16x16x32_bf16(Bt[n][k], At[m][k], acc[ai][bj][m][n], 0, 0, 0); __builtin_amdgcn_s_setprio(0); } while (0)
#define PG8_WAIT_V(n) asm volatile("s_waitcnt vmcnt(" #n ")" ::: "memory")
#define PG8_WAIT_L(n) asm volatile("s_waitcnt lgkmcnt(" #n ")" ::: "memory")
#define PG8_BAR __builtin_amdgcn_s_barrier()
#define PG8_SCHED __builtin_amdgcn_sched_barrier(0)
#define PG8_ABASE(u) ((const char*)g.A + ((size_t)(u).pm * BM * g.lda + (g.agrp ? (size_t)((u).pn / g.agrp) * K : (size_t)0)) * 2)
#define PG8_BBASE(u) ((const char*)g.Bt + (size_t)(u).pn * BM * g.ldb * 2)
    Unit cur, nxt; int ui = 0;
    if (!S.next(0, cur)) return;
    f32x4 acc[2][2][4][2];
#pragma unroll
    for (int a = 0; a < 2; ++a)
#pragma unroll
        for (int b = 0; b < 2; ++b)
#pragma unroll
            for (int m = 0; m < 4; ++m)
#pragma unroll
                for (int n = 0; n < 2; ++n) acc[a][b][m][n] = (f32x4){0.f, 0.f, 0.f, 0.f};
    bf16x8 At[4][2], B0[2][2], B1[2][2];
    const char* cA = PG8_ABASE(cur); const char* cB = PG8_BBASE(cur);
    PG8_STAGE(PG8_SB(0, 0), cB, voffB); PG8_STAGE(PG8_SA(0, 0), cA, voffA); PG8_STAGE(PG8_SB(0, 1), cB + hstepB, voffB); PG8_STAGE(PG8_SA(0, 1), cA + hstepA, voffA);
    if (wr == 1) PG8_BAR;
    PG8_WAIT_V(4); PG8_BAR;
    PG8_STAGE(PG8_SB(1, 0), cB + kstep, voffB); PG8_STAGE(PG8_SA(1, 0), cA + kstep, voffA); PG8_STAGE(PG8_SB(1, 1), cB + hstepB + kstep, voffB);
    PG8_WAIT_V(6); PG8_BAR;
    LAS unsigned char* const wslot = lds + STAGE_BYTES + wid * 1536;
    for (;;) {
        E.prefetch(wslot, cur, wc, lane);
        const bool has_next = S.next(ui + 1, nxt);
        const char* nA = has_next ? PG8_ABASE(nxt) : cA; const char* nB = has_next ? PG8_BBASE(nxt) : cB;
        for (int t = 0; t < nt; t += 2) {
            const bool last = (t == nt - 2);
            const char* a1 = cA + (size_t)(t + 1) * kstep;
            const char* a2 = last ? nA : cA + (size_t)(t + 2) * kstep; const char* b2 = last ? nB : cB + (size_t)(t + 2) * kstep;
            const char* a3 = a2 + kstep; const char* b3 = b2 + kstep;
            PG8_LDB(B0, 0, 0); PG8_SCHED; PG8_LDA(At, 0, 0); PG8_STAGE(PG8_SA(1, 1), a1 + hstepA, voffA);
            PG8_WAIT_L(8); PG8_BAR; PG8_WAIT_L(0); PG8_MMA(0, 0, At, B0); PG8_BAR; PG8_SCHED;
            PG8_LDB(B1, 0, 1); PG8_STAGE(PG8_SB(0, 0), b2, voffB);
            PG8_BAR; PG8_WAIT_L(0); PG8_MMA(0, 1, At, B1); PG8_BAR;
            PG8_LDA(At, 0, 1); PG8_STAGE(PG8_SA(0, 0), a2, voffA);
            PG8_BAR; PG8_WAIT_L(0); PG8_MMA(1, 0, At, B0); PG8_BAR; PG8_SCHED;
            PG8_STAGE(PG8_SB(0, 1), b2 + hstepB, voffB);
            PG8_WAIT_V(6); PG8_BAR; PG8_MMA(1, 1, At, B1); PG8_BAR;
            PG8_LDB(B0, 1, 0); PG8_SCHED; PG8_LDA(At, 1, 0); PG8_STAGE(PG8_SA(0, 1), a2 + hstepA, voffA);
            PG8_WAIT_L(8); PG8_BAR; PG8_WAIT_L(0); PG8_MMA(0, 0, At, B0); PG8_BAR; PG8_SCHED;
            PG8_LDB(B1, 1, 1); PG8_STAGE(PG8_SB(1, 0), b3, voffB);
            PG8_BAR; PG8_WAIT_L(0); PG8_MMA(0, 1, At, B1); PG8_BAR;
            PG8_LDA(At, 1, 1); PG8_STAGE(PG8_SA(1, 0), a3, voffA);
            PG8_BAR; PG8_WAIT_L(0); PG8_MMA(1, 0, At, B0); PG8_BAR; PG8_SCHED;
            PG8_STAGE(PG8_SB(1, 1), b3 + hstepB, voffB);
            PG8_WAIT_V(6); PG8_BAR; PG8_MMA(1, 1, At, B1); PG8_BAR;
        }
        E(acc, cur, wr, wc, fr, fq, wslot);
        if (!has_next) break;
#pragma unroll
        for (int a = 0; a < 2; ++a)
#pragma unroll
            for (int b = 0; b < 2; ++b)
#pragma unroll
                for (int m = 0; m < 4; ++m)
#pragma unroll
                    for (int n = 0; n < 2; ++n) acc[a][b][m][n] = (f32x4){0.f, 0.f, 0.f, 0.f};
        cur = nxt; cA = nA; cB = nB; ++ui;
    }
    PG8_WAIT_V(0);
    if (wr == 0) PG8_BAR;
    PG8_BAR;
#undef PG8_SA
#undef PG8_SB
#undef PG8_STAGE
#undef PG8_LDA
#undef PG8_LDB
#undef PG8_MMA
#undef PG8_WAIT_V
#undef PG8_WAIT_L
#undef PG8_BAR
#undef PG8_SCHED
#undef PG8_ABASE
#undef PG8_BBASE
}
}
namespace att {
constexpr int HD = 128, NW = 8, QBLK = 32, KVBLK = 64;
constexpr float SCALE = 0.088388347648318440f;
constexpr float THR = 8.f;
constexpr int LDQ = 3072, LDK = 3072, LDO = 2048;
constexpr int SHM_V = KVBLK * HD * 2, SHM_K = KVBLK * HD * 2, SHM_ATTN = 2 * SHM_V + 2 * SHM_K + NW * 64 * 4;
#define KSWZ(row, colB) ((row) * 256 + ((colB) ^ (((row) & 7) << 4)))
#define SBAR() __builtin_amdgcn_sched_barrier(0)
__device__ __forceinline__ int crow(int r, int hi) { return (r & 3) + 8 * (r >> 2) + 4 * hi; }

__device__ __forceinline__ void partialSM(f32x16& p0, f32x16& p1, float& m_reg, float& mn, float& alpha) {
  constexpr float C = SCALE * 1.4426950408889634f;
  float pmax = p0[0];
#pragma unroll
  for (int r = 1; r < 16; ++r) pmax = fmaxf(pmax, p0[r]);
#pragma unroll
  for (int r = 0; r < 16; ++r) pmax = fmaxf(pmax, p1[r]);
  { auto rr = __builtin_amdgcn_permlane32_swap(__float_as_uint(pmax), __float_as_uint(pmax), false, false);
    pmax = fmaxf(__uint_as_float(rr[0]), __uint_as_float(rr[1])); }
  if (__builtin_expect(__all(pmax - m_reg <= THR / SCALE), 1)) { mn = m_reg; alpha = 1.f; }
  else { mn = fmaxf(m_reg, pmax); alpha = __builtin_amdgcn_exp2f((m_reg - mn) * C); m_reg = mn; }
  float mnC = -mn * C;
#pragma unroll
  for (int r = 0; r < 16; ++r) p0[r] = fmaf(p0[r], C, mnC);
#pragma unroll
  for (int r = 0; r < 16; ++r) p1[r] = fmaf(p1[r], C, mnC);
#pragma unroll
  for (int r = 0; r < 16; ++r) p0[r] = __builtin_amdgcn_exp2f(p0[r]);
}
__device__ __forceinline__ void finishSM(f32x16& p0, f32x16& p1, float alpha, float& l_reg, bf16x8& pa0, bf16x8& pa1, bf16x8& pa2, bf16x8& pa3) {
#pragma unroll
  for (int r = 0; r < 16; ++r) p1[r] = __builtin_amdgcn_exp2f(p1[r]);
  float ps = 0;
#pragma unroll
  for (int r = 0; r < 16; ++r) ps += p0[r];
#pragma unroll
  for (int r = 0; r < 16; ++r) ps += p1[r];
  { auto rr = __builtin_amdgcn_permlane32_swap(__float_as_uint(ps), __float_as_uint(ps), false, false);
    ps = __uint_as_float(rr[0]) + __uint_as_float(rr[1]); }
  l_reg = l_reg * alpha + ps;
#define PK4(P, BASE, OUT) do { unsigned a0 = cvt_pk_bf16(P[BASE + 0], P[BASE + 1]), a1 = cvt_pk_bf16(P[BASE + 2], P[BASE + 3]);   \
    unsigned b0 = cvt_pk_bf16(P[BASE + 4], P[BASE + 5]), b1 = cvt_pk_bf16(P[BASE + 6], P[BASE + 7]);                              \
    auto r0 = __builtin_amdgcn_permlane32_swap(a0, b0, false, false); auto r1 = __builtin_amdgcn_permlane32_swap(a1, b1, false, false); \
    u32x4 w = {r0[0], r1[0], r0[1], r1[1]}; OUT = *reinterpret_cast<bf16x8*>(&w); } while (0)
  PK4(p0, 0, pa0); PK4(p0, 8, pa1); PK4(p1, 0, pa2); PK4(p1, 8, pa3);
#undef PK4
}
__device__ __forceinline__ void qkt(f32x16& p0, f32x16& p1, const bf16_t* Ks, const bf16x8* qr, int r32, int hi) {
  p0 = f32x16{}; p1 = f32x16{};
#pragma unroll
  for (int d0 = 0; d0 < 8; ++d0) { int cb = (d0 * 16 + hi * 8) * 2;
    bf16x8 b0 = *reinterpret_cast<const bf16x8*>((const char*)Ks + KSWZ(r32, cb));
    bf16x8 b1 = *reinterpret_cast<const bf16x8*>((const char*)Ks + KSWZ(32 + r32, cb));
    p0 = __builtin_amdgcn_mfma_f32_32x32x16_bf16(b0, qr[d0], p0, 0, 0, 0);
    p1 = __builtin_amdgcn_mfma_f32_32x32x16_bf16(b1, qr[d0], p1, 0, 0, 0); }
}
__device__ __forceinline__ int v_st(int k, int c) { const int kk = (k & ~0xC) | ((k & 4) << 1) | ((k & 8) >> 1); return ((kk >> 3) * 4 + (c >> 5)) * 512 + ((kk & 7) * 32 + (c & 31)) * 2; }
__device__ __forceinline__ int v_rd_base(int lane) { return ((lane & 3) << 3) | (((lane >> 2) & 3) << 6) | (((lane >> 4) & 1) << 5) | (((lane >> 5) & 1) << 8); }
constexpr int v_rd_off(int d0, int ks, int half) { return d0 * 512 + ks * 4096 + half * 2048; }
template <int OFF> __device__ __forceinline__ s16x4 tr_read(int vb) {
  s16x4 r; asm volatile("ds_read_b64_tr_b16 %0, %1 offset:%2" : "=&v"(r) : "v"(vb), "i"(OFF) : "memory"); return r;
}
template <int D0> __device__ __forceinline__ void pv_one(f32x16& od, int vb, bf16x8 pa0, bf16x8 pa1, bf16x8 pa2, bf16x8 pa3) {
  const s16x4 l0 = tr_read<v_rd_off(D0, 0, 0)>(vb), h0 = tr_read<v_rd_off(D0, 0, 1)>(vb), l1 = tr_read<v_rd_off(D0, 1, 0)>(vb), h1 = tr_read<v_rd_off(D0, 1, 1)>(vb);
  const s16x4 l2 = tr_read<v_rd_off(D0, 2, 0)>(vb), h2 = tr_read<v_rd_off(D0, 2, 1)>(vb), l3 = tr_read<v_rd_off(D0, 3, 0)>(vb), h3 = tr_read<v_rd_off(D0, 3, 1)>(vb);
  asm volatile("s_waitcnt lgkmcnt(0)" ::: "memory"); SBAR();
#define PK(L, H) (bf16x8){L[0], L[1], L[2], L[3], H[0], H[1], H[2], H[3]}
  od = __builtin_amdgcn_mfma_f32_32x32x16_bf16(PK(l0, h0), pa0, od, 0, 0, 0);
  od = __builtin_amdgcn_mfma_f32_32x32x16_bf16(PK(l1, h1), pa1, od, 0, 0, 0);
  od = __builtin_amdgcn_mfma_f32_32x32x16_bf16(PK(l2, h2), pa2, od, 0, 0, 0);
  od = __builtin_amdgcn_mfma_f32_32x32x16_bf16(PK(l3, h3), pa3, od, 0, 0, 0);
#undef PK
}
__device__ __forceinline__ void pv_d0(f32x16* o, int vb, bf16x8 pa0, bf16x8 pa1, bf16x8 pa2, bf16x8 pa3) {
  pv_one<0>(o[0], vb, pa0, pa1, pa2, pa3); pv_one<1>(o[1], vb, pa0, pa1, pa2, pa3); pv_one<2>(o[2], vb, pa0, pa1, pa2, pa3); pv_one<3>(o[3], vb, pa0, pa1, pa2, pa3);
}

__device__ __forceinline__ void attn_dense_body(const bf16_t* __restrict__ Qb, const bf16_t* __restrict__ Kh, const bf16_t* __restrict__ Vh,
                                                bf16_t* __restrict__ Ob, int seq, char* lds) {
  int tid = threadIdx.x; asm volatile("" : "+v"(tid));
  const int wid = tid >> 6, lane = tid & 63, r32 = lane & 31, hi = lane >> 5;
  bf16_t* V_lds = (bf16_t*)lds; bf16_t* K_lds = (bf16_t*)(lds + 2 * SHM_V);
  float* ws = (float*)(lds + 2 * SHM_V + 2 * SHM_K) + wid * 64; float* li_l = ws; float* al_l = ws + 32;
  float m_reg = -1e30f, l_reg = 0; f32x16 o[4] = {}; bf16x8 qr[8];
  const bf16_t* Qw = Qb + (long)(wid * QBLK + r32) * LDQ + hi * 8;
#pragma unroll
  for (int d0 = 0; d0 < 8; ++d0) qr[d0] = *reinterpret_cast<const bf16x8*>(Qw + d0 * 16);
  const int sr = tid >> 4, sc = (tid & 15) * 8, vst0 = v_st(sr, sc), vst1 = v_st(32 + sr, sc);
  const int vb0 = (int)(uintptr_t)V_lds + v_rd_base(lane);
  struct { bf16x8 vs0, vs1, ks0, ks1; } sr_[2];
#define SLOAD(i, k0) do { sr_[i].vs0 = *reinterpret_cast<const bf16x8*>(&Vh[(long)((k0) + sr) * LDK + sc]); sr_[i].vs1 = *reinterpret_cast<const bf16x8*>(&Vh[(long)((k0) + 32 + sr) * LDK + sc]); \
    sr_[i].ks0 = *reinterpret_cast<const bf16x8*>(&Kh[(long)((k0) + sr) * LDK + sc]); sr_[i].ks1 = *reinterpret_cast<const bf16x8*>(&Kh[(long)((k0) + 32 + sr) * LDK + sc]); } while (0)
#define SWRITE(b, i) do { *(bf16x8*)((char*)V_lds + (b) * SHM_V + vst0) = sr_[i].vs0;          \
    *(bf16x8*)((char*)V_lds + (b) * SHM_V + vst1) = sr_[i].vs1; int kc = sc * 2;               \
    *(bf16x8*)((char*)K_lds + (b) * SHM_K + KSWZ(sr, kc)) = sr_[i].ks0;                       \
    *(bf16x8*)((char*)K_lds + (b) * SHM_K + KSWZ(32 + sr, kc)) = sr_[i].ks1; } while (0)
#define SWAIT() asm volatile("s_waitcnt vmcnt(4)" ::: "memory")
#define RESC(a) do { if (__any((a) < 1.f)) { const float _al = (a); \
    _Pragma("unroll") for (int d = 0; d < 4; ++d) _Pragma("unroll") for (int r = 0; r < 16; ++r) o[d][r] *= _al; } } while (0)
  f32x16 pA0, pA1, pB0, pB1; float mnA, mnB, alA, alB; bf16x8 pa0, pa1, pa2, pa3; const int NT = seq / KVBLK;
  constexpr int SE = 0, SO = 1;
  SLOAD(SE, 0); asm volatile("s_waitcnt vmcnt(0)" ::: "memory"); SWRITE(0, SE); __syncthreads();
  qkt(pA0, pA1, K_lds, qr, r32, hi); partialSM(pA0, pA1, m_reg, mnA, alA);
  SLOAD(SO, KVBLK); if (2 < NT) SLOAD(SE, 2 * KVBLK);
  SWAIT(); SWRITE(1, SO); __syncthreads();
  for (int j = 1; j + 1 < NT; j += 2) {
    SBAR(); qkt(pB0, pB1, (bf16_t*)((char*)K_lds + SHM_K), qr, r32, hi);
    finishSM(pA0, pA1, alA, l_reg, pa0, pa1, pa2, pa3); SBAR();
    SLOAD(SO, (j + 2) * KVBLK); SBAR();
    pv_d0(o, vb0, pa0, pa1, pa2, pa3); partialSM(pB0, pB1, m_reg, mnB, alB);
    __syncthreads(); SWAIT(); SWRITE(0, SE);
    RESC(alB); __syncthreads();
    SBAR(); qkt(pA0, pA1, K_lds, qr, r32, hi);
    finishSM(pB0, pB1, alB, l_reg, pa0, pa1, pa2, pa3); SBAR();
    if (j + 3 < NT) SLOAD(SE, (j + 3) * KVBLK); SBAR();
    pv_d0(o, vb0 + (int)SHM_V, pa0, pa1, pa2, pa3); partialSM(pA0, pA1, m_reg, mnA, alA);
    __syncthreads(); SWAIT(); SWRITE(1, SO);
    RESC(alA); __syncthreads();
  }
  SBAR(); qkt(pB0, pB1, (bf16_t*)((char*)K_lds + SHM_K), qr, r32, hi);
  finishSM(pA0, pA1, alA, l_reg, pa0, pa1, pa2, pa3); SBAR();
  pv_d0(o, vb0, pa0, pa1, pa2, pa3); partialSM(pB0, pB1, m_reg, mnB, alB);
  __syncthreads(); RESC(alB);
  finishSM(pB0, pB1, alB, l_reg, pa0, pa1, pa2, pa3); SBAR();
  pv_d0(o, vb0 + (int)SHM_V, pa0, pa1, pa2, pa3);
  const float rl = __builtin_amdgcn_rcpf(l_reg);
  bf16_t* Ow = Ob + (long)(wid * QBLK + r32) * LDO + hi * 8;
#pragma unroll
  for (int d0 = 0; d0 < 4; ++d0)
#pragma unroll
    for (int g = 0; g < 4; g += 2) {
      unsigned ax = cvt_pk_bf16(o[d0][4 * g + 0] * rl, o[d0][4 * g + 1] * rl), ay = cvt_pk_bf16(o[d0][4 * g + 2] * rl, o[d0][4 * g + 3] * rl);
      unsigned bx = cvt_pk_bf16(o[d0][4 * g + 4] * rl, o[d0][4 * g + 5] * rl), by = cvt_pk_bf16(o[d0][4 * g + 6] * rl, o[d0][4 * g + 7] * rl);
      { auto r0 = __builtin_amdgcn_permlane32_swap(ax, bx, false, false); ax = r0[0]; bx = r0[1]; }
      { auto r1 = __builtin_amdgcn_permlane32_swap(ay, by, false, false); ay = r1[0]; by = r1[1]; }
      u32x4 w = {ax, ay, bx, by};
      *reinterpret_cast<u32x4*>(Ow + d0 * 32 + 8 * g) = w;
    }
#undef SLOAD
#undef SWRITE
#undef SWAIT
#undef RESC
}
#undef KSWZ
#undef SBAR
}
#define XB_TMO      128
#define XB_XCNT(j)  (256  + 64 * (j))
#define XB_XSUB(j)  (1280 + 64 * (j))
#define XB_XGEN(j)  (2304 + 64 * (j))
#define XB_TOP      3328
#define XB_TOPGEN   3392
#define XCD_BAR_WORDS 3456
#define XB_SPIN_CAP (1u << 22)

__device__ __forceinline__ unsigned xb_ld(unsigned* p)              { return __hip_atomic_load(p, __ATOMIC_RELAXED, __HIP_MEMORY_SCOPE_AGENT); }
__device__ __forceinline__ unsigned xb_add(unsigned* p, unsigned v) { return __hip_atomic_fetch_add(p, v, __ATOMIC_RELAXED, __HIP_MEMORY_SCOPE_AGENT); }
__device__ __forceinline__ unsigned xb_xcc_id() { return (unsigned)__builtin_amdgcn_s_getreg((3 << 11) | 20) & 0xFu; }
#define XB_SPIN(cond, bar) do { unsigned _sp = 0; while (cond) { __builtin_amdgcn_s_sleep(1); \
    if ((++_sp & 255u) == 0u) { if (xb_ld(&(bar)[XB_TMO])) break; if (_sp > XB_SPIN_CAP) { atomicAdd(&(bar)[XB_TMO], 1u); break; } } } } while (0)

struct XcdBarrier { unsigned* bar; unsigned x; volatile LAS unsigned* st; };

__device__ __forceinline__ XcdBarrier xcd_barrier_post(unsigned* bar, volatile LAS unsigned* st) {
    XcdBarrier b; b.bar = bar; b.x = xb_xcc_id(); b.st = st;
    if (threadIdx.x == 0) (void)xb_add(&bar[XB_XCNT(b.x)], 1u);
    return b;
}
__device__ __forceinline__ void xcd_barrier_complete(unsigned* bar, unsigned x, unsigned& nloc, unsigned& nx) {
    const unsigned G = gridDim.x * gridDim.y * gridDim.z;
    unsigned sum, cnt, mine, sp = 0u;
    for (;;) {
        sum = 0u; cnt = 0u; mine = 0u;
#pragma unroll
        for (unsigned j = 0; j < 16; ++j) { const unsigned c = xb_ld(&bar[XB_XCNT(j)]); sum += c; cnt += (c > 0u) ? 1u : 0u; mine = (j == x) ? c : mine; }
        if (sum == G) break;
        __builtin_amdgcn_s_sleep(1);
        if ((++sp & 255u) == 0u) { if (xb_ld(&bar[XB_TMO])) break; if (sp > XB_SPIN_CAP) { atomicAdd(&bar[XB_TMO], 1u); break; } }
    }
    nloc = mine > 0u ? mine : 1u; nx = cnt > 0u ? cnt : 1u;
}
__device__ __forceinline__ void xcd_barrier(const XcdBarrier& b) {
    asm volatile("s_waitcnt vmcnt(0)" ::: "memory");
    __syncthreads();
    if (threadIdx.x == 0) {
        unsigned* bar = b.bar;
        __builtin_amdgcn_s_waitcnt(0);
        unsigned nloc = b.st[0], nx = b.st[1];
        if (nloc == 0u) { xcd_barrier_complete(bar, b.x, nloc, nx); b.st[0] = nloc; b.st[1] = nx; }
        const unsigned old = xb_add(&bar[XB_XSUB(b.x)], 1u);
        const unsigned gen = old / nloc;
        if (old + 1u == (gen + 1u) * nloc) {
            __builtin_amdgcn_fence(__ATOMIC_RELEASE, "agent");
            asm volatile("s_waitcnt vmcnt(0)" ::: "memory");
            const unsigned og = xb_add(&bar[XB_TOP], 1u);
            const unsigned tg = og / nx;
            if (og + 1u == (tg + 1u) * nx) xb_add(&bar[XB_TOPGEN], 1u);
            else XB_SPIN(xb_ld(&bar[XB_TOPGEN]) == tg, bar);
            __builtin_amdgcn_fence(__ATOMIC_ACQUIRE, "agent");
            xb_add(&bar[XB_XGEN(b.x)], 1u);
            asm volatile("s_waitcnt vmcnt(0)" ::: "memory");
        } else {
            XB_SPIN(xb_ld(&bar[XB_XGEN(b.x)]) == gen, bar);
            __builtin_amdgcn_fence(__ATOMIC_ACQUIRE, "agent");
            asm volatile("s_waitcnt vmcnt(0)" ::: "memory");
        }
    }
    __syncthreads();
}
#define LDS_WAIT() asm volatile("s_waitcnt lgkmcnt(0)" ::: "memory")
#define VM_WAIT() asm volatile("s_waitcnt vmcnt(0)" ::: "memory")
constexpr int NWAVES = 8, NTHREADS = 512;
constexpr int LDS_BYTES = 147456;
constexpr int MISC_OFF = 140 * 1024;

struct Args { const float* in[32]; float* out; unsigned char* ws; int ph_lo, ph_hi, li, pad; };
struct Frame { LAS unsigned char* lds; int tid, lane, wave, vcu, G, gw, NGW; };

enum { I_XP = 0, I_XS, I_CP, I_CS, I_MODW, I_MODB, I_NMPRE, I_NMPOST, I_NFPRE, I_NFPOST, I_FUP, I_FCW, I_FCB, I_FDN, I_POOLW, I_POOLS,
       I_HWIN, I_HBIN, I_HCW, I_HCB, I_HFW1, I_HFB1, I_HFW2, I_HFB2, I_HFW3, I_HFREQ, I_HSKIP, I_HWOUT, I_AQKV, I_AQG, I_AKG, I_AWO };

constexpr size_t MiB = 1u << 20;
constexpr size_t WS_CTL = 0, CTL_ZERO_BYTES = 1 * MiB;
constexpr size_t WS_MOD = 1 * MiB;
constexpr size_t WS_A2 = 2 * MiB;
constexpr size_t WS_W3T = 5 * MiB;
constexpr size_t WS_POOLW = 6 * MiB;
constexpr size_t WS_HYWIN = 10 * MiB;
constexpr size_t WS_HYWOUT = 34 * MiB;
constexpr size_t WS_ATQKV = 42 * MiB;
constexpr size_t WS_ATWO = 54 * MiB;
constexpr size_t WS_WUP = 62 * MiB;
constexpr size_t WS_WDN = 106 * MiB;
constexpr size_t WS_H = 128 * MiB;
constexpr size_t WS_M1 = 320 * MiB;
constexpr size_t WS_BIG = 512 * MiB;
constexpr size_t WS_U = WS_BIG, WS_EA = WS_BIG + 528 * MiB, WS_EB = WS_BIG + 548 * MiB;
constexpr size_t WS_QKV = WS_BIG, WS_O = WS_BIG + 288 * MiB;
constexpr size_t WS_P = WS_BIG;
constexpr size_t WS_UT = 320 * MiB;
constexpr size_t WS_EU = 896 * MiB;
constexpr size_t WS_FK = 906 * MiB;
constexpr size_t WS_ZT = 1099 * MiB;
constexpr size_t WS_M1H = WS_M1;
constexpr size_t WS_XB = 1147 * MiB;
constexpr size_t WS_END = 1339 * MiB;
constexpr int FK_PITCH_P = 2 * LP + 32, FK_PITCH_S = 2 * LS + 32;
constexpr size_t FK_SAMPLE_OFF = (size_t)2 * 512 * FK_PITCH_P;

__device__ __forceinline__ unsigned pk2(float lo, float hi) { return cvt_pk_bf16(lo, hi); }
template <bool GLUMAP = false>
__device__ __forceinline__ void transpose_item(const float* W, int N, bf16_t* WT, int ldk, LAS float* scr, int item, int lane) {
    const int nblk = N / 32, kb = item / nblk, nb = item % nblk, k0 = 64 * kb, n0 = 32 * nb;
    const int d0 = GLUMAP ? (((n0 % DFF) / 128) * 256 + (n0 / DFF) * 128 + (n0 % 128)) : n0;
    { f32x4 v[8]; const int kr = lane >> 3, ch = (lane & 7) * 4;
#pragma unroll
      for (int i = 0; i < 8; ++i) v[i] = *(const f32x4*)(W + (size_t)(k0 + kr + 8 * i) * N + n0 + ch);
#pragma unroll
      for (int i = 0; i < 8; ++i) { LAS float* d = scr + (kr + 8 * i) * 33 + ch; d[0] = v[i].x; d[1] = v[i].y; d[2] = v[i].z; d[3] = v[i].w; } }
    LDS_WAIT();
    const int c = lane & 7;
#pragma unroll
    for (int j = 0; j < 4; ++j) { const int n = (lane >> 3) + 8 * j; const LAS float* s = scr + (8 * c) * 33 + n;
        u32x4 o; o.x = pk2(s[0 * 33], s[1 * 33]); o.y = pk2(s[2 * 33], s[3 * 33]); o.z = pk2(s[4 * 33], s[5 * 33]); o.w = pk2(s[6 * 33], s[7 * 33]);
        *(u32x4*)(WT + (size_t)(d0 + n) * ldk + k0 + 8 * c) = o; }
    LDS_WAIT();
}
template <bool GLUMAP = false>
__device__ __forceinline__ void prep_matrix(const Frame& F, const float* W, int K, int N, bf16_t* WT) {
    LAS float* scr = (LAS float*)(F.lds + F.wave * 8448);
    const int nitems = (K / 64) * (N / 32);
    for (int it = F.gw; it < nitems; it += F.NGW) transpose_item<GLUMAP>(W, N, WT, K, scr, it, F.lane);
}
__device__ __forceinline__ void prep_ffn_weights(const Frame& F, const Args& a, int layer) {
    prep_matrix<true>(F, a.in[I_FUP] + (size_t)layer * D * 2 * DFF, D, 2 * DFF, (bf16_t*)(a.ws + WS_WUP));
    prep_matrix(F, a.in[I_FDN] + (size_t)layer * DFF * D, DFF, D, (bf16_t*)(a.ws + WS_WDN));
}

__device__ __forceinline__ void mod_phase(const Frame& F, const Args& a) {
    LAS float* cact = (LAS float*)F.lds;
    LAS float* red = (LAS float*)(F.lds + 40960);
    for (int i = F.tid; i < NB * D; i += NTHREADS) { const int b = i / D, k = i % D; const float c = b < 4 ? a.in[I_CP][b * D + k] : a.in[I_CS][k]; cact[i] = c / (1.0f + __expf(-c)); }
    __syncthreads();
    const int rg = F.tid >> 4, cl = F.tid & 15;
    for (int u = F.vcu; u < NLAYER * 192; u += F.G) {
        const int layer = u / 192, col0 = (u % 192) * 64;
        const float* W = a.in[I_MODW] + (size_t)layer * D * 6 * D + col0 + cl * 4;
        f32x4 acc[NB];
#pragma unroll
        for (int b = 0; b < NB; ++b) acc[b] = (f32x4){0.f, 0.f, 0.f, 0.f};
#pragma unroll 8
        for (int k = rg; k < D; k += 32) { const f32x4 w = *(const f32x4*)(W + (size_t)k * 6 * D);
#pragma unroll
            for (int b = 0; b < NB; ++b) acc[b] += w * cact[b * D + k]; }
#pragma unroll
        for (int b = 0; b < NB; ++b) *(LAS f32x4*)(red + (rg * NB + b) * 64 + cl * 4) = acc[b];
        __syncthreads();
        if (F.tid < NB * 64) { const int b = F.tid >> 6, c = F.tid & 63; float s = 0.f;
            for (int r = 0; r < 32; ++r) s += red[(r * NB + b) * 64 + c];
            ((float*)(a.ws + WS_MOD))[((size_t)layer * NB + b) * 6 * D + col0 + c] = s + a.in[I_MODB][(size_t)layer * 6 * D + col0 + c]; }
        __syncthreads();
    }
}

__device__ __forceinline__ void hyena_features(const Frame& F, const Args& a) {
    const float* w1 = a.in[I_HFW1]; const float* b1 = a.in[I_HFB1]; const float* w2 = a.in[I_HFW2]; const float* b2 = a.in[I_HFB2]; const float* fr = a.in[I_HFREQ];
    bf16_t* A2 = (bf16_t*)(a.ws + WS_A2);
    const int lane = F.lane; const float freq = fr[lane], bb1 = b1[lane], bb2 = b2[lane];
    for (int t = F.gw; t < LP + LS; t += F.NGW) {
        const int ls = t >= LP, n = ls ? t - LP : t, L = ls ? LS : LP;
        const float tn = (float)n / (float)(L - 1), w = 6.283185307179586f * (float)n / (float)L;
        float z = 0.f;
        if (lane == 0) z = tn;
        else if (lane <= 32) { const int k = (lane - 1) & 15; const float f = 1e-4f + (float)k * ((15.0f - 1e-4f) / 15.0f); const float ang = f * w; z = lane <= 16 ? cosf(ang) : -sinf(ang); }
        float s1 = bb1;
#pragma unroll
        for (int i = 0; i < 33; ++i) s1 += __shfl(z, i) * w1[i * 64 + lane];
        const float a1 = sinf(freq * s1);
        float s2 = bb2;
#pragma unroll 16
        for (int i = 0; i < 64; ++i) s2 += __shfl(a1, i) * w2[i * 64 + lane];
        A2[(size_t)t * 64 + lane] = f2bf(sinf(freq * s2));
    }
}

__device__ __forceinline__ void prologue_phase(const Frame& F, const Args& a) {
    prep_matrix(F, a.in[I_HWIN], D, 3 * D, (bf16_t*)(a.ws + WS_HYWIN));
    prep_matrix(F, a.in[I_HWOUT], D, D, (bf16_t*)(a.ws + WS_HYWOUT));
    prep_matrix(F, a.in[I_AQKV], D, 3072, (bf16_t*)(a.ws + WS_ATQKV));
    prep_matrix(F, a.in[I_AWO], D, D, (bf16_t*)(a.ws + WS_ATWO));
    prep_matrix(F, a.in[I_HFW3], 64, 8192, (bf16_t*)(a.ws + WS_W3T));
    for (int jg = 0; jg < 8; ++jg)
        prep_matrix(F, a.in[I_POOLW] + (size_t)jg * 512 * 512, 512, 512, (bf16_t*)(a.ws + WS_POOLW) + (size_t)jg * 512 * 512);
    __syncthreads();
    hyena_features(F, a);
    __syncthreads();
    mod_phase(F, a);
}

struct NormP { const float* xp; const float* xs; const bf16_t* xb; float* xout; bf16_t* xbout; const bf16_t* m; const float* modg; int gate_off; const float* gpost;
               const float* modh; int sc_off, sh_off; const float* gpre; bf16_t* H; };
__device__ __forceinline__ void norm_load_row(const NormP& p, int r, int lane, f32x4 (&xn)[8], u32x4 (&xh)[4], u32x4 (&mn)[4]) {
    if (p.xb) {
#pragma unroll
        for (int j = 0; j < 4; ++j) xh[j] = *(const u32x4*)(p.xb + (size_t)r * D + lane * 8 + 512 * j);
    } else { const float* xr = r < TP ? p.xp + (size_t)r * D : p.xs + (size_t)(r - TP) * D;
#pragma unroll
        for (int j = 0; j < 4; ++j) { xn[2 * j] = *(const f32x4*)(xr + lane * 8 + 512 * j); xn[2 * j + 1] = *(const f32x4*)(xr + lane * 8 + 512 * j + 4); } }
    if (p.m) {
#pragma unroll
        for (int j = 0; j < 4; ++j) mn[j] = *(const u32x4*)(p.m + (size_t)r * D + lane * 8 + 512 * j); }
}
__device__ __forceinline__ void unpack4x2(const u32x4 w, f32x4& a, f32x4& b) { a = (f32x4){bf_lo(w.x), bf_hi(w.x), bf_lo(w.y), bf_hi(w.y)}; b = (f32x4){bf_lo(w.z), bf_hi(w.z), bf_lo(w.w), bf_hi(w.w)}; }
__device__ __forceinline__ u32x4 pack4x2(const f32x4 a, const f32x4 b) { u32x4 w; w.x = pk2(a.x, a.y); w.y = pk2(a.z, a.w); w.z = pk2(b.x, b.y); w.w = pk2(b.z, b.w); return w; }
__device__ __forceinline__ void norm_phase(const Frame& F, const NormP p) {
    LAS float* va = (LAS float*)F.lds; LAS float* vb = va + D; LAS float* vc = vb + D;
    const int lane = F.lane;
    for (int blk = F.vcu; blk < T / 64; blk += F.G) {
        const int r0 = blk * 64, b = seq_of_row(r0);
        f32x4 xn[2][8]; u32x4 xh[2][4], mn[2][4];
#pragma unroll
        for (int q = 0; q < 2; ++q) {
#pragma unroll
            for (int j = 0; j < 8; ++j) xn[q][j] = (f32x4){0.f, 0.f, 0.f, 0.f};
#pragma unroll
            for (int j = 0; j < 4; ++j) { xh[q][j] = (u32x4){0u, 0u, 0u, 0u}; mn[q][j] = (u32x4){0u, 0u, 0u, 0u}; }
            norm_load_row(p, r0 + F.wave * 8 + q, lane, xn[q], xh[q], mn[q]); }
        __syncthreads();
        for (int c = F.tid; c < D; c += NTHREADS) {
            if (p.m) va[c] = p.modg[(size_t)b * 6 * D + p.gate_off + c] * p.gpost[c];
            if (p.H) { vb[c] = p.gpre[c] * (1.0f + p.modh[(size_t)b * 6 * D + p.sc_off + c]); vc[c] = p.modh[(size_t)b * 6 * D + p.sh_off + c]; }
        }
        __syncthreads();
#pragma unroll
        for (int i = 0; i < 8; ++i) {
            const int r = r0 + F.wave * 8 + i, q = i & 1;
            f32x4 x[8]; u32x4 mw[4];
#pragma unroll
            for (int j = 0; j < 4; ++j) { if (p.xb) unpack4x2(xh[q][j], x[2 * j], x[2 * j + 1]); else { x[2 * j] = xn[q][2 * j]; x[2 * j + 1] = xn[q][2 * j + 1]; } mw[j] = mn[q][j]; }
            if (i < 6) norm_load_row(p, r + 2, lane, xn[q], xh[q], mn[q]);
            if (p.m) {
                f32x4 mv[8]; float ss = 0.f;
#pragma unroll
                for (int j = 0; j < 4; ++j) unpack4x2(mw[j], mv[2 * j], mv[2 * j + 1]);
#pragma unroll
                for (int j = 0; j < 8; ++j) ss += (mv[j].x * mv[j].x + mv[j].y * mv[j].y) + (mv[j].z * mv[j].z + mv[j].w * mv[j].w);
                const float rstd = 1.0f / sqrtf(wave_sum(ss) * (1.0f / D) + EPS);
#pragma unroll
                for (int j = 0; j < 8; ++j) { const f32x4 g = *(const LAS f32x4*)(va + lane * 8 + 512 * (j >> 1) + 4 * (j & 1)); x[j] += g * (mv[j] * rstd); }
                if (p.xout) { float* xo = p.xout + (size_t)r * D;
#pragma unroll
                    for (int j = 0; j < 8; ++j) *(f32x4*)(xo + lane * 8 + 512 * (j >> 1) + 4 * (j & 1)) = x[j]; }
                if (p.xbout) { bf16_t* xo = p.xbout + (size_t)r * D;
#pragma unroll
                    for (int j = 0; j < 4; ++j) *(u32x4*)(xo + lane * 8 + 512 * j) = pack4x2(x[2 * j], x[2 * j + 1]); }
            }
            if (p.H) {
                float ss = 0.f;
#pragma unroll
                for (int j = 0; j < 8; ++j) ss += (x[j].x * x[j].x + x[j].y * x[j].y) + (x[j].z * x[j].z + x[j].w * x[j].w);
                const float rstd = 1.0f / sqrtf(wave_sum(ss) * (1.0f / D) + EPS);
                bf16_t* hr = p.H + (size_t)r * D;
#pragma unroll
                for (int j = 0; j < 4; ++j) { f32x4 h[2];
#pragma unroll
                    for (int e = 0; e < 2; ++e) { const int off = lane * 8 + 512 * j + 4 * e; const f32x4 g = *(const LAS f32x4*)(vb + off), s = *(const LAS f32x4*)(vc + off); h[e] = (x[2 * j + e] * rstd) * g + s; }
                    *(u32x4*)(hr + lane * 8 + 512 * j) = pack4x2(h[0], h[1]); }
            }
        }
    }
    __syncthreads();
}

__device__ __forceinline__ void acc8(float (&acc)[8], const u32x4 w, float sg) {
    acc[0] += sg * bf_lo(w.x); acc[1] += sg * bf_hi(w.x); acc[2] += sg * bf_lo(w.y); acc[3] += sg * bf_hi(w.y); acc[4] += sg * bf_lo(w.z); acc[5] += sg * bf_hi(w.z); acc[6] += sg * bf_lo(w.w); acc[7] += sg * bf_hi(w.w); }
__device__ __forceinline__ void pool_phase(const Frame& F, const bf16_t* H, bf16_t* P) {
    const int lane = F.lane;
    for (int u = F.gw; u < (T / 32) * 4; u += F.NGW) {
        const int g = u & 3, seg = u >> 2, t0 = seg * 32, s = seq_of_row(t0), st = seq_start(s), L = seq_len(s);
        const int win = 2 << g, half = win >> 1, col = g * 512 + lane * 8;
        const bf16_t* Hs = H + (size_t)st * D + col;
        float acc[8];
#pragma unroll
        for (int e = 0; e < 8; ++e) acc[e] = 0.f;
        const int tl0 = t0 - st;
        { int lo = tl0 - half; lo = lo < 0 ? 0 : lo; int hi = tl0 + win - half - 1; hi = hi > L - 1 ? L - 1 : hi;
          u32x4 w[16];
#pragma unroll
          for (int k = 0; k < 16; ++k) { const int r = lo + k; w[k] = (r <= hi) ? *(const u32x4*)(Hs + (size_t)r * D) : (u32x4){0u, 0u, 0u, 0u}; }
#pragma unroll
          for (int k = 0; k < 16; ++k) acc8(acc, w[k], 1.0f); }
        for (int i0 = 0; i0 < 32; i0 += 8) {
            u32x4 cen[8], inn[8], outt[8];
#pragma unroll
            for (int k = 0; k < 8; ++k) { const int tl = tl0 + i0 + k;
                cen[k] = *(const u32x4*)(Hs + (size_t)tl * D);
                const int ri = tl + win - half, ro = tl - half;
                inn[k] = (ri < L) ? *(const u32x4*)(Hs + (size_t)ri * D) : (u32x4){0u, 0u, 0u, 0u};
                outt[k] = (ro >= 0) ? *(const u32x4*)(Hs + (size_t)ro * D) : (u32x4){0u, 0u, 0u, 0u}; }
#pragma unroll
            for (int k = 0; k < 8; ++k) { const int tl = tl0 + i0 + k; int lo = tl - half; lo = lo < 0 ? 0 : lo; int hi = tl + win - half - 1; hi = hi > L - 1 ? L - 1 : hi;
                const float inv = 1.0f / (float)(hi - lo + 1); const u32x4 c = cen[k];
                u32x4 o; o.x = pk2(acc[0] * inv - bf_lo(c.x), acc[1] * inv - bf_hi(c.x)); o.y = pk2(acc[2] * inv - bf_lo(c.y), acc[3] * inv - bf_hi(c.y));
                o.z = pk2(acc[4] * inv - bf_lo(c.z), acc[5] * inv - bf_hi(c.z)); o.w = pk2(acc[6] * inv - bf_lo(c.w), acc[7] * inv - bf_hi(c.w));
                *(u32x4*)(P + (size_t)(st + tl) * D + col) = o;
                acc8(acc, inn[k], 1.0f); acc8(acc, outt[k], -1.0f); }
        }
    }
}

__device__ __forceinline__ float gelu_tanh(float x) { return pg8::gelu_tanh_f(x); }
__device__ __forceinline__ void unpack8(const u32x4 w, float (&v)[8]) { v[0] = bf_lo(w.x); v[1] = bf_hi(w.x); v[2] = bf_lo(w.y); v[3] = bf_hi(w.y); v[4] = bf_lo(w.z); v[5] = bf_hi(w.z); v[6] = bf_lo(w.w); v[7] = bf_hi(w.w); }
__device__ __forceinline__ void ffn_fix_phase(const Frame& F, const bf16_t* EA, const bf16_t* EB, bf16_t* U, const float* cw, const float* cb) {
    const int lane = F.lane;
    for (int it = F.gw; it < 384 * 2 * 11; it += F.NGW) {
        const int cbk = it % 11, e = (it / 11) & 1, hb = it / 22, c0 = cbk * 512 + lane * 8;
        const int row = hb * 128 + (e ? 127 : 0), s = seq_of_row(row), pos = row - seq_start(s), L = seq_len(s);
        const u32x4 z4 = (u32x4){0u, 0u, 0u, 0u};
        u32x4 rp, rc, rn, rg;
        if (e == 0) { rp = pos > 0 ? *(const u32x4*)(EA + ((size_t)(hb - 1) * 4 + 3) * DFF + c0) : z4; rc = *(const u32x4*)(EA + ((size_t)hb * 4 + 0) * DFF + c0); rn = *(const u32x4*)(EA + ((size_t)hb * 4 + 1) * DFF + c0);
                      rg = *(const u32x4*)(EB + ((size_t)hb * 2 + 0) * DFF + c0); }
        else { rp = *(const u32x4*)(EA + ((size_t)hb * 4 + 2) * DFF + c0); rc = *(const u32x4*)(EA + ((size_t)hb * 4 + 3) * DFF + c0); rn = pos < L - 1 ? *(const u32x4*)(EA + ((size_t)(hb + 1) * 4 + 0) * DFF + c0) : z4;
               rg = *(const u32x4*)(EB + ((size_t)hb * 2 + 1) * DFF + c0); }
        float prev[8], cur[8], nxt[8], gv[8], o[8];
        unpack8(rp, prev); unpack8(rc, cur); unpack8(rn, nxt); unpack8(rg, gv);
#pragma unroll
        for (int k = 0; k < 8; ++k) { const float y = cw[c0 + k] * prev[k] + cw[DFF + c0 + k] * cur[k] + cw[2 * DFF + c0 + k] * nxt[k] + cb[c0 + k]; o[k] = gelu_tanh(y) * gv[k]; }
        u32x4 w; w.x = pk2(o[0], o[1]); w.y = pk2(o[2], o[3]); w.z = pk2(o[4], o[5]); w.w = pk2(o[6], o[7]);
        *(u32x4*)(U + (size_t)row * DFF + c0) = w;
    }
}

__device__ __forceinline__ void qk_norm_rope_phase(const Frame& F, bf16_t* QKV, const float* qg, const float* kg) {
    const int lane = F.lane, l16 = lane & 15, axis = l16 >> 3, half = (l16 >> 2) & 1, sub = lane >> 4;
    float gq[8], gk[8], inv[8];
#pragma unroll
    for (int j = 0; j < 8; ++j) { gq[j] = qg[l16 * 8 + j]; gk[j] = kg[l16 * 8 + j]; const int i = (l16 & 3) * 8 + j; inv[j] = expf(-9.210340371976184f * (float)(2 * i) / 64.0f) * 0.15915494309189535f; }
    u32x4 raw[5], nxt[5];
#pragma unroll
    for (int st = 0; st < 5; ++st) { raw[st] = (u32x4){0u, 0u, 0u, 0u}; nxt[st] = (u32x4){0u, 0u, 0u, 0u}; }
    if (F.gw < T) {
#pragma unroll
        for (int st = 0; st < 5; ++st) raw[st] = *(const u32x4*)(QKV + (size_t)F.gw * 3072 + (st * 4 + sub) * 128 + l16 * 8); }
    for (int t = F.gw; t < T; t += F.NGW) {
        if (t + F.NGW < T) {
#pragma unroll
            for (int st = 0; st < 5; ++st) nxt[st] = *(const u32x4*)(QKV + (size_t)(t + F.NGW) * 3072 + (st * 4 + sub) * 128 + l16 * 8); }
        const int s = seq_of_row(t), tl = t - seq_start(s); const float pos = (float)(axis == 0 ? (tl >> 6) : (tl & 63));
        float cs[8], sn[8];
#pragma unroll
        for (int j = 0; j < 8; ++j) { const float rev = pos * inv[j]; cs[j] = __builtin_amdgcn_cosf(rev); sn[j] = __builtin_amdgcn_sinf(rev); }
#pragma unroll
        for (int st = 0; st < 5; ++st) {
            const int hh = st * 4 + sub; bf16_t* p = QKV + (size_t)t * 3072 + hh * 128 + l16 * 8;
            float v[8]; unpack8(raw[st], v);
            float ss = 0.f;
#pragma unroll
            for (int j = 0; j < 8; ++j) ss += v[j] * v[j];
            ss += __shfl_xor(ss, 1); ss += __shfl_xor(ss, 2); ss += __shfl_xor(ss, 4); ss += __shfl_xor(ss, 8);
            const float rstd = 1.0f / sqrtf(ss * (1.0f / 128.0f) + EPS);
            float o[8];
#pragma unroll
            for (int j = 0; j < 8; ++j) { const float y = v[j] * rstd * (hh < 16 ? gq[j] : gk[j]); const float pr = __shfl_xor(y, 4);
                o[j] = half == 0 ? (y * cs[j] - pr * sn[j]) : (y * cs[j] + pr * sn[j]); }
            u32x4 w; w.x = pk2(o[0], o[1]); w.y = pk2(o[2], o[3]); w.z = pk2(o[4], o[5]); w.w = pk2(o[6], o[7]);
            *(u32x4*)p = w;
        }
#pragma unroll
        for (int st = 0; st < 5; ++st) raw[st] = nxt[st];
    }
}

__device__ __forceinline__ void attn_unit(const Frame& F, const bf16_t* QKV, bf16_t* O, int s, int head, int qb) {
    const int st = seq_start(s), L = seq_len(s), kvh = head >> 2;
    const bf16_t* Qb = QKV + (size_t)(st + qb * 256) * 3072 + head * 128;
    const bf16_t* Kh = QKV + (size_t)st * 3072 + 2048 + kvh * 128;
    const bf16_t* Vh = QKV + (size_t)st * 3072 + 2560 + kvh * 128;
    bf16_t* Ob = O + (size_t)(st + qb * 256) * D + head * 128;
    __syncthreads();
    att::attn_dense_body(Qb, Kh, Vh, Ob, L, (char*)F.lds);
}
__device__ __forceinline__ void attn_phase(const Frame& F, const bf16_t* QKV, bf16_t* O) {
    const int per = F.G / 8;
    if (F.G == 256) {
        const int xg = F.vcu / per, r = F.vcu % per;
        for (int j = 0; j < 4; ++j) {
            const int kvh = xg >> 1, idx = (xg & 1) * 128 + j * 32 + r, hg = idx >> 6, qb = idx & 63;
            attn_unit(F, QKV, O, 4, kvh * 4 + hg, qb);
        }
        for (int i = 0; i < 8; ++i) {
            const int grp = xg * 2 + (i >> 2), s = grp >> 2, kvh = grp & 3, idx = (i & 3) * 32 + r, hg = idx >> 5, qb = idx & 31;
            attn_unit(F, QKV, O, s, kvh * 4 + hg, qb);
        }
    } else {
        for (int u = F.vcu; u < 64 * 16 + 4 * 32 * 16; u += F.G) {
            if (u < 1024) attn_unit(F, QKV, O, 4, u >> 6, u & 63);
            else { const int v = u - 1024; attn_unit(F, QKV, O, v >> 9, (v >> 5) & 15, v & 31); }
        }
    }
    __syncthreads();
}
namespace hy {
__device__ constexpr float TWC[16] = {1.0f, 0.98078528040323043f, 0.92387953251128674f, 0.83146961230254524f, 0.70710678118654752f, 0.55557023301960218f, 0.38268343236508977f, 0.19509032201612825f,
                                      0.0f, -0.19509032201612825f, -0.38268343236508977f, -0.55557023301960218f, -0.70710678118654752f, -0.83146961230254524f, -0.92387953251128674f, -0.98078528040323043f};
__device__ constexpr float TWS[16] = {0.0f, 0.19509032201612825f, 0.38268343236508977f, 0.55557023301960218f, 0.70710678118654752f, 0.83146961230254524f, 0.92387953251128674f, 0.98078528040323043f,
                                      1.0f, 0.98078528040323043f, 0.92387953251128674f, 0.83146961230254524f, 0.70710678118654752f, 0.55557023301960218f, 0.38268343236508977f, 0.19509032201612825f};
__device__ __forceinline__ f32x2 cmul(f32x2 a, f32x2 b) {
    f32x2 r;
    asm("v_pk_mul_f32 %0, %1, %2 op_sel:[0,0] op_sel_hi:[0,1]\n\t"
        "v_pk_fma_f32 %0, %1, %2, %0 op_sel:[1,1,0] op_sel_hi:[1,0,1] neg_lo:[1,0,0]"
        : "=&v"(r) : "v"(a), "v"(b));
    return r;
}
__device__ __forceinline__ f32x2 cmulc(f32x2 a, f32x2 b) {
    f32x2 r;
    asm("v_pk_mul_f32 %0, %1, %2 op_sel:[0,0] op_sel_hi:[0,1] neg_hi:[0,1]\n\t"
        "v_pk_fma_f32 %0, %1, %2, %0 op_sel:[1,1,0] op_sel_hi:[1,0,1]"
        : "=&v"(r) : "v"(a), "v"(b));
    return r;
}
__device__ __forceinline__ f32x2 pk_add_pm(f32x2 a, f32x2 b) { f32x2 r; asm("v_pk_add_f32 %0, %1, %2 neg_hi:[0,1]" : "=v"(r) : "v"(a), "v"(b)); return r; }
__device__ __forceinline__ f32x2 pk_add_mp(f32x2 a, f32x2 b) { f32x2 r; asm("v_pk_add_f32 %0, %1, %2 neg_lo:[0,1]" : "=v"(r) : "v"(a), "v"(b)); return r; }
__device__ __forceinline__ f32x2 pk_addc(f32x2 a, f32x2 b)   { f32x2 r; asm("v_pk_add_f32 %0, %1, %2 neg_hi:[1,1]" : "=v"(r) : "v"(a), "v"(b)); return r; }
__device__ __forceinline__ f32x2 cconj(f32x2 a) { return (f32x2){a.x, -a.y}; }
__device__ __forceinline__ f32x2 twid(float rev) {
    float c = __builtin_amdgcn_cosf(rev), s = __builtin_amdgcn_sinf(rev);
    asm volatile("s_nop 1" : "+v"(c), "+v"(s));
    return (f32x2){c, -s};
}
__device__ __forceinline__ f32x2 twid_sc(float rev) {
    float c = __builtin_amdgcn_cosf(rev), s = __builtin_amdgcn_sinf(rev);
    asm volatile("s_nop 1" : "+v"(c), "+v"(s));
    return (f32x2){s, c};
}

__device__ __forceinline__ f32x2 sub_rot_mi(f32x2 a, f32x2 b) { f32x2 r; asm("v_pk_add_f32 %0, %1, %2 op_sel:[1,1] op_sel_hi:[0,0] neg_lo:[0,1] neg_hi:[1,0]" : "=v"(r) : "v"(a), "v"(b)); return r; }
__device__ __forceinline__ f32x2 sub_rot_pi(f32x2 a, f32x2 b) { f32x2 r; asm("v_pk_add_f32 %0, %1, %2 op_sel:[1,1] op_sel_hi:[0,0] neg_lo:[1,0] neg_hi:[0,1]" : "=v"(r) : "v"(a), "v"(b)); return r; }
template <int R, bool INV> __device__ __forceinline__ void dft(f32x2 (&v)[R]) {
    if constexpr (R == 2) { const f32x2 a = v[0], b = v[1]; v[0] = a + b; v[1] = a - b; }
    else {
        constexpr int H = R / 2; f32x2 u[H], w[H];
#pragma unroll
        for (int j = 0; j < H; ++j) { const f32x2 a = v[j], b = v[j + H]; u[j] = a + b; const f32x2 t = a - b;
            const int k = j * (32 / R);
            if (j == 0) w[j] = t;
            else if (4 * j == R) w[j] = INV ? sub_rot_pi(a, b) : sub_rot_mi(a, b);
            else w[j] = INV ? (f32x2){t.x * TWC[k] - t.y * TWS[k], t.y * TWC[k] + t.x * TWS[k]} : (f32x2){t.x * TWC[k] + t.y * TWS[k], t.y * TWC[k] - t.x * TWS[k]}; }
        dft<H, INV>(u); dft<H, INV>(w);
#pragma unroll
        for (int p = 0; p < H; ++p) { v[2 * p] = u[p]; v[2 * p + 1] = w[p]; }
    }
}
__device__ __forceinline__ int PADI(int p) { return p + (p >> 5) + (p >> 9); }
__device__ __forceinline__ unsigned PADI(unsigned p) { return p + (p >> 5) + (p >> 9); }

__host__ __device__ constexpr int POFF(int x) { return x + (x >> 5) + (x >> 9); }
template <int LOGM> __host__ __device__ constexpr int ZS() { return POFF(1 << LOGM); }
template <int R> __device__ __forceinline__ void twid_powers(f32x2 w1, f32x2 (&w)[R]) {
    w[1] = w1;
#pragma unroll
    for (int p = 2; p < R; ++p) w[p] = (p & 1) ? cmul(w[p - 1], w1) : cmul(w[p >> 1], w[p >> 1]);
}
template <int LOGM, int LOGNS, int LOGR, bool INV, int NZ, bool HALF = false> __device__ __forceinline__ void fft_stage(LAS f32x2* Z, int tid) {
    asm volatile("" : "+v"(tid));
    constexpr int R = 1 << LOGR, LOGSUB = LOGNS - LOGR, SUB = 1 << LOGSUB, NBF = 1 << (LOGM - LOGR);
    constexpr float INVNS = 1.0f / (float)(1 << LOGNS);
#pragma unroll 1
    for (int bf = tid; bf < NBF; bf += NTHREADS) {
        const int j = bf & (SUB - 1), blk = bf >> LOGSUB, base = (blk << LOGNS) + j;
        LAS f32x2* Zb = Z + PADI(base);
        f32x2 v[NZ][R];
#pragma unroll
        for (int z = 0; z < NZ; ++z)
#pragma unroll
            for (int q = 0; q < R; ++q) v[z][q] = (HALF && !INV && q >= R / 2) ? (f32x2){0.f, 0.f} : Zb[z * ZS<LOGM>() + POFF(q << LOGSUB)];
        f32x2 w[R];
        if constexpr (LOGSUB > 0) { const f32x2 t = twid((float)j * INVNS); twid_powers<R>(INV ? cconj(t) : t, w); }
#pragma unroll
        for (int z = 0; z < NZ; ++z) {
            if constexpr (!INV) {
                dft<R, false>(v[z]);
                if constexpr (LOGSUB > 0) {
#pragma unroll
                    for (int p = 1; p < R; ++p) v[z][p] = cmul(v[z][p], w[p]);
                }
            } else {
                if constexpr (LOGSUB > 0) {
#pragma unroll
                    for (int p = 1; p < R; ++p) v[z][p] = cmul(v[z][p], w[p]);
                }
                dft<R, true>(v[z]);
            }
#pragma unroll
            for (int q = 0; q < R; ++q) if (!(HALF && INV && q >= R / 2)) Zb[z * ZS<LOGM>() + POFF(q << LOGSUB)] = v[z][q];
        }
    }
    __syncthreads();
}
template <int LOGM> struct Cfg;
template <> struct Cfg<13> { static constexpr int L1 = 3, L2 = 3, L3 = 3, L4 = 4; };
template <> struct Cfg<14> { static constexpr int L1 = 3, L2 = 3, L3 = 4, L4 = 4; };
template <int LOGM, int NZ, bool PADDED = false> __device__ __forceinline__ void fft_fwd(LAS f32x2* Z, int tid) {
    using C = Cfg<LOGM>;
    fft_stage<LOGM, LOGM, C::L1, false, NZ, PADDED>(Z, tid);
    fft_stage<LOGM, LOGM - C::L1, C::L2, false, NZ>(Z, tid);
    fft_stage<LOGM, LOGM - C::L1 - C::L2, C::L3, false, NZ>(Z, tid);
    fft_stage<LOGM, C::L4, C::L4, false, NZ>(Z, tid);
}
template <int LOGM, int NZ, bool PADDED = false> __device__ __forceinline__ void fft_inv(LAS f32x2* Z, int tid) {
    using C = Cfg<LOGM>;
    fft_stage<LOGM, C::L4, C::L4, true, NZ>(Z, tid);
    fft_stage<LOGM, LOGM - C::L1 - C::L2, C::L3, true, NZ>(Z, tid);
    fft_stage<LOGM, LOGM - C::L1, C::L2, true, NZ>(Z, tid);
    fft_stage<LOGM, LOGM, C::L1, true, NZ, PADDED>(Z, tid);
}
template <int LOGM> __host__ __device__ constexpr int drev(int k) {
    using C = Cfg<LOGM>;
    const int k1 = k & ((1 << C::L1) - 1), k2 = (k >> C::L1) & ((1 << C::L2) - 1), k3 = (k >> (C::L1 + C::L2)) & ((1 << C::L3) - 1), k4 = k >> (C::L1 + C::L2 + C::L3);
    return (k1 << (C::L2 + C::L3 + C::L4)) | (k2 << (C::L3 + C::L4)) | (k3 << C::L4) | k4;
}

template <int LOGM, int NZ> __device__ __forceinline__ void kernel_fft_unit(const Frame& F, float* row0, size_t rstride) {
    constexpr int M = 1 << LOGM, NC = M / 2 / NTHREADS; LAS f32x2* Z = (LAS f32x2*)F.lds; int tid = threadIdx.x; asm volatile("" : "+v"(tid));
    __syncthreads();
#pragma unroll
    for (int z = 0; z < NZ; ++z) { const float* row = row0 + z * rstride; unsigned t0 = (unsigned)tid; asm volatile("" : "+v"(t0)); f32x2 lo[NC]; float re[NC], im[NC];
#pragma unroll
      for (int c = 0; c < NC; ++c) { const unsigned n = t0 + NTHREADS * c; lo[c] = ((const f32x2*)row)[n];
          const unsigned n2 = n + M / 2;
          re[c] = (n2 == (unsigned)(M / 2)) ? 0.f : row[M + (2 * M - 2 * n2)]; im[c] = row[M + (2 * M - 2 * n2 - 1)]; }
#pragma unroll
      for (int c = 0; c < NC; ++c) { LAS f32x2* Zi = Z + PADI(t0);
          Zi[z * ZS<LOGM>() + POFF(NTHREADS * c)] = lo[c]; Zi[z * ZS<LOGM>() + POFF(NTHREADS * c + M / 2)] = (f32x2){re[c], im[c]}; } }
    __syncthreads();
    fft_fwd<LOGM, NZ>(Z, tid);
    { unsigned tk = (unsigned)tid; asm volatile("" : "+v"(tk));
      constexpr int CS = 4 / NZ, TOP = M / 512 - 1;
      const int pmAi = PADI(drev<LOGM>(512 - (int)tk));
      const LAS f32x2* Zk = Z + PADI(drev<LOGM>((int)tk));
      const LAS f32x2* ZmO = Z + pmAi;
      const LAS f32x2* ZmE = Z + ((LOGM == 14 && tk == 0u) ? pmAi - 263 : pmAi);
      const LAS f32x2* Zm0 = Z + ((tk == 0u) ? 0 : pmAi + POFF(drev<LOGM>(512 * TOP)));
      const float a0 = (float)tk * (1.0f / (float)(2 * M));
#pragma unroll
      for (int c0 = 0; c0 < NC; c0 += CS) {
          f32x2 A[4], B[4], V[4], E2[4], D2[4], P[4];
#pragma unroll
          for (int cc = 0; cc < CS; ++cc) { const int c = c0 + cc; const f32x2 v = twid_sc(a0 + (float)c * (512.0f / (float)(2 * M)));
              const LAS f32x2* Zm = (c == 0) ? Zm0 : (((c & 1) || LOGM == 13) ? ZmO : ZmE); const int dm = (c == 0) ? 0 : POFF(drev<LOGM>(512 * (TOP - c)));
#pragma unroll
              for (int z = 0; z < NZ; ++z) { const int sl = cc * NZ + z; V[sl] = v; A[sl] = Zk[z * ZS<LOGM>() + POFF(drev<LOGM>(512 * c))]; B[sl] = Zm[z * ZS<LOGM>() + dm]; } }
#pragma unroll
          for (int sl = 0; sl < 4; ++sl) E2[sl] = pk_add_pm(A[sl], B[sl]);
#pragma unroll
          for (int sl = 0; sl < 4; ++sl) D2[sl] = pk_add_mp(A[sl], B[sl]);
#pragma unroll
          for (int sl = 0; sl < 4; ++sl) P[sl] = cmul(V[sl], D2[sl]);
#pragma unroll
          for (int sl = 0; sl < 4; ++sl) A[sl] = E2[sl] - P[sl];
#pragma unroll
          for (int sl = 0; sl < 4; ++sl) B[sl] = pk_addc(E2[sl], P[sl]);
#pragma unroll
          for (int cc = 0; cc < CS; ++cc) { const unsigned k = tk + NTHREADS * (unsigned)(c0 + cc);
#pragma unroll
              for (int z = 0; z < NZ; ++z) { float* row = row0 + z * rstride; const int sl = cc * NZ + z;
                  *(f32x2*)(row + 2u * k) = A[sl]; *(f32x2*)(row + 2u * ((unsigned)M - k)) = B[sl]; } }
      }
      if (tid == 0) {
          const f32x2 v = twid_sc(0.25f);
#pragma unroll
          for (int z = 0; z < NZ; ++z) { float* row = row0 + z * rstride; const f32x2 a = Z[z * ZS<LOGM>() + PADI(drev<LOGM>(M / 2))];
              const f32x2 e2 = pk_add_pm(a, a), d2 = pk_add_mp(a, a), pp = cmul(v, d2);
              *(f32x2*)(row + M) = pk_addc(e2, pp); }
      }
    }
}

template <int LOGM, int NZ> __device__ __forceinline__ void conv_unit(const Frame& F, const bf16_t* vrow, const bf16_t* g0row, const bf16_t* g1row, size_t sstride, const float* k0row, const float* k1row,
                                                                      float skip0, float skip1, bf16_t* orow, size_t ostride) {
    constexpr int M = 1 << LOGM, NC = M / 2 / NTHREADS; LAS f32x2* Z = (LAS f32x2*)F.lds; int tid = threadIdx.x; asm volatile("" : "+v"(tid));
    float zz[NZ][2 * NC];
    __syncthreads();
#pragma unroll
    for (int z = 0; z < NZ; ++z) { unsigned t0 = (unsigned)tid; asm volatile("" : "+v"(t0)); const unsigned* vp = (const unsigned*)(vrow + z * sstride);
#pragma unroll
      for (int c = 0; c < NC; ++c) { const unsigned n = t0 + NTHREADS * c; const unsigned w = vp[n]; zz[z][2 * c] = bf_lo(w); zz[z][2 * c + 1] = bf_hi(w);
          (Z + PADI(t0))[z * ZS<LOGM>() + POFF(NTHREADS * c)] = (f32x2){zz[z][2 * c], zz[z][2 * c + 1]}; } }
    __syncthreads();
#pragma unroll
    for (int o = 0; o < 2; ++o) {
        const float* kf = o ? k1row : k0row; const bf16_t* grow = o ? g1row : g0row; const float skip = o ? skip1 : skip0;
        f32x2 Kk[NC], Km[NC]; const f32x2 Kh = ((const f32x2*)kf)[M / 2];
        { unsigned tk = (unsigned)tid; asm volatile("" : "+v"(tk));
#pragma unroll
          for (int c = 0; c < NC; ++c) { const unsigned k = tk + NTHREADS * c; Kk[c] = ((const f32x2*)kf)[k]; Km[c] = ((const f32x2*)kf)[(unsigned)M - k]; } }
        unsigned gwv[NZ][NC];
#pragma unroll
        for (int z = 0; z < NZ; ++z) { unsigned t1 = (unsigned)tid; asm volatile("" : "+v"(t1)); const unsigned* gp = (const unsigned*)(grow + z * sstride);
#pragma unroll
          for (int c = 0; c < NC; ++c) gwv[z][c] = gp[t1 + NTHREADS * c]; }
        fft_fwd<LOGM, NZ, true>(Z, tid);
        { unsigned tk = (unsigned)tid; asm volatile("" : "+v"(tk));
          constexpr int CS = 4 / NZ, TOP = M / 512 - 1;
          const int pmAi = PADI(drev<LOGM>(512 - (int)tk));
          LAS f32x2* Zk = Z + PADI(drev<LOGM>((int)tk));
          LAS f32x2* ZmO = Z + pmAi;
          LAS f32x2* ZmE = Z + ((LOGM == 14 && tk == 0u) ? pmAi - 263 : pmAi);
          LAS f32x2* Zm0 = Z + ((tk == 0u) ? 0 : pmAi + POFF(drev<LOGM>(512 * TOP)));
          const float a0 = (float)tk * (1.0f / (float)(2 * M));
#pragma unroll
          for (int c0 = 0; c0 < NC; c0 += CS) {
              f32x2 A[4], B[4], V[4], KK[4], KM[4], E[4], Dm[4], P[4], X1[4], X2[4], Yk[4], Ym[4];
#pragma unroll
              for (int cc = 0; cc < CS; ++cc) { const int c = c0 + cc; const f32x2 v = twid_sc(a0 + (float)c * (512.0f / (float)(2 * M)));
                  LAS f32x2* Zm = (c == 0) ? Zm0 : (((c & 1) || LOGM == 13) ? ZmO : ZmE); const int dm = (c == 0) ? 0 : POFF(drev<LOGM>(512 * (TOP - c)));
#pragma unroll
                  for (int z = 0; z < NZ; ++z) { const int sl = cc * NZ + z; V[sl] = v; KK[sl] = Kk[c]; KM[sl] = Km[c]; A[sl] = Zk[z * ZS<LOGM>() + POFF(drev<LOGM>(512 * c))]; B[sl] = Zm[z * ZS<LOGM>() + dm]; } }
#pragma unroll
              for (int sl = 0; sl < 4; ++sl) E[sl] = pk_add_pm(A[sl], B[sl]);
#pragma unroll
              for (int sl = 0; sl < 4; ++sl) Dm[sl] = pk_add_mp(A[sl], B[sl]);
#pragma unroll
              for (int sl = 0; sl < 4; ++sl) P[sl] = cmul(V[sl], Dm[sl]);
#pragma unroll
              for (int sl = 0; sl < 4; ++sl) X1[sl] = E[sl] - P[sl];
#pragma unroll
              for (int sl = 0; sl < 4; ++sl) X2[sl] = E[sl] + P[sl];
#pragma unroll
              for (int sl = 0; sl < 4; ++sl) Yk[sl] = cmul(X1[sl], KK[sl]);
#pragma unroll
              for (int sl = 0; sl < 4; ++sl) Ym[sl] = cmulc(X2[sl], KM[sl]);
#pragma unroll
              for (int sl = 0; sl < 4; ++sl) E[sl] = Yk[sl] + Ym[sl];
#pragma unroll
              for (int sl = 0; sl < 4; ++sl) Dm[sl] = Yk[sl] - Ym[sl];
#pragma unroll
              for (int sl = 0; sl < 4; ++sl) P[sl] = cmulc(Dm[sl], V[sl]);
#pragma unroll
              for (int sl = 0; sl < 4; ++sl) A[sl] = E[sl] - P[sl];
#pragma unroll
              for (int sl = 0; sl < 4; ++sl) B[sl] = pk_addc(E[sl], P[sl]);
#pragma unroll
              for (int cc = 0; cc < CS; ++cc) { const int c = c0 + cc;
                  LAS f32x2* Zm = (c == 0) ? Zm0 : (((c & 1) || LOGM == 13) ? ZmO : ZmE); const int dm = (c == 0) ? 0 : POFF(drev<LOGM>(512 * (TOP - c)));
#pragma unroll
                  for (int z = 0; z < NZ; ++z) { const int sl = cc * NZ + z; Zm[z * ZS<LOGM>() + dm] = B[sl]; Zk[z * ZS<LOGM>() + POFF(drev<LOGM>(512 * c))] = A[sl]; } }
          }
          if (tid == 0) {
              const f32x2 v = twid_sc(0.25f);
#pragma unroll
              for (int z = 0; z < NZ; ++z) { LAS f32x2* zp = Z + z * ZS<LOGM>() + PADI(drev<LOGM>(M / 2)); const f32x2 a = *zp;
                  const f32x2 e = pk_add_pm(a, a), dm = pk_add_mp(a, a), pp = cmul(v, dm), yk = cmul(e - pp, Kh), ym = cmulc(e + pp, Kh);
                  const f32x2 ye = yk + ym, qq = cmulc(yk - ym, v);
                  *zp = ye - qq; }
          } }
        __syncthreads();
        fft_inv<LOGM, NZ, true>(Z, tid);
        constexpr float SC = 0.125f / (float)M;
#pragma unroll
        for (int z = 0; z < NZ; ++z) { unsigned t1 = (unsigned)tid; asm volatile("" : "+v"(t1)); unsigned* op = (unsigned*)(orow + z * ostride);
#pragma unroll
          for (int c = 0; c < NC; ++c) { const unsigned n = t1 + NTHREADS * c; LAS f32x2* Zo = Z + PADI(t1) + z * ZS<LOGM>() + POFF(NTHREADS * c); const f32x2 y = *Zo; const unsigned gw = gwv[z][c];
            zz[z][2 * c] = bf_lo(gw) * (y.x * SC + zz[z][2 * c] * skip); zz[z][2 * c + 1] = bf_hi(gw) * (y.y * SC + zz[z][2 * c + 1] * skip);
            if (o == 0) *Zo = (f32x2){zz[z][2 * c], zz[z][2 * c + 1]};
            else op[n] = pk2(zz[z][2 * c], zz[z][2 * c + 1]); } }
        __syncthreads();
    }
}
}

__device__ __forceinline__ void hy_fix_phase(const Frame& F, const Args& a) {
    bf16_t* UT = (bf16_t*)(a.ws + WS_UT); const bf16_t* EU = (const bf16_t*)(a.ws + WS_EU); const float* cw = a.in[I_HCW];
    for (int it = F.gw; it < 383 * 96; it += F.NGW) {
        const int hb = it / 96, col = (it % 96) * 64 + F.lane, rl = hb * 128 + 127, s = seq_of_row(rl);
        if (seq_of_row(rl + 1) != s) continue;
        const int L = seq_len(s), tl = rl - seq_start(s);
        const float ul = bf1(EU[((size_t)hb * 2 + 1) * (3 * D) + col]), uf = bf1(EU[((size_t)(hb + 1) * 2 + 0) * (3 * D) + col]);
        bf16_t* p = UT + (size_t)seq_start(s) * (3 * D) + (size_t)col * L + tl;
        p[0] = f2bf(bf1(p[0]) + cw[2 * 3 * D + col] * uf);
        p[1] = f2bf(bf1(p[1]) + cw[col] * ul);
    }
}
__device__ __forceinline__ void hy_transpose_back_item(const Frame& F, const Args& a, int q, int item, LAS float* tile) {
    const bf16_t* ZT = (const bf16_t*)(a.ws + WS_ZT); bf16_t* ZZ = (bf16_t*)(a.ws + WS_H);
    const int lane = F.lane, cb8 = item & 7, rb = item >> 3, t0 = rb * 64, s = seq_of_row(t0), tl0 = t0 - seq_start(s), L = seq_len(s);
    const bf16_t* src = ZT + (size_t)seq_start(s) * 512 + (size_t)(cb8 * 64) * L + tl0;
    LDS_WAIT();
#pragma unroll
    for (int it = 0; it < 8; ++it) { const int ch = it * 8 + (lane >> 3), tk = (lane & 7) * 8; float v[8]; unpack8(*(const u32x4*)(src + (size_t)ch * L + tk), v);
#pragma unroll
        for (int e = 0; e < 8; ++e) tile[ch * 65 + tk + e] = v[e]; }
    LDS_WAIT();
#pragma unroll
    for (int it = 0; it < 8; ++it) { const int tk = it * 8 + (lane >> 3), c0 = (lane & 7) * 8; float v[8];
#pragma unroll
        for (int e = 0; e < 8; ++e) v[e] = tile[(c0 + e) * 65 + tk];
        u32x4 w; w.x = pk2(v[0], v[1]); w.y = pk2(v[2], v[3]); w.z = pk2(v[4], v[5]); w.w = pk2(v[6], v[7]);
        *(u32x4*)(ZZ + (size_t)(t0 + tk) * D + q * 512 + cb8 * 64 + c0) = w; }
}
__device__ __forceinline__ void hy_filter_item(const Frame& F, const Args& a, int q, int item) {
    const bf16_t* W3T = (const bf16_t*)(a.ws + WS_W3T); const bf16_t* A2 = (const bf16_t*)(a.ws + WS_A2); float* FK = (float*)(a.ws + WS_FK);
    const int lane = F.lane, r32 = lane & 31, hi = lane >> 5, cb = item & 63, tg = item >> 6, od = cb >> 4, cblk = cb & 15, o = od >> 1, dir = od & 1;
    const int wcol0 = od * D + q * 512 + cblk * 32;
    bf16x8 afr[4];
#pragma unroll
    for (int s = 0; s < 4; ++s) afr[s] = *(const bf16x8*)(W3T + (size_t)(wcol0 + r32) * 64 + 16 * s + 8 * hi);
    float delta[16];
#pragma unroll
    for (int r = 0; r < 16; ++r) { const int d = q * 512 + cblk * 32 + att::crow(r, hi); delta[r] = 3.0701134573253945f + (float)d * (12.280453829301578f / 2047.0f); }
    bf16x8 bfa[8][4];
#pragma unroll
    for (int i = 0; i < 8; ++i)
#pragma unroll
        for (int s = 0; s < 4; ++s) bfa[i][s] = *(const bf16x8*)(A2 + (size_t)((tg * 8 + i) * 32 + r32) * 64 + 16 * s + 8 * hi);
#pragma unroll
    for (int i = 0; i < 8; ++i) {
        const int tt0 = (tg * 8 + i) * 32, ls = tt0 >= LP, n = tt0 - (ls ? LP : 0) + r32, L = ls ? LS : LP;
        f32x16 acc = {};
#pragma unroll
        for (int s = 0; s < 4; ++s) acc = __builtin_amdgcn_mfma_f32_32x32x16_bf16(afr[s], bfa[i][s], acc, 0, 0, 0);
        const float tn = (float)n / (float)(L - 1);
        float* base = FK + (ls ? FK_SAMPLE_OFF : (size_t)0) + (size_t)dir * L + n;
        const size_t pitch = ls ? FK_PITCH_S : FK_PITCH_P;
#pragma unroll
        for (int r = 0; r < 16; ++r) { const int c = cblk * 32 + att::crow(r, hi);
            base[(size_t)(o * 512 + c) * pitch] = acc[r] * (__expf(-tn * delta[r]) + 0.05f); }
    }
}
__device__ __forceinline__ void hy_phase_a(const Frame& F, const Args& a, int q, bool do_back = true) {
    LAS float* tile = (LAS float*)(F.lds + F.wave * 17408);
    if (q < 4) for (int it = F.gw; it < 64 * 96; it += F.NGW) hy_filter_item(F, a, q, it);
    if (q > 0 && do_back) for (int it = F.gw; it < 768 * 8; it += F.NGW) hy_transpose_back_item(F, a, q - 1, it, tile);
}
__device__ __forceinline__ void hy_phase_c(const Frame& F, const Args& a, int q) {
    const bf16_t* UT = (const bf16_t*)(a.ws + WS_UT); float* FK = (float*)(a.ws + WS_FK); bf16_t* ZT = (bf16_t*)(a.ws + WS_ZT);
    const float* skip = a.in[I_HSKIP];
    for (int c = F.vcu; c < 512; c += F.G) {
        hy::kernel_fft_unit<14, 1>(F, FK + FK_SAMPLE_OFF + (size_t)c * FK_PITCH_S, 0);
        hy::kernel_fft_unit<14, 1>(F, FK + FK_SAMPLE_OFF + (size_t)(512 + c) * FK_PITCH_S, 0);
        hy::kernel_fft_unit<13, 2>(F, FK + (size_t)c * FK_PITCH_P, (size_t)512 * FK_PITCH_P);
        VM_WAIT(); __syncthreads();
        if (F.wave == 0) { __builtin_amdgcn_fence(__ATOMIC_ACQUIRE, "agent"); VM_WAIT(); }
        __syncthreads();
        const int d = q * 512 + c; const float s0 = skip[d], s1 = skip[D + d];
        { const bf16_t* ub = UT + (size_t)seq_start(4) * (3 * D);
          hy::conv_unit<14, 1>(F, ub + (size_t)d * LS, ub + (size_t)(D + d) * LS, ub + (size_t)(2 * D + d) * LS, 0,
                               FK + FK_SAMPLE_OFF + (size_t)c * FK_PITCH_S, FK + FK_SAMPLE_OFF + (size_t)(512 + c) * FK_PITCH_S, s0, s1, ZT + (size_t)seq_start(4) * 512 + (size_t)c * LS, 0); }
#pragma unroll 1
        for (int s = 0; s < 4; s += 2) { const bf16_t* ub = UT + (size_t)seq_start(s) * (3 * D);
          hy::conv_unit<13, 2>(F, ub + (size_t)d * LP, ub + (size_t)(D + d) * LP, ub + (size_t)(2 * D + d) * LP, (size_t)LP * (3 * D),
                               FK + (size_t)c * FK_PITCH_P, FK + (size_t)(512 + c) * FK_PITCH_P, s0, s1, ZT + (size_t)seq_start(s) * 512 + (size_t)c * LP, (size_t)LP * 512); }
    }
    __syncthreads();
}
#ifndef MK_MULTI_LAUNCH
#define MK_MULTI_LAUNCH 0
#endif
#ifndef PROBE
#define PROBE 0
#endif
#ifndef EN_MASK
#define EN_MASK 0xff
#endif
#define EN_GEMM ((EN_MASK) & 1)
#define EN_ATT  ((EN_MASK) & 2)
#define EN_HYA  ((EN_MASK) & 4)
#define EN_HYB  ((EN_MASK) & 8)
#define EN_HYC  ((EN_MASK) & 16)
#define EN_MISC ((EN_MASK) & 32)
constexpr int NPH = 41;
constexpr int CW_BAR = 4096;

__device__ __forceinline__ const float* modrow(const Args& a, int layer) { return (const float*)(a.ws + WS_MOD) + (size_t)layer * NB * 6 * D; }

__global__ void __launch_bounds__(NTHREADS, 2) fwd_kernel(Args a) {
    extern __shared__ __attribute__((aligned(16))) unsigned char lds_raw[];
    Frame F0;
    Frame& F = F0;
    F.lds = (LAS unsigned char*)lds_raw;
    F.tid = threadIdx.x; F.lane = F.tid & 63; F.wave = __builtin_amdgcn_readfirstlane(F.tid >> 6);
    F.G = gridDim.x; { const int bx = blockIdx.x; F.vcu = (F.G % 8 == 0) ? (bx % 8) * (F.G / 8) + bx / 8 : bx; }
    F.gw = F.vcu * NWAVES + F.wave; F.NGW = F.G * NWAVES;
    volatile LAS unsigned* MISC = (volatile LAS unsigned*)(F.lds + MISC_OFF);
    if (F.tid < 64) MISC[F.tid] = 0u;
    __syncthreads();
    unsigned* ctl = (unsigned*)(a.ws + WS_CTL);
    const int lo = a.ph_lo, hi = a.ph_hi;
    XcdBarrier bar; bar.bar = ctl + CW_BAR + a.li * XCD_BAR_WORDS; bar.x = 0; bar.st = MISC + 8;
    if (hi - lo > 1) bar = xcd_barrier_post(ctl + CW_BAR + a.li * XCD_BAR_WORDS, MISC + 8);
    int ph = 0;
#define PH_BEGIN if (ph >= lo && ph < hi) { Frame F = F0; { int t_ = threadIdx.x; asm volatile("" : "+v"(t_)); F.tid = t_; F.lane = t_ & 63; }
#define PH_END   if (ph + 1 < hi) { xcd_barrier(bar); if (PROBE == 9) xcd_barrier(bar); } } ++ph;

    bf16_t* const H = (bf16_t*)(a.ws + WS_H); bf16_t* const M1 = (bf16_t*)(a.ws + WS_M1);
    float* const out = a.out;
    const int bx = (int)blockIdx.x;

    bf16_t* const XB = (bf16_t*)(a.ws + WS_XB);
#define NORM_N1(layer) do { NormP p{a.in[I_XP], a.in[I_XS], nullptr, nullptr, nullptr, nullptr, nullptr, 0, nullptr, modrow(a, layer), D, 0, a.in[I_NMPRE] + (layer) * D, H}; if (EN_MISC) norm_phase(F, p); } while (0)
#define NORM_N2(layer, MPTR) do { NormP p{a.in[I_XP], a.in[I_XS], (layer) == 0 ? nullptr : XB, nullptr, XB, MPTR, modrow(a, layer), 2 * D, a.in[I_NMPOST] + (layer) * D, modrow(a, layer), 4 * D, 3 * D, a.in[I_NFPRE] + (layer) * D, H}; \
        if (EN_MISC) norm_phase(F, p); if (PROBE == 4) { NormP p2 = p; p2.xbout = (bf16_t*)(a.ws + 512 * MiB); p2.H = (bf16_t*)(a.ws + 704 * MiB); norm_phase(F, p2); } } while (0)
#define NORM_N3(layer) do { NormP p{nullptr, nullptr, XB, (layer) + 1 < NLAYER ? nullptr : out, (layer) + 1 < NLAYER ? XB : nullptr, M1, modrow(a, layer), 5 * D, a.in[I_NFPOST] + (layer) * D, modrow(a, (layer) + 1 < NLAYER ? (layer) + 1 : (layer)), D, 0, \
        a.in[I_NMPRE] + ((layer) + 1 < NLAYER ? (layer) + 1 : (layer)) * D, (layer) + 1 < NLAYER ? H : nullptr}; if (EN_MISC) norm_phase(F, p); \
        if (PROBE == 4 && (layer) + 1 < NLAYER) { NormP p2 = p; p2.xbout = (bf16_t*)(a.ws + 512 * MiB); p2.H = (bf16_t*)(a.ws + 704 * MiB); norm_phase(F, p2); } } while (0)
#define GEMM_PHASE(Aptr, Bptr, LDA, LDB, KK, AGRP, MM, NN, Optr, LDC, BIAS, SCALE) do { pg8::Gemm g{Aptr, Bptr, LDA, LDB, KK, AGRP}; pg8::StaticOrder S; S.init(MM, NN, F.G, bx); \
        pg8::EpiBf16 E{Optr, LDC, BIAS, SCALE}; for (int rep8 = 0; rep8 < ((PROBE == 8 && (KK) != DFF) ? 2 : 1); ++rep8) { if (EN_GEMM) pg8::gemm_phase<false, pg8::EpiBf16, pg8::StaticOrder>(F.lds, g, S, E); } } while (0)
#define FFN_LAYER(layer) do { \
        PH_BEGIN for (int rep = 0; rep < (PROBE == 1 ? 2 : 1); ++rep) { pg8::Gemm g{H, (const bf16_t*)(a.ws + WS_WUP), D, D, D, 0}; pg8::StaticOrder S; S.init(T, 2 * DFF, F.G, bx); \
            pg8::EpiGlu E{(bf16_t*)(a.ws + WS_U), (bf16_t*)(a.ws + WS_EA), (bf16_t*)(a.ws + WS_EB), a.in[I_FCW] + (size_t)(layer) * 3 * DFF, a.in[I_FCB] + (size_t)(layer) * DFF, DFF}; \
            if (EN_GEMM) pg8::gemm_phase<true, pg8::EpiGlu, pg8::StaticOrder>(F.lds, g, S, E); } PH_END \
        PH_BEGIN if (EN_MISC) ffn_fix_phase(F, (const bf16_t*)(a.ws + WS_EA), (const bf16_t*)(a.ws + WS_EB), (bf16_t*)(a.ws + WS_U), a.in[I_FCW] + (size_t)(layer) * 3 * DFF, a.in[I_FCB] + (size_t)(layer) * DFF); PH_END \
        PH_BEGIN for (int rep = 0; rep < (PROBE == 1 ? 2 : 1); ++rep) { GEMM_PHASE((const bf16_t*)(a.ws + WS_U), (const bf16_t*)(a.ws + WS_WDN), DFF, DFF, DFF, 0, T, D, M1, D, nullptr, nullptr); } PH_END \
        PH_BEGIN NORM_N3(layer); if ((layer) + 1 < NLAYER) { __syncthreads(); prep_ffn_weights(F, a, (layer) + 1); if (PROBE == 7) prep_ffn_weights(F, a, (layer) + 1); } PH_END \
    } while (0)
#define POOL_LAYER(layer, j) do { \
        PH_BEGIN for (int rep = 0; rep < ((PROBE == 4 || PROBE == 11) ? 2 : 1); ++rep) { if (EN_MISC) pool_phase(F, H, (bf16_t*)(a.ws + WS_P)); } PH_END \
        PH_BEGIN GEMM_PHASE((const bf16_t*)(a.ws + WS_P), (const bf16_t*)(a.ws + WS_POOLW) + (size_t)(j) * D * 512, D, 512, 512, 2, T, D, M1, D, nullptr, a.in[I_POOLS] + (j) * D); PH_END \
    } while (0)

    PH_BEGIN for (int rep = 0; rep < (PROBE == 7 ? 2 : 1); ++rep) { if (EN_MISC) prologue_phase(F, a); __syncthreads(); } PH_END

    PH_BEGIN NORM_N1(0); __syncthreads(); prep_ffn_weights(F, a, 0); if (PROBE == 7) prep_ffn_weights(F, a, 0); PH_END
    POOL_LAYER(0, 0);
    PH_BEGIN NORM_N2(0, M1); PH_END
    FFN_LAYER(0);

    PH_BEGIN { pg8::Gemm g{H, (const bf16_t*)(a.ws + WS_HYWIN), D, D, D, 0}; pg8::StaticOrder S; S.init(T, 3 * D, F.G, bx);
        pg8::EpiHyT E{(bf16_t*)(a.ws + WS_UT), (bf16_t*)(a.ws + WS_EU), a.in[I_HBIN], a.in[I_HCW], a.in[I_HCB], 3 * D};
        for (int rep8 = 0; rep8 < (PROBE == 8 ? 2 : 1); ++rep8) { if (EN_GEMM) pg8::gemm_phase<true, pg8::EpiHyT, pg8::StaticOrder>(F.lds, g, S, E); } } PH_END
    for (int q = 0; q < 4; ++q) {
        PH_BEGIN if (EN_HYA) { if (q == 0) hy_fix_phase(F, a); hy_phase_a(F, a, q); } PH_END
        PH_BEGIN if (EN_HYC) hy_phase_c(F, a, q); PH_END
    }
    PH_BEGIN if (EN_HYA) hy_phase_a(F, a, 4); PH_END
    PH_BEGIN GEMM_PHASE(H, (const bf16_t*)(a.ws + WS_HYWOUT), D, D, D, 0, T, D, (bf16_t*)(a.ws + WS_M1H), D, nullptr, nullptr); PH_END
    PH_BEGIN NORM_N2(1, (const bf16_t*)(a.ws + WS_M1H)); PH_END
    FFN_LAYER(1);

    PH_BEGIN GEMM_PHASE(H, (const bf16_t*)(a.ws + WS_ATQKV), D, D, D, 0, T, 3072, (bf16_t*)(a.ws + WS_QKV), 3072, nullptr, nullptr); PH_END
    PH_BEGIN if (EN_MISC) qk_norm_rope_phase(F, (bf16_t*)(a.ws + WS_QKV), a.in[I_AQG], a.in[I_AKG]); PH_END
    PH_BEGIN for (int rep = 0; rep < (PROBE == 2 ? 2 : 1); ++rep) { if (EN_ATT) attn_phase(F, (const bf16_t*)(a.ws + WS_QKV), (bf16_t*)(a.ws + WS_O)); } PH_END
    PH_BEGIN GEMM_PHASE((const bf16_t*)(a.ws + WS_O), (const bf16_t*)(a.ws + WS_ATWO), D, D, D, 0, T, D, M1, D, nullptr, nullptr); PH_END
    PH_BEGIN NORM_N2(2, M1); PH_END
    FFN_LAYER(2);

    POOL_LAYER(3, 1);
    PH_BEGIN NORM_N2(3, M1); PH_END
    FFN_LAYER(3);
}

__global__ void k_fail_fill(float* out, size_t n) { for (size_t i = (size_t)blockIdx.x * blockDim.x + threadIdx.x; i < n; i += (size_t)gridDim.x * blockDim.x) out[i] = __builtin_nanf(""); }

extern "C" void kernel_launch(void* const* d_in, const int* in_sizes, int n_in, void* d_out, int out_size, void* d_ws, size_t ws_size, hipStream_t stream) {
    static int grid = 0;
    if (grid == 0) {
        int dev = 0, cus = 0, per_cu = 0;
        if (n_in != 32 || out_size != T * D || ws_size < WS_END) {
            fprintf(stderr, "kernel_launch: shape/workspace mismatch: n_in %d out %d ws %zu (need %zu)\n", n_in, out_size, ws_size, (size_t)WS_END); grid = -1; }
        else if (hipGetDevice(&dev) != hipSuccess || hipDeviceGetAttribute(&cus, hipDeviceAttributeMultiprocessorCount, dev) != hipSuccess) grid = -1;
        else if (hipFuncSetAttribute((const void*)fwd_kernel, hipFuncAttributeMaxDynamicSharedMemorySize, LDS_BYTES) != hipSuccess) grid = -1;
        else {
            if (hipOccupancyMaxActiveBlocksPerMultiprocessor(&per_cu, (const void*)fwd_kernel, NTHREADS, LDS_BYTES) != hipSuccess || per_cu < 1)
                fprintf(stderr, "kernel_launch: occupancy query reports %d workgroups per CU\n", per_cu);
            (void)hipGetLastError();
            grid = cus;
        }
    }
    if (grid < 0) { hipLaunchKernelGGL(k_fail_fill, dim3(1024), dim3(256), 0, stream, (float*)d_out, (size_t)out_size); return; }
    (void)hipMemsetAsync((char*)d_ws + WS_CTL, 0, CTL_ZERO_BYTES, stream);
    Args a{};
    for (int i = 0; i < 32; ++i) a.in[i] = (const float*)d_in[i];
    a.out = (float*)d_out; a.ws = (unsigned char*)d_ws;
#if MK_MULTI_LAUNCH
    for (int k = 0; k < NPH; ++k) { a.ph_lo = k; a.ph_hi = k + 1; a.li = k; a.pad = 0;
        hipLaunchKernelGGL(fwd_kernel, dim3(grid), dim3(NTHREADS), LDS_BYTES, stream, a); }
#else
    a.ph_lo = 0; a.ph_hi = NPH; a.li = 0; a.pad = 0;
    hipLaunchKernelGGL(fwd_kernel, dim3(grid), dim3(NTHREADS), LDS_BYTES, stream, a);
#endif
    const hipError_t le = hipPeekAtLastError();
    if (le != hipSuccess) fprintf(stderr, "kernel_launch: launch failed: %s\n", hipGetErrorName(le));
}
```

```cpp
#include <hip/hip_runtime.h>
#include <cstdio>
#include <cstdint>

#define LAS __attribute__((address_space(3)))
#define GAS __attribute__((address_space(1)))
typedef unsigned short bf16_t;
typedef short bf16x8 __attribute__((ext_vector_type(8)));
typedef short s16x4 __attribute__((ext_vector_type(4)));
typedef float f32x2 __attribute__((ext_vector_type(2)));
typedef float f32x4 __attribute__((ext_vector_type(4)));
typedef float f32x16 __attribute__((ext_vector_type(16)));
typedef unsigned u32x2 __attribute__((ext_vector_type(2)));
typedef unsigned u32x4 __attribute__((ext_vector_type(4)));

constexpr int D = 2048, T = 49152, DFF = 5632, NLAYER = 4, NB = 5;
constexpr int LP = 8192, LS = 16384, TP = 32768;
constexpr float EPS = 1e-6f;
__device__ __forceinline__ int seq_of_row(int r) { return r < TP ? (r >> 13) : 4; }
__device__ __forceinline__ int seq_start(int s) { return s << 13; }
__device__ __forceinline__ int seq_len(int s) { return s < 4 ? LP : LS; }

__device__ __forceinline__ unsigned cvt_pk_bf16(float lo, float hi) { unsigned r; asm volatile("v_cvt_pk_bf16_f32 %0, %1, %2" : "=v"(r) : "v"(lo), "v"(hi)); return r; }
__device__ __forceinline__ float bf_lo(unsigned w) { return __uint_as_float(w << 16); }
__device__ __forceinline__ float bf_hi(unsigned w) { return __uint_as_float(w & 0xffff0000u); }
__device__ __forceinline__ float bf1(bf16_t h) { return __uint_as_float(((unsigned)h) << 16); }
__device__ __forceinline__ bf16_t f2bf(float f) { return (bf16_t)(cvt_pk_bf16(f, 0.f) & 0xffffu); }
__device__ __forceinline__ float wave_sum(float v) {
#pragma unroll
    for (int o = 1; o < 64; o <<= 1) v += __shfl_xor(v, o);
    return v;
}

namespace pg8 {
constexpr int BM = 256, BK = 64, HALF = 128, HTB = HALF * BK * 2, STAGE_BYTES = 8 * HTB, NXCD = 8, WGM = 8;
__host__ __device__ __forceinline__ int lds_byte(int r, int c) { const int st = (r >> 4) * 2 + (c >> 5), rr = r & 15, cc = c & 31, ob = rr * 64 + cc * 2; return st * 1024 + (ob ^ (((ob >> 9) & 1) << 5)); }
__host__ __device__ __forceinline__ void stage_rc(int b, int& R, int& C) { const int st = b / 1024, sb = b % 1024, swz = sb ^ (((sb >> 9) & 1) << 5); R = (st >> 1) * 16 + swz / 64; C = (st & 1) * 32 + (swz % 64) / 2; }
__host__ __device__ __forceinline__ int perm32(int rho) { const int n = rho >> 4, i = rho & 15; return 8 * (i >> 2) + 4 * n + (i & 3); }

struct Unit { int pm, pn; };
struct Gemm { const bf16_t* A; const bf16_t* Bt; int lda, ldb, K, agrp; };

struct StaticOrder {
    int nM, nN, nwg, G, c;
    __device__ void init(int M, int N, int G_, int c_) { nM = M / BM; nN = N / BM; nwg = nM * nN; G = G_; c = c_; }
    __device__ bool next(int i, Unit& u) const {
        const long L = (long)i * G + c; if (L >= nwg) return false;
        int wgid = (int)L; { const int q = nwg / NXCD, r = nwg % NXCD, xcd = wgid % NXCD, off = wgid / NXCD; wgid = (xcd < r ? xcd * (q + 1) : r * (q + 1) + (xcd - r) * q) + off; }
        const int nig = WGM * nN, gid = wgid / nig, fm = gid * WGM, gsz = (nM - fm) < WGM ? (nM - fm) : WGM;
        u.pm = fm + ((wgid % nig) % gsz); u.pn = (wgid % nig) / gsz; return true;
    }
};

struct EpiBf16 {
    bf16_t* O; int ldc; const float* bias; const float* scale;
    __device__ __forceinline__ void prefetch(LAS unsigned char*, const Unit&, int, int) const {}
    __device__ __forceinline__ void operator()(const f32x4 (&acc)[2][2][4][2], const Unit& u, int wr, int wc, int fr, int fq, const LAS unsigned char*) const {
        asm volatile("" ::: "memory");
        const int row0 = u.pm * BM + wr * 64 + fr, col0 = u.pn * BM + wc * 32 + 8 * fq;
        f32x4 bv[2][2], sv[2][2];
#pragma unroll
        for (int bj = 0; bj < 2; ++bj)
#pragma unroll
            for (int n = 0; n < 2; ++n) {
                bv[bj][n] = bias ? *(const f32x4*)(bias + col0 + bj * HALF + 4 * n) : (f32x4){0.f, 0.f, 0.f, 0.f};
                sv[bj][n] = scale ? *(const f32x4*)(scale + col0 + bj * HALF + 4 * n) : (f32x4){1.f, 1.f, 1.f, 1.f}; }
#pragma unroll
        for (int ai = 0; ai < 2; ++ai)
#pragma unroll
            for (int m = 0; m < 4; ++m) { bf16_t* rowp = O + (size_t)(row0 + ai * HALF + m * 16) * ldc + col0;
#pragma unroll
                for (int bj = 0; bj < 2; ++bj) { f32x4 v0 = acc[ai][bj][m][0], v1 = acc[ai][bj][m][1];
                    if (bias) { v0 += bv[bj][0]; v1 += bv[bj][1]; }
                    if (scale) { v0 *= sv[bj][0]; v1 *= sv[bj][1]; }
                    u32x4 w; w.x = cvt_pk_bf16(v0[0], v0[1]); w.y = cvt_pk_bf16(v0[2], v0[3]); w.z = cvt_pk_bf16(v1[0], v1[1]); w.w = cvt_pk_bf16(v1[2], v1[3]);
                    *(u32x4*)(rowp + bj * HALF) = w; } }
    }
};

__device__ __forceinline__ float gelu_tanh_f(float x) {
    const float arg = x * __builtin_fmaf(x * x, -0.10294323970f, -2.30220819814f);
    return x * __builtin_amdgcn_rcpf(1.0f + __builtin_amdgcn_exp2f(arg));
}
__device__ __forceinline__ f32x2 gelu_tanh_2(f32x2 x) {
    const f32x2 arg = x * __builtin_elementwise_fma(x * x, (f32x2){-0.10294323970f, -0.10294323970f}, (f32x2){-2.30220819814f, -2.30220819814f});
    const f32x2 d = (f32x2){__builtin_amdgcn_exp2f(arg.x), __builtin_amdgcn_exp2f(arg.y)} + (f32x2){1.0f, 1.0f};
    return x * (f32x2){__builtin_amdgcn_rcpf(d.x), __builtin_amdgcn_rcpf(d.y)};
}
__device__ __forceinline__ float dpp_shr1(float v) { return __int_as_float(__builtin_amdgcn_update_dpp(0, __float_as_int(v), 0x111, 0xf, 0xf, false)); }
__device__ __forceinline__ float dpp_shl1(float v) { return __int_as_float(__builtin_amdgcn_update_dpp(0, __float_as_int(v), 0x101, 0xf, 0xf, false)); }
__device__ __forceinline__ u32x4 pack8(const f32x4 a, const f32x4 b) { u32x4 w; w.x = cvt_pk_bf16(a[0], a[1]); w.y = cvt_pk_bf16(a[2], a[3]); w.z = cvt_pk_bf16(b[0], b[1]); w.w = cvt_pk_bf16(b[2], b[3]); return w; }
struct EpiGlu {
    bf16_t* U; bf16_t* EA; bf16_t* EB; const float* cw; const float* cb; int dff;
    __device__ __forceinline__ void prefetch(LAS unsigned char* wslot, const Unit& u, int wc, int lane) const {
        const int chw = u.pn * HALF + wc * 32 + (lane & 31);
        const float* g0 = (lane < 32) ? cw + chw : cw + dff + chw;
        const float* g1 = (lane < 32) ? cw + 2 * dff + chw : cb + chw;
        __builtin_amdgcn_global_load_lds((const unsigned*)g0, (LAS unsigned*)wslot, 4, 0, 0);
        __builtin_amdgcn_global_load_lds((const unsigned*)g1, (LAS unsigned*)(wslot + 256), 4, 0, 0);
    }
    __device__ __forceinline__ void operator()(const f32x4 (&acc)[2][2][4][2], const Unit& u, int wr, int wc, int fr, int fq, const LAS unsigned char* wslot) const {
        asm volatile("" ::: "memory");
        const int ch0 = u.pn * HALF + wc * 32 + 8 * fq;
        f32x4 w0[2], w1[2], w2[2], bb[2], pv[2], nx[2];
        const LAS float* wsl = (const LAS float*)wslot + 8 * fq;
#pragma unroll
        for (int n = 0; n < 2; ++n) { w0[n] = *(const LAS f32x4*)(wsl + 4 * n); w1[n] = *(const LAS f32x4*)(wsl + 32 + 4 * n); w2[n] = *(const LAS f32x4*)(wsl + 64 + 4 * n); bb[n] = *(const LAS f32x4*)(wsl + 96 + 4 * n);
#pragma unroll
            for (int j = 0; j < 4; ++j) { pv[n][j] = dpp_shr1(acc[1][0][3][n][j]); nx[n][j] = dpp_shl1(acc[0][0][0][n][j]); } }
        const size_t tok0 = (size_t)u.pm * BM + 128 * wr + 8 * fr;
#pragma unroll
        for (int k = 0; k < 8; ++k) {
            f32x4 o[2];
            {
                f32x2 y[4], yg[4], tt[4], dd[4], rr[4];
#pragma unroll
                for (int q = 0; q < 4; ++q) { const int n = q >> 1;
                    const f32x4 ap4 = (k == 0) ? pv[n] : acc[(k - 1) >> 2][0][(k - 1) & 3][n], ac4 = acc[k >> 2][0][k & 3][n], an4 = (k == 7) ? nx[n] : acc[(k + 1) >> 2][0][(k + 1) & 3][n], gt4 = acc[k >> 2][1][k & 3][n];
                    const f32x2 ap = (q & 1) ? ap4.hi : ap4.lo, ac = (q & 1) ? ac4.hi : ac4.lo, an = (q & 1) ? an4.hi : an4.lo, gt = (q & 1) ? gt4.hi : gt4.lo;
                    const f32x2 c0 = (q & 1) ? w0[n].hi : w0[n].lo, c1 = (q & 1) ? w1[n].hi : w1[n].lo, c2 = (q & 1) ? w2[n].hi : w2[n].lo, cb2 = (q & 1) ? bb[n].hi : bb[n].lo;
                    y[q] = __builtin_elementwise_fma(c2, an, __builtin_elementwise_fma(c1, ac, __builtin_elementwise_fma(c0, ap, cb2)));
                    yg[q] = y[q] * gt; }
#pragma unroll
                for (int q = 0; q < 4; ++q) tt[q] = y[q] * y[q];
#pragma unroll
                for (int q = 0; q < 4; ++q) tt[q] = __builtin_elementwise_fma(tt[q], (f32x2){-0.10294323970f, -0.10294323970f}, (f32x2){-2.30220819814f, -2.30220819814f});
#pragma unroll
                for (int q = 0; q < 4; ++q) tt[q] = y[q] * tt[q];
#pragma unroll
                for (int q = 0; q < 4; ++q) dd[q] = (f32x2){__builtin_amdgcn_exp2f(tt[q].x), __builtin_amdgcn_exp2f(tt[q].y)};
#pragma unroll
                for (int q = 0; q < 4; ++q) dd[q] = dd[q] + (f32x2){1.0f, 1.0f};
#pragma unroll
                for (int q = 0; q < 4; ++q) rr[q] = (f32x2){__builtin_amdgcn_rcpf(dd[q].x), __builtin_amdgcn_rcpf(dd[q].y)};
#pragma unroll
                for (int q = 0; q < 4; ++q) rr[q] = yg[q] * rr[q];
                o[0] = (f32x4){rr[0].x, rr[0].y, rr[1].x, rr[1].y}; o[1] = (f32x4){rr[2].x, rr[2].y, rr[3].x, rr[3].y};
            }
            const bool edge = (k == 0 && fr == 0) || (k == 7 && fr == 15);
            if (!edge) *(u32x4*)(U + (tok0 + k) * dff + ch0) = pack8(o[0], o[1]);
        }
        const size_t hb = (size_t)u.pm * 2 + wr;
        if (fr == 0) { *(u32x4*)(EA + (hb * 4 + 0) * dff + ch0) = pack8(acc[0][0][0][0], acc[0][0][0][1]); *(u32x4*)(EA + (hb * 4 + 1) * dff + ch0) = pack8(acc[0][0][1][0], acc[0][0][1][1]);
                       *(u32x4*)(EB + (hb * 2 + 0) * dff + ch0) = pack8(acc[0][1][0][0], acc[0][1][0][1]); }
        if (fr == 15) { *(u32x4*)(EA + (hb * 4 + 2) * dff + ch0) = pack8(acc[1][0][2][0], acc[1][0][2][1]); *(u32x4*)(EA + (hb * 4 + 3) * dff + ch0) = pack8(acc[1][0][3][0], acc[1][0][3][1]);
                        *(u32x4*)(EB + (hb * 2 + 1) * dff + ch0) = pack8(acc[1][1][3][0], acc[1][1][3][1]); }
    }
};

struct EpiHyT {
    bf16_t* UT; bf16_t* EU; const float* bin; const float* cw; const float* cb; int ncol;
    __device__ __forceinline__ void prefetch(LAS unsigned char* wslot, const Unit& u, int wc, int lane) const {
        const int c = u.pn * BM + (lane >> 5) * HALF + wc * 32 + (lane & 31);
        __builtin_amdgcn_global_load_lds((const unsigned*)(bin + c), (LAS unsigned*)wslot, 4, 0, 0);
        __builtin_amdgcn_global_load_lds((const unsigned*)(cw + c), (LAS unsigned*)(wslot + 256), 4, 0, 0);
        __builtin_amdgcn_global_load_lds((const unsigned*)(cw + ncol + c), (LAS unsigned*)(wslot + 512), 4, 0, 0);
        __builtin_amdgcn_global_load_lds((const unsigned*)(cw + 2 * ncol + c), (LAS unsigned*)(wslot + 768), 4, 0, 0);
        __builtin_amdgcn_global_load_lds((const unsigned*)(cb + c), (LAS unsigned*)(wslot + 1024), 4, 0, 0);
    }
    __device__ __forceinline__ void operator()(const f32x4 (&acc)[2][2][4][2], const Unit& u, int wr, int wc, int fr, int fq, const LAS unsigned char* wslot) const {
        asm volatile("" ::: "memory");
        const int row0 = u.pm * BM + 128 * wr, s = seq_of_row(row0), L = seq_len(s), tl0 = row0 - seq_start(s) + 8 * fr;
        bf16_t* base = UT + (size_t)seq_start(s) * ncol + tl0;
        const size_t hb = (size_t)u.pm * 2 + wr;
#pragma unroll
        for (int bj = 0; bj < 2; ++bj)
#pragma unroll
            for (int n = 0; n < 2; ++n) {
                const int c0 = u.pn * BM + bj * HALF + wc * 32 + 8 * fq + 4 * n;
                const LAS float* wsl = (const LAS float*)wslot + bj * 32 + 8 * fq + 4 * n;
                const f32x4 bi = *(const LAS f32x4*)wsl, w0 = *(const LAS f32x4*)(wsl + 64), w1 = *(const LAS f32x4*)(wsl + 128), w2 = *(const LAS f32x4*)(wsl + 192), bb = *(const LAS f32x4*)(wsl + 256);
                f32x4 x[8];
#pragma unroll
                for (int k = 0; k < 8; ++k) x[k] = acc[k >> 2][bj][k & 3][n] + bi;
                f32x4 pv, nx;
#pragma unroll
                for (int j = 0; j < 4; ++j) { pv[j] = dpp_shr1(x[7][j]); nx[j] = dpp_shl1(x[0][j]); }
#pragma unroll
                for (int j = 0; j < 4; ++j) {
                    float y[8];
#pragma unroll
                    for (int k = 0; k < 8; ++k) { const float ap = (k == 0) ? pv[j] : x[k - 1][j], an = (k == 7) ? nx[j] : x[k + 1][j]; y[k] = __builtin_fmaf(w2[j], an, __builtin_fmaf(w1[j], x[k][j], __builtin_fmaf(w0[j], ap, bb[j]))); }
                    u32x4 w; w.x = cvt_pk_bf16(y[0], y[1]); w.y = cvt_pk_bf16(y[2], y[3]); w.z = cvt_pk_bf16(y[4], y[5]); w.w = cvt_pk_bf16(y[6], y[7]);
                    *(u32x4*)(base + (size_t)(c0 + j) * L) = w;
                }
                if (fr == 0) { u32x2 w; w.x = cvt_pk_bf16(x[0][0], x[0][1]); w.y = cvt_pk_bf16(x[0][2], x[0][3]); *(u32x2*)(EU + (hb * 2 + 0) * ncol + c0) = w; }
                if (fr == 15) { u32x2 w; w.x = cvt_pk_bf16(x[7][0], x[7][1]); w.y = cvt_pk_bf16(x[7][2], x[7][3]); *(u32x2*)(EU + (hb * 2 + 1) * ncol + c0) = w; }
            }
    }
};

template <bool ROWPERM, class Epi, class Sched>
__device__ __forceinline__ void gemm_phase(LAS unsigned char* lds, const Gemm g, const Sched& S, const Epi& E) {
    int tid = threadIdx.x; asm volatile("" : "+v"(tid));
    const int wid = __builtin_amdgcn_readfirstlane(tid >> 6), lane = tid & 63, wr = wid >> 2, wc = wid & 3, fr = lane & 15, fq = lane >> 4;
    const int K = g.K, nt = K / BK;
    unsigned voffA[2], voffB[2];
#pragma unroll
    for (int i = 0; i < 2; ++i) { int R, C; stage_rc(tid * 16 + i * 8192, R, C); const int Rb = (R & ~31) + perm32(R & 31);
        const int Ra = ROWPERM ? (128 * (R >> 6) + 8 * (R & 15) + ((R >> 4) & 3)) : R;
        voffA[i] = (unsigned)(Ra * g.lda + C) * 2u; voffB[i] = (unsigned)(Rb * g.ldb + C) * 2u; }
    const size_t kstep = (size_t)(BK * 2);
    const size_t hstepA = (size_t)(ROWPERM ? 4 : HALF) * g.lda * 2, hstepB = (size_t)HALF * g.ldb * 2;
    const unsigned ldsw = (unsigned)wid * 1024u;
    const int aoff = lds_byte(wr * 64 + fr, fq * 8), boff = lds_byte(wc * 32 + fr, fq * 8);
#define PG8_SA(b, h) (((b) * 2 + (h)) * HTB)
#define PG8_SB(b, h) ((4 + (b) * 2 + (h)) * HTB)
#define PG8_STAGE(bufoff, gbase, voff) do { _Pragma("unroll") for (int _i = 0; _i < 2; ++_i) \
        __builtin_amdgcn_global_load_lds((const unsigned*)((const char*)(gbase) + (voff)[_i]), (LAS unsigned*)(lds + (bufoff) + ldsw + _i * 8192), 16, 0, 0); } while (0)
#define PG8_LDA(dst, b, h) do { _Pragma("unroll") for (int m = 0; m < 4; ++m) _Pragma("unroll") for (int k = 0; k < 2; ++k) dst[m][k] = *(const LAS bf16x8*)(lds + PG8_SA(b, h) + aoff + m * 2048 + k * 1024); } while (0)
#define PG8_LDB(dst, b, h) do { _Pragma("unroll") for (int n = 0; n < 2; ++n) _Pragma("unroll") for (int k = 0; k < 2; ++k) dst[n][k] = *(const LAS bf16x8*)(lds + PG8_SB(b, h) + boff + n * 2048 + k * 1024); } while (0)
#define PG8_MMA(ai, bj, At, Bt) do { __builtin_amdgcn_s_setprio(1); _Pragma("unroll") for (int m = 0; m < 4; ++m) _Pragma("unroll") for (int n = 0; n < 2; ++n) _Pragma("unroll") for (int k = 0; k < 2; ++k) \
        acc[ai][bj][m][n] = __builtin_amdgcn_mfma_f32_16x16x32_bf16(Bt[n][k], At[m][k], acc[ai][bj][m][n], 0, 0, 0); __builtin_amdgcn_s_setprio(0); } while (0)
#define PG8_WAIT_V(n) asm volatile("s_waitcnt vmcnt(" #n ")" ::: "memory")
#define PG8_WAIT_L(n) asm volatile("s_waitcnt lgkmcnt(" #n ")" ::: "memory")
#define PG8_BAR __builtin_amdgcn_s_barrier()
#define PG8_SCHED __builtin_amdgcn_sched_barrier(0)
#define PG8_ABASE(u) ((const char*)g.A + ((size_t)(u).pm * BM * g.lda + (g.agrp ? (size_t)((u).pn / g.agrp) * K : (size_t)0)) * 2)
#define PG8_BBASE(u) ((const char*)g.Bt + (size_t)(u).pn * BM * g.ldb * 2)
    Unit cur, nxt; int ui = 0;
    if (!S.next(0, cur)) return;
    f32x4 acc[2][2][4][2];
#pragma unroll
    for (int a = 0; a < 2; ++a)
#pragma unroll
        for (int b = 0; b < 2; ++b)
#pragma unroll
            for (int m = 0; m < 4; ++m)
#pragma unroll
                for (int n = 0; n < 2; ++n) acc[a][b][m][n] = (f32x4){0.f, 0.f, 0.f, 0.f};
    bf16x8 At[4][2], B0[2][2], B1[2][2];
    const char* cA = PG8_ABASE(cur); const char* cB = PG8_BBASE(cur);
    PG8_STAGE(PG8_SB(0, 0), cB, voffB); PG8_STAGE(PG8_SA(0, 0), cA, voffA); PG8_STAGE(PG8_SB(0, 1), cB + hstepB, voffB); PG8_STAGE(PG8_SA(0, 1), cA + hstepA, voffA);
    if (wr == 1) PG8_BAR;
    PG8_WAIT_V(4); PG8_BAR;
    PG8_STAGE(PG8_SB(1, 0), cB + kstep, voffB); PG8_STAGE(PG8_SA(1, 0), cA + kstep, voffA); PG8_STAGE(PG8_SB(1, 1), cB + hstepB + kstep, voffB);
    PG8_WAIT_V(6); PG8_BAR;
    LAS unsigned char* const wslot = lds + STAGE_BYTES + wid * 1536;
    for (;;) {
        E.prefetch(wslot, cur, wc, lane);
        const bool has_next = S.next(ui + 1, nxt);
        const char* nA = has_next ? PG8_ABASE(nxt) : cA; const char* nB = has_next ? PG8_BBASE(nxt) : cB;
        for (int t = 0; t < nt; t += 2) {
            const bool last = (t == nt - 2);
            const char* a1 = cA + (size_t)(t + 1) * kstep;
            const char* a2 = last ? nA : cA + (size_t)(t + 2) * kstep; const char* b2 = last ? nB : cB + (size_t)(t + 2) * kstep;
            const char* a3 = a2 + kstep; const char* b3 = b2 + kstep;
            PG8_LDB(B0, 0, 0); PG8_SCHED; PG8_LDA(At, 0, 0); PG8_STAGE(PG8_SA(1, 1), a1 + hstepA, voffA);
            PG8_WAIT_L(8); PG8_BAR; PG8_WAIT_L(0); PG8_MMA(0, 0, At, B0); PG8_BAR; PG8_SCHED;
            PG8_LDB(B1, 0, 1); PG8_STAGE(PG8_SB(0, 0), b2, voffB);
            PG8_BAR; PG8_WAIT_L(0); PG8_MMA(0, 1, At, B1); PG8_BAR;
            PG8_LDA(At, 0, 1); PG8_STAGE(PG8_SA(0, 0), a2, voffA);
            PG8_BAR; PG8_WAIT_L(0); PG8_MMA(1, 0, At, B0); PG8_BAR; PG8_SCHED;
            PG8_STAGE(PG8_SB(0, 1), b2 + hstepB, voffB);
            PG8_WAIT_V(6); PG8_BAR; PG8_MMA(1, 1, At, B1); PG8_BAR;
            PG8_LDB(B0, 1, 0); PG8_SCHED; PG8_LDA(At, 1, 0); PG8_STAGE(PG8_SA(0, 1), a2 + hstepA, voffA);
            PG8_WAIT_L(8); PG8_BAR; PG8_WAIT_L(0); PG8_MMA(0, 0, At, B0); PG8_BAR; PG8_SCHED;
            PG8_LDB(B1, 1, 1); PG8_STAGE(PG8_SB(1, 0), b3, voffB);
            PG8_BAR; PG8_WAIT_L(0); PG8_MMA(0, 1, At, B1); PG8_BAR;
            PG8_LDA(At, 1, 1); PG8_STAGE(PG8_SA(1, 0), a3, voffA);
            PG8_BAR; PG8_WAIT_L(0); PG8_MMA(1, 0, At, B0); PG8_BAR; PG8_SCHED;
            PG8_STAGE(PG8_SB(1, 1), b3 + hstepB, voffB);
            PG8_WAIT_V(6); PG8_BAR; PG8_MMA(1, 1, At, B1); PG8_BAR;
        }
        E(acc, cur, wr, wc, fr, fq, wslot);
        if (!has_next) break;
#pragma unroll
        for (int a = 0; a < 2; ++a)
#pragma unroll
            for (int b = 0; b < 2; ++b)
#pragma unroll
                for (int m = 0; m < 4; ++m)
#pragma unroll
                    for (int n = 0; n < 2; ++n) acc[a][b][m][n] = (f32x4){0.f, 0.f, 0.f, 0.f};
        cur = nxt; cA = nA; cB = nB; ++ui;
    }
    PG8_WAIT_V(0);
    if (wr == 0) PG8_BAR;
    PG8_BAR;
#undef PG8_SA
#undef PG8_SB
#undef PG8_STAGE
#undef PG8_LDA
#undef PG8_LDB
#undef PG8_MMA
#undef PG8_WAIT_V
#undef PG8_WAIT_L
#undef PG8_BAR
#undef PG8_SCHED
#undef PG8_ABASE
#undef PG8_BBASE
}
}
namespace att {
constexpr int HD = 128, NW = 8, QBLK = 32, KVBLK = 64;
constexpr float SCALE = 0.088388347648318440f;
constexpr float THR = 8.f;
constexpr int LDQ = 3072, LDK = 3072, LDO = 2048;
constexpr int SHM_V = KVBLK * HD * 2, SHM_K = KVBLK * HD * 2, SHM_ATTN = 2 * SHM_V + 2 * SHM_K + NW * 64 * 4;
#define KSWZ(row, colB) ((row) * 256 + ((colB) ^ (((row) & 7) << 4)))
#define SBAR() __builtin_amdgcn_sched_barrier(0)
__device__ __forceinline__ int crow(int r, int hi) { return (r & 3) + 8 * (r >> 2) + 4 * hi; }

__device__ __forceinline__ void partialSM(f32x16& p0, f32x16& p1, float& m_reg, float& mn, float& alpha) {
  constexpr float C = SCALE * 1.4426950408889634f;
  float pmax = p0[0];
#pragma unroll
  for (int r = 1; r < 16; ++r) pmax = fmaxf(pmax, p0[r]);
#pragma unroll
  for (int r = 0; r < 16; ++r) pmax = fmaxf(pmax, p1[r]);
  { auto rr = __builtin_amdgcn_permlane32_swap(__float_as_uint(pmax), __float_as_uint(pmax), false, false);
    pmax = fmaxf(__uint_as_float(rr[0]), __uint_as_float(rr[1])); }
  if (__builtin_expect(__all(pmax - m_reg <= THR / SCALE), 1)) { mn = m_reg; alpha = 1.f; }
  else { mn = fmaxf(m_reg, pmax); alpha = __builtin_amdgcn_exp2f((m_reg - mn) * C); m_reg = mn; }
  float mnC = -mn * C;
#pragma unroll
  for (int r = 0; r < 16; ++r) p0[r] = fmaf(p0[r], C, mnC);
#pragma unroll
  for (int r = 0; r < 16; ++r) p1[r] = fmaf(p1[r], C, mnC);
#pragma unroll
  for (int r = 0; r < 16; ++r) p0[r] = __builtin_amdgcn_exp2f(p0[r]);
}
__device__ __forceinline__ void finishSM(f32x16& p0, f32x16& p1, float alpha, float& l_reg, bf16x8& pa0, bf16x8& pa1, bf16x8& pa2, bf16x8& pa3) {
#pragma unroll
  for (int r = 0; r < 16; ++r) p1[r] = __builtin_amdgcn_exp2f(p1[r]);
  float ps = 0;
#pragma unroll
  for (int r = 0; r < 16; ++r) ps += p0[r];
#pragma unroll
  for (int r = 0; r < 16; ++r) ps += p1[r];
  { auto rr = __builtin_amdgcn_permlane32_swap(__float_as_uint(ps), __float_as_uint(ps), false, false);
    ps = __uint_as_float(rr[0]) + __uint_as_float(rr[1]); }
  l_reg = l_reg * alpha + ps;
#define PK4(P, BASE, OUT) do { unsigned a0 = cvt_pk_bf16(P[BASE + 0], P[BASE + 1]), a1 = cvt_pk_bf16(P[BASE + 2], P[BASE + 3]);   \
    unsigned b0 = cvt_pk_bf16(P[BASE + 4], P[BASE + 5]), b1 = cvt_pk_bf16(P[BASE + 6], P[BASE + 7]);                              \
    auto r0 = __builtin_amdgcn_permlane32_swap(a0, b0, false, false); auto r1 = __builtin_amdgcn_permlane32_swap(a1, b1, false, false); \
    u32x4 w = {r0[0], r1[0], r0[1], r1[1]}; OUT = *reinterpret_cast<bf16x8*>(&w); } while (0)
  PK4(p0, 0, pa0); PK4(p0, 8, pa1); PK4(p1, 0, pa2); PK4(p1, 8, pa3);
#undef PK4
}
__device__ __forceinline__ void qkt(f32x16& p0, f32x16& p1, const bf16_t* Ks, const bf16x8* qr, int r32, int hi) {
  p0 = f32x16{}; p1 = f32x16{};
#pragma unroll
  for (int d0 = 0; d0 < 8; ++d0) { int cb = (d0 * 16 + hi * 8) * 2;
    bf16x8 b0 = *reinterpret_cast<const bf16x8*>((const char*)Ks + KSWZ(r32, cb));
    bf16x8 b1 = *reinterpret_cast<const bf16x8*>((const char*)Ks + KSWZ(32 + r32, cb));
    p0 = __builtin_amdgcn_mfma_f32_32x32x16_bf16(b0, qr[d0], p0, 0, 0, 0);
    p1 = __builtin_amdgcn_mfma_f32_32x32x16_bf16(b1, qr[d0], p1, 0, 0, 0); }
}
__device__ __forceinline__ int v_st(int k, int c) { const int kk = (k & ~0xC) | ((k & 4) << 1) | ((k & 8) >> 1); return ((kk >> 3) * 4 + (c >> 5)) * 512 + ((kk & 7) * 32 + (c & 31)) * 2; }
__device__ __forceinline__ int v_rd_base(int lane) { return ((lane & 3) << 3) | (((lane >> 2) & 3) << 6) | (((lane >> 4) & 1) << 5) | (((lane >> 5) & 1) << 8); }
constexpr int v_rd_off(int d0, int ks, int half) { return d0 * 512 + ks * 4096 + half * 2048; }
template <int OFF> __device__ __forceinline__ s16x4 tr_read(int vb) {
  s16x4 r; asm volatile("ds_read_b64_tr_b16 %0, %1 offset:%2" : "=&v"(r) : "v"(vb), "i"(OFF) : "memory"); return r;
}
template <int D0> __device__ __forceinline__ void pv_one(f32x16& od, int vb, bf16x8 pa0, bf16x8 pa1, bf16x8 pa2, bf16x8 pa3) {
  const s16x4 l0 = tr_read<v_rd_off(D0, 0, 0)>(vb), h0 = tr_read<v_rd_off(D0, 0, 1)>(vb), l1 = tr_read<v_rd_off(D0, 1, 0)>(vb), h1 = tr_read<v_rd_off(D0, 1, 1)>(vb);
  const s16x4 l2 = tr_read<v_rd_off(D0, 2, 0)>(vb), h2 = tr_read<v_rd_off(D0, 2, 1)>(vb), l3 = tr_read<v_rd_off(D0, 3, 0)>(vb), h3 = tr_read<v_rd_off(D0, 3, 1)>(vb);
  asm volatile("s_waitcnt lgkmcnt(0)" ::: "memory"); SBAR();
#define PK(L, H) (bf16x8){L[0], L[1], L[2], L[3], H[0], H[1], H[2], H[3]}
  od = __builtin_amdgcn_mfma_f32_32x32x16_bf16(PK(l0, h0), pa0, od, 0, 0, 0);
  od = __builtin_amdgcn_mfma_f32_32x32x16_bf16(PK(l1, h1), pa1, od, 0, 0, 0);
  od = __builtin_amdgcn_mfma_f32_32x32x16_bf16(PK(l2, h2), pa2, od, 0, 0, 0);
  od = __builtin_amdgcn_mfma_f32_32x32x16_bf16(PK(l3, h3), pa3, od, 0, 0, 0);
#undef PK
}
__device__ __forceinline__ void pv_d0(f32x16* o, int vb, bf16x8 pa0, bf16x8 pa1, bf16x8 pa2, bf16x8 pa3) {
  pv_one<0>(o[0], vb, pa0, pa1, pa2, pa3); pv_one<1>(o[1], vb, pa0, pa1, pa2, pa3); pv_one<2>(o[2], vb, pa0, pa1, pa2, pa3); pv_one<3>(o[3], vb, pa0, pa1, pa2, pa3);
}

__device__ __forceinline__ void attn_dense_body(const bf16_t* __restrict__ Qb, const bf16_t* __restrict__ Kh, const bf16_t* __restrict__ Vh,
                                                bf16_t* __restrict__ Ob, int seq, char* lds) {
  int tid = threadIdx.x; asm volatile("" : "+v"(tid));
  const int wid = tid >> 6, lane = tid & 63, r32 = lane & 31, hi = lane >> 5;
  bf16_t* V_lds = (bf16_t*)lds; bf16_t* K_lds = (bf16_t*)(lds + 2 * SHM_V);
  float* ws = (float*)(lds + 2 * SHM_V + 2 * SHM_K) + wid * 64; float* li_l = ws; float* al_l = ws + 32;
  float m_reg = -1e30f, l_reg = 0; f32x16 o[4] = {}; bf16x8 qr[8];
  const bf16_t* Qw = Qb + (long)(wid * QBLK + r32) * LDQ + hi * 8;
#pragma unroll
  for (int d0 = 0; d0 < 8; ++d0) qr[d0] = *reinterpret_cast<const bf16x8*>(Qw + d0 * 16);
  const int sr = tid >> 4, sc = (tid & 15) * 8, vst0 = v_st(sr, sc), vst1 = v_st(32 + sr, sc);
  const int vb0 = (int)(uintptr_t)V_lds + v_rd_base(lane);
  struct { bf16x8 vs0, vs1, ks0, ks1; } sr_[2];
#define SLOAD(i, k0) do { sr_[i].vs0 = *reinterpret_cast<const bf16x8*>(&Vh[(long)((k0) + sr) * LDK + sc]); sr_[i].vs1 = *reinterpret_cast<const bf16x8*>(&Vh[(long)((k0) + 32 + sr) * LDK + sc]); \
    sr_[i].ks0 = *reinterpret_cast<const bf16x8*>(&Kh[(long)((k0) + sr) * LDK + sc]); sr_[i].ks1 = *reinterpret_cast<const bf16x8*>(&Kh[(long)((k0) + 32 + sr) * LDK + sc]); } while (0)
#define SWRITE(b, i) do { *(bf16x8*)((char*)V_lds + (b) * SHM_V + vst0) = sr_[i].vs0;          \
    *(bf16x8*)((char*)V_lds + (b) * SHM_V + vst1) = sr_[i].vs1; int kc = sc * 2;               \
    *(bf16x8*)((char*)K_lds + (b) * SHM_K + KSWZ(sr, kc)) = sr_[i].ks0;                       \
    *(bf16x8*)((char*)K_lds + (b) * SHM_K + KSWZ(32 + sr, kc)) = sr_[i].ks1; } while (0)
#define SWAIT() asm volatile("s_waitcnt vmcnt(4)" ::: "memory")
#define RESC(a) do { if (__any((a) < 1.f)) { const float _al = (a); \
    _Pragma("unroll") for (int d = 0; d < 4; ++d) _Pragma("unroll") for (int r = 0; r < 16; ++r) o[d][r] *= _al; } } while (0)
  f32x16 pA0, pA1, pB0, pB1; float mnA, mnB, alA, alB; bf16x8 pa0, pa1, pa2, pa3; const int NT = seq / KVBLK;
  constexpr int SE = 0, SO = 1;
  SLOAD(SE, 0); asm volatile("s_waitcnt vmcnt(0)" ::: "memory"); SWRITE(0, SE); __syncthreads();
  qkt(pA0, pA1, K_lds, qr, r32, hi); partialSM(pA0, pA1, m_reg, mnA, alA);
  SLOAD(SO, KVBLK); if (2 < NT) SLOAD(SE, 2 * KVBLK);
  SWAIT(); SWRITE(1, SO); __syncthreads();
  for (int j = 1; j + 1 < NT; j += 2) {
    SBAR(); qkt(pB0, pB1, (bf16_t*)((char*)K_lds + SHM_K), qr, r32, hi);
    finishSM(pA0, pA1, alA, l_reg, pa0, pa1, pa2, pa3); SBAR();
    SLOAD(SO, (j + 2) * KVBLK); SBAR();
    pv_d0(o, vb0, pa0, pa1, pa2, pa3); partialSM(pB0, pB1, m_reg, mnB, alB);
    __syncthreads(); SWAIT(); SWRITE(0, SE);
    RESC(alB); __syncthreads();
    SBAR(); qkt(pA0, pA1, K_lds, qr, r32, hi);
    finishSM(pB0, pB1, alB, l_reg, pa0, pa1, pa2, pa3); SBAR();
    if (j + 3 < NT) SLOAD(SE, (j + 3) * KVBLK); SBAR();
    pv_d0(o, vb0 + (int)SHM_V, pa0, pa1, pa2, pa3); partialSM(pA0, pA1, m_reg, mnA, alA);
    __syncthreads(); SWAIT(); SWRITE(1, SO);
    RESC(alA); __syncthreads();
  }
  SBAR(); qkt(pB0, pB1, (bf16_t*)((char*)K_lds + SHM_K), qr, r32, hi);
  finishSM(pA0, pA1, alA, l_reg, pa0, pa1, pa2, pa3); SBAR();
  pv_d0(o, vb0, pa0, pa1, pa2, pa3); partialSM(pB0, pB1, m_reg, mnB, alB);
  __syncthreads(); RESC(alB);
  finishSM(pB0, pB1, alB, l_reg, pa0, pa1, pa2, pa3); SBAR();
  pv_d0(o, vb0 + (int)SHM_V, pa0, pa1, pa2, pa3);
  const float rl = __builtin_amdgcn_rcpf(l_reg);
  bf16_t* Ow = Ob + (long)(wid * QBLK + r32) * LDO + hi * 8;
#pragma unroll
  for (int d0 = 0; d0 < 4; ++d0)
#pragma unroll
    for (int g = 0; g < 4; g += 2) {
      unsigned ax = cvt_pk_bf16(o[d0][4 * g + 0] * rl, o[d0][4 * g + 1] * rl), ay = cvt_pk_bf16(o[d0][4 * g + 2] * rl, o[d0][4 * g + 3] * rl);
      unsigned bx = cvt_pk_bf16(o[d0][4 * g + 4] * rl, o[d0][4 * g + 5] * rl), by = cvt_pk_bf16(o[d0][4 * g + 6] * rl, o[d0][4 * g + 7] * rl);
      { auto r0 = __builtin_amdgcn_permlane32_swap(ax, bx, false, false); ax = r0[0]; bx = r0[1]; }
      { auto r1 = __builtin_amdgcn_permlane32_swap(ay, by, false, false); ay = r1[0]; by = r1[1]; }
      u32x4 w = {ax, ay, bx, by};
      *reinterpret_cast<u32x4*>(Ow + d0 * 32 + 8 * g) = w;
    }
#undef SLOAD
#undef SWRITE
#undef SWAIT
#undef RESC
}
#undef KSWZ
#undef SBAR
}
#define XB_TMO      128
#define XB_XCNT(j)  (256  + 64 * (j))
#define XB_XSUB(j)  (1280 + 64 * (j))
#define XB_XGEN(j)  (2304 + 64 * (j))
#define XB_TOP      3328
#define XB_TOPGEN   3392
#define XCD_BAR_WORDS 3456
#define XB_SPIN_CAP (1u << 22)

__device__ __forceinline__ unsigned xb_ld(unsigned* p)              { return __hip_atomic_load(p, __ATOMIC_RELAXED, __HIP_MEMORY_SCOPE_AGENT); }
__device__ __forceinline__ unsigned xb_add(unsigned* p, unsigned v) { return __hip_atomic_fetch_add(p, v, __ATOMIC_RELAXED, __HIP_MEMORY_SCOPE_AGENT); }
__device__ __forceinline__ unsigned xb_xcc_id() { return (unsigned)__builtin_amdgcn_s_getreg((3 << 11) | 20) & 0xFu; }
#define XB_SPIN(cond, bar) do { unsigned _sp = 0; while (cond) { __builtin_amdgcn_s_sleep(1); \
    if ((++_sp & 255u) == 0u) { if (xb_ld(&(bar)[XB_TMO])) break; if (_sp > XB_SPIN_CAP) { atomicAdd(&(bar)[XB_TMO], 1u); break; } } } } while (0)

struct XcdBarrier { unsigned* bar; unsigned x; volatile LAS unsigned* st; };

__device__ __forceinline__ XcdBarrier xcd_barrier_post(unsigned* bar, volatile LAS unsigned* st) {
    XcdBarrier b; b.bar = bar; b.x = xb_xcc_id(); b.st = st;
    if (threadIdx.x == 0) (void)xb_add(&bar[XB_XCNT(b.x)], 1u);
    return b;
}
__device__ __forceinline__ void xcd_barrier_complete(unsigned* bar, unsigned x, unsigned& nloc, unsigned& nx) {
    const unsigned G = gridDim.x * gridDim.y * gridDim.z;
    unsigned sum, cnt, mine, sp = 0u;
    for (;;) {
        sum = 0u; cnt = 0u; mine = 0u;
#pragma unroll
        for (unsigned j = 0; j < 16; ++j) { const unsigned c = xb_ld(&bar[XB_XCNT(j)]); sum += c; cnt += (c > 0u) ? 1u : 0u; mine = (j == x) ? c : mine; }
        if (sum == G) break;
        __builtin_amdgcn_s_sleep(1);
        if ((++sp & 255u) == 0u) { if (xb_ld(&bar[XB_TMO])) break; if (sp > XB_SPIN_CAP) { atomicAdd(&bar[XB_TMO], 1u); break; } }
    }
    nloc = mine > 0u ? mine : 1u; nx = cnt > 0u ? cnt : 1u;
}
__device__ __forceinline__ void xcd_barrier(const XcdBarrier& b) {
    asm volatile("s_waitcnt vmcnt(0)" ::: "memory");
    __syncthreads();
    if (threadIdx.x == 0) {
        unsigned* bar = b.bar;
        __builtin_amdgcn_s_waitcnt(0);
        unsigned nloc = b.st[0], nx = b.st[1];
        if (nloc == 0u) { xcd_barrier_complete(bar, b.x, nloc, nx); b.st[0] = nloc; b.st[1] = nx; }
        const unsigned old = xb_add(&bar[XB_XSUB(b.x)], 1u);
        const unsigned gen = old / nloc;
        if (old + 1u == (gen + 1u) * nloc) {
            __builtin_amdgcn_fence(__ATOMIC_RELEASE, "agent");
            asm volatile("s_waitcnt vmcnt(0)" ::: "memory");
            const unsigned og = xb_add(&bar[XB_TOP], 1u);
            const unsigned tg = og / nx;
            if (og + 1u == (tg + 1u) * nx) xb_add(&bar[XB_TOPGEN], 1u);
            else XB_SPIN(xb_ld(&bar[XB_TOPGEN]) == tg, bar);
            __builtin_amdgcn_fence(__ATOMIC_ACQUIRE, "agent");
            xb_add(&bar[XB_XGEN(b.x)], 1u);
            asm volatile("s_waitcnt vmcnt(0)" ::: "memory");
        } else {
            XB_SPIN(xb_ld(&bar[XB_XGEN(b.x)]) == gen, bar);
            __builtin_amdgcn_fence(__ATOMIC_ACQUIRE, "agent");
            asm volatile("s_waitcnt vmcnt(0)" ::: "memory");
        }
    }
    __syncthreads();
}
#define LDS_WAIT() asm volatile("s_waitcnt lgkmcnt(0)" ::: "memory")
#define VM_WAIT() asm volatile("s_waitcnt vmcnt(0)" ::: "memory")
constexpr int NWAVES = 8, NTHREADS = 512;
constexpr int LDS_BYTES = 147456;
constexpr int MISC_OFF = 140 * 1024;

struct Args { const float* in[32]; float* out; unsigned char* ws; int ph_lo, ph_hi, li, pad; };
struct Frame { LAS unsigned char* lds; int tid, lane, wave, vcu, G, gw, NGW; };

enum { I_XP = 0, I_XS, I_CP, I_CS, I_MODW, I_MODB, I_NMPRE, I_NMPOST, I_NFPRE, I_NFPOST, I_FUP, I_FCW, I_FCB, I_FDN, I_POOLW, I_POOLS,
       I_HWIN, I_HBIN, I_HCW, I_HCB, I_HFW1, I_HFB1, I_HFW2, I_HFB2, I_HFW3, I_HFREQ, I_HSKIP, I_HWOUT, I_AQKV, I_AQG, I_AKG, I_AWO };

constexpr size_t MiB = 1u << 20;
constexpr size_t WS_CTL = 0, CTL_ZERO_BYTES = 1 * MiB;
constexpr size_t WS_MOD = 1 * MiB;
constexpr size_t WS_A2 = 2 * MiB;
constexpr size_t WS_W3T = 5 * MiB;
constexpr size_t WS_POOLW = 6 * MiB;
constexpr size_t WS_HYWIN = 10 * MiB;
constexpr size_t WS_HYWOUT = 34 * MiB;
constexpr size_t WS_ATQKV = 42 * MiB;
constexpr size_t WS_ATWO = 54 * MiB;
constexpr size_t WS_WUP = 62 * MiB;
constexpr size_t WS_WDN = 106 * MiB;
constexpr size_t WS_H = 128 * MiB;
constexpr size_t WS_M1 = 320 * MiB;
constexpr size_t WS_BIG = 512 * MiB;
constexpr size_t WS_U = WS_BIG, WS_EA = WS_BIG + 528 * MiB, WS_EB = WS_BIG + 548 * MiB;
constexpr size_t WS_QKV = WS_BIG, WS_O = WS_BIG + 288 * MiB;
constexpr size_t WS_P = WS_BIG;
constexpr size_t WS_UT = 320 * MiB;
constexpr size_t WS_EU = 896 * MiB;
constexpr size_t WS_FK = 906 * MiB;
constexpr size_t WS_ZT = 1099 * MiB;
constexpr size_t WS_M1H = WS_M1;
constexpr size_t WS_XB = 1147 * MiB;
constexpr size_t WS_END = 1339 * MiB;
constexpr int FK_PITCH_P = 2 * LP + 32, FK_PITCH_S = 2 * LS + 32;
constexpr size_t FK_SAMPLE_OFF = (size_t)2 * 512 * FK_PITCH_P;

__device__ __forceinline__ unsigned pk2(float lo, float hi) { return cvt_pk_bf16(lo, hi); }
template <bool GLUMAP = false>
__device__ __forceinline__ void transpose_item(const float* W, int N, bf16_t* WT, int ldk, LAS float* scr, int item, int lane) {
    const int nblk = N / 32, kb = item / nblk, nb = item % nblk, k0 = 64 * kb, n0 = 32 * nb;
    const int d0 = GLUMAP ? (((n0 % DFF) / 128) * 256 + (n0 / DFF) * 128 + (n0 % 128)) : n0;
    { f32x4 v[8]; const int kr = lane >> 3, ch = (lane & 7) * 4;
#pragma unroll
      for (int i = 0; i < 8; ++i) v[i] = *(const f32x4*)(W + (size_t)(k0 + kr + 8 * i) * N + n0 + ch);
#pragma unroll
      for (int i = 0; i < 8; ++i) { LAS float* d = scr + (kr + 8 * i) * 33 + ch; d[0] = v[i].x; d[1] = v[i].y; d[2] = v[i].z; d[3] = v[i].w; } }
    LDS_WAIT();
    const int c = lane & 7;
#pragma unroll
    for (int j = 0; j < 4; ++j) { const int n = (lane >> 3) + 8 * j; const LAS float* s = scr + (8 * c) * 33 + n;
        u32x4 o; o.x = pk2(s[0 * 33], s[1 * 33]); o.y = pk2(s[2 * 33], s[3 * 33]); o.z = pk2(s[4 * 33], s[5 * 33]); o.w = pk2(s[6 * 33], s[7 * 33]);
        *(u32x4*)(WT + (size_t)(d0 + n) * ldk + k0 + 8 * c) = o; }
    LDS_WAIT();
}
template <bool GLUMAP = false>
__device__ __forceinline__ void prep_matrix(const Frame& F, const float* W, int K, int N, bf16_t* WT) {
    LAS float* scr = (LAS float*)(F.lds + F.wave * 8448);
    const int nitems = (K / 64) * (N / 32);
    for (int it = F.gw; it < nitems; it += F.NGW) transpose_item<GLUMAP>(W, N, WT, K, scr, it, F.lane);
}
__device__ __forceinline__ void prep_ffn_weights(const Frame& F, const Args& a, int layer) {
    prep_matrix<true>(F, a.in[I_FUP] + (size_t)layer * D * 2 * DFF, D, 2 * DFF, (bf16_t*)(a.ws + WS_WUP));
    prep_matrix(F, a.in[I_FDN] + (size_t)layer * DFF * D, DFF, D, (bf16_t*)(a.ws + WS_WDN));
}

__device__ __forceinline__ void mod_phase(const Frame& F, const Args& a) {
    LAS float* cact = (LAS float*)F.lds;
    LAS float* red = (LAS float*)(F.lds + 40960);
    for (int i = F.tid; i < NB * D; i += NTHREADS) { const int b = i / D, k = i % D; const float c = b < 4 ? a.in[I_CP][b * D + k] : a.in[I_CS][k]; cact[i] = c / (1.0f + __expf(-c)); }
    __syncthreads();
    const int rg = F.tid >> 4, cl = F.tid & 15;
    for (int u = F.vcu; u < NLAYER * 192; u += F.G) {
        const int layer = u / 192, col0 = (u % 192) * 64;
        const float* W = a.in[I_MODW] + (size_t)layer * D * 6 * D + col0 + cl * 4;
        f32x4 acc[NB];
#pragma unroll
        for (int b = 0; b < NB; ++b) acc[b] = (f32x4){0.f, 0.f, 0.f, 0.f};
#pragma unroll 8
        for (int k = rg; k < D; k += 32) { const f32x4 w = *(const f32x4*)(W + (size_t)k * 6 * D);
#pragma unroll
            for (int b = 0; b < NB; ++b) acc[b] += w * cact[b * D + k]; }
#pragma unroll
        for (int b = 0; b < NB; ++b) *(LAS f32x4*)(red + (rg * NB + b) * 64 + cl * 4) = acc[b];
        __syncthreads();
        if (F.tid < NB * 64) { const int b = F.tid >> 6, c = F.tid & 63; float s = 0.f;
            for (int r = 0; r < 32; ++r) s += red[(r * NB + b) * 64 + c];
            ((float*)(a.ws + WS_MOD))[((size_t)layer * NB + b) * 6 * D + col0 + c] = s + a.in[I_MODB][(size_t)layer * 6 * D + col0 + c]; }
        __syncthreads();
    }
}

__device__ __forceinline__ void hyena_features(const Frame& F, const Args& a) {
    const float* w1 = a.in[I_HFW1]; const float* b1 = a.in[I_HFB1]; const float* w2 = a.in[I_HFW2]; const float* b2 = a.in[I_HFB2]; const float* fr = a.in[I_HFREQ];
    bf16_t* A2 = (bf16_t*)(a.ws + WS_A2);
    const int lane = F.lane; const float freq = fr[lane], bb1 = b1[lane], bb2 = b2[lane];
    for (int t = F.gw; t < LP + LS; t += F.NGW) {
        const int ls = t >= LP, n = ls ? t - LP : t, L = ls ? LS : LP;
        const float tn = (float)n / (float)(L - 1), w = 6.283185307179586f * (float)n / (float)L;
        float z = 0.f;
        if (lane == 0) z = tn;
        else if (lane <= 32) { const int k = (lane - 1) & 15; const float f = 1e-4f + (float)k * ((15.0f - 1e-4f) / 15.0f); const float ang = f * w; z = lane <= 16 ? cosf(ang) : -sinf(ang); }
        float s1 = bb1;
#pragma unroll
        for (int i = 0; i < 33; ++i) s1 += __shfl(z, i) * w1[i * 64 + lane];
        const float a1 = sinf(freq * s1);
        float s2 = bb2;
#pragma unroll 16
        for (int i = 0; i < 64; ++i) s2 += __shfl(a1, i) * w2[i * 64 + lane];
        A2[(size_t)t * 64 + lane] = f2bf(sinf(freq * s2));
    }
}

__device__ __forceinline__ void prologue_phase(const Frame& F, const Args& a) {
    prep_matrix(F, a.in[I_HWIN], D, 3 * D, (bf16_t*)(a.ws + WS_HYWIN));
    prep_matrix(F, a.in[I_HWOUT], D, D, (bf16_t*)(a.ws + WS_HYWOUT));
    prep_matrix(F, a.in[I_AQKV], D, 3072, (bf16_t*)(a.ws + WS_ATQKV));
    prep_matrix(F, a.in[I_AWO], D, D, (bf16_t*)(a.ws + WS_ATWO));
    prep_matrix(F, a.in[I_HFW3], 64, 8192, (bf16_t*)(a.ws + WS_W3T));
    for (int jg = 0; jg < 8; ++jg)
        prep_matrix(F, a.in[I_POOLW] + (size_t)jg * 512 * 512, 512, 512, (bf16_t*)(a.ws + WS_POOLW) + (size_t)jg * 512 * 512);
    __syncthreads();
    hyena_features(F, a);
    __syncthreads();
    mod_phase(F, a);
}

struct NormP { const float* xp; const float* xs; const bf16_t* xb; float* xout; bf16_t* xbout; const bf16_t* m; const float* modg; int gate_off; const float* gpost;
               const float* modh; int sc_off, sh_off; const float* gpre; bf16_t* H; };
__device__ __forceinline__ void norm_load_row(const NormP& p, int r, int lane, f32x4 (&xn)[8], u32x4 (&xh)[4], u32x4 (&mn)[4]) {
    if (p.xb) {
#pragma unroll
        for (int j = 0; j < 4; ++j) xh[j] = *(const u32x4*)(p.xb + (size_t)r * D + lane * 8 + 512 * j);
    } else { const float* xr = r < TP ? p.xp + (size_t)r * D : p.xs + (size_t)(r - TP) * D;
#pragma unroll
        for (int j = 0; j < 4; ++j) { xn[2 * j] = *(const f32x4*)(xr + lane * 8 + 512 * j); xn[2 * j + 1] = *(const f32x4*)(xr + lane * 8 + 512 * j + 4); } }
    if (p.m) {
#pragma unroll
        for (int j = 0; j < 4; ++j) mn[j] = *(const u32x4*)(p.m + (size_t)r * D + lane * 8 + 512 * j); }
}
__device__ __forceinline__ void unpack4x2(const u32x4 w, f32x4& a, f32x4& b) { a = (f32x4){bf_lo(w.x), bf_hi(w.x), bf_lo(w.y), bf_hi(w.y)}; b = (f32x4){bf_lo(w.z), bf_hi(w.z), bf_lo(w.w), bf_hi(w.w)}; }
__device__ __forceinline__ u32x4 pack4x2(const f32x4 a, const f32x4 b) { u32x4 w; w.x = pk2(a.x, a.y); w.y = pk2(a.z, a.w); w.z = pk2(b.x, b.y); w.w = pk2(b.z, b.w); return w; }
__device__ __forceinline__ void norm_phase(const Frame& F, const NormP p) {
    LAS float* va = (LAS float*)F.lds; LAS float* vb = va + D; LAS float* vc = vb + D;
    const int lane = F.lane;
    for (int blk = F.vcu; blk < T / 64; blk += F.G) {
        const int r0 = blk * 64, b = seq_of_row(r0);
        f32x4 xn[2][8]; u32x4 xh[2][4], mn[2][4];
#pragma unroll
        for (int q = 0; q < 2; ++q) {
#pragma unroll
            for (int j = 0; j < 8; ++j) xn[q][j] = (f32x4){0.f, 0.f, 0.f, 0.f};
#pragma unroll
            for (int j = 0; j < 4; ++j) { xh[q][j] = (u32x4){0u, 0u, 0u, 0u}; mn[q][j] = (u32x4){0u, 0u, 0u, 0u}; }
            norm_load_row(p, r0 + F.wave * 8 + q, lane, xn[q], xh[q], mn[q]); }
        __syncthreads();
        for (int c = F.tid; c < D; c += NTHREADS) {
            if (p.m) va[c] = p.modg[(size_t)b * 6 * D + p.gate_off + c] * p.gpost[c];
            if (p.H) { vb[c] = p.gpre[c] * (1.0f + p.modh[(size_t)b * 6 * D + p.sc_off + c]); vc[c] = p.modh[(size_t)b * 6 * D + p.sh_off + c]; }
        }
        __syncthreads();
#pragma unroll
        for (int i = 0; i < 8; ++i) {
            const int r = r0 + F.wave * 8 + i, q = i & 1;
            f32x4 x[8]; u32x4 mw[4];
#pragma unroll
            for (int j = 0; j < 4; ++j) { if (p.xb) unpack4x2(xh[q][j], x[2 * j], x[2 * j + 1]); else { x[2 * j] = xn[q][2 * j]; x[2 * j + 1] = xn[q][2 * j + 1]; } mw[j] = mn[q][j]; }
            if (i < 6) norm_load_row(p, r + 2, lane, xn[q], xh[q], mn[q]);
            if (p.m) {
                f32x4 mv[8]; float ss = 0.f;
#pragma unroll
                for (int j = 0; j < 4; ++j) unpack4x2(mw[j], mv[2 * j], mv[2 * j + 1]);
#pragma unroll
                for (int j = 0; j < 8; ++j) ss += (mv[j].x * mv[j].x + mv[j].y * mv[j].y) + (mv[j].z * mv[j].z + mv[j].w * mv[j].w);
                const float rstd = 1.0f / sqrtf(wave_sum(ss) * (1.0f / D) + EPS);
#pragma unroll
                for (int j = 0; j < 8; ++j) { const f32x4 g = *(const LAS f32x4*)(va + lane * 8 + 512 * (j >> 1) + 4 * (j & 1)); x[j] += g * (mv[j] * rstd); }
                if (p.xout) { float* xo = p.xout + (size_t)r * D;
#pragma unroll
                    for (int j = 0; j < 8; ++j) *(f32x4*)(xo + lane * 8 + 512 * (j >> 1) + 4 * (j & 1)) = x[j]; }
                if (p.xbout) { bf16_t* xo = p.xbout + (size_t)r * D;
#pragma unroll
                    for (int j = 0; j < 4; ++j) *(u32x4*)(xo + lane * 8 + 512 * j) = pack4x2(x[2 * j], x[2 * j + 1]); }
            }
            if (p.H) {
                float ss = 0.f;
#pragma unroll
                for (int j = 0; j < 8; ++j) ss += (x[j].x * x[j].x + x[j].y * x[j].y) + (x[j].z * x[j].z + x[j].w * x[j].w);
                const float rstd = 1.0f / sqrtf(wave_sum(ss) * (1.0f / D) + EPS);
                bf16_t* hr = p.H + (size_t)r * D;
#pragma unroll
                for (int j = 0; j < 4; ++j) { f32x4 h[2];
#pragma unroll
                    for (int e = 0; e < 2; ++e) { const int off = lane * 8 + 512 * j + 4 * e; const f32x4 g = *(const LAS f32x4*)(vb + off), s = *(const LAS f32x4*)(vc + off); h[e] = (x[2 * j + e] * rstd) * g + s; }
                    *(u32x4*)(hr + lane * 8 + 512 * j) = pack4x2(h[0], h[1]); }
            }
        }
    }
    __syncthreads();
}

__device__ __forceinline__ void acc8(float (&acc)[8], const u32x4 w, float sg) {
    acc[0] += sg * bf_lo(w.x); acc[1] += sg * bf_hi(w.x); acc[2] += sg * bf_lo(w.y); acc[3] += sg * bf_hi(w.y); acc[4] += sg * bf_lo(w.z); acc[5] += sg * bf_hi(w.z); acc[6] += sg * bf_lo(w.w); acc[7] += sg * bf_hi(w.w); }
__device__ __forceinline__ void pool_phase(const Frame& F, const bf16_t* H, bf16_t* P) {
    const int lane = F.lane;
    for (int u = F.gw; u < (T / 32) * 4; u += F.NGW) {
        const int g = u & 3, seg = u >> 2, t0 = seg * 32, s = seq_of_row(t0), st = seq_start(s), L = seq_len(s);
        const int win = 2 << g, half = win >> 1, col = g * 512 + lane * 8;
        const bf16_t* Hs = H + (size_t)st * D + col;
        float acc[8];
#pragma unroll
        for (int e = 0; e < 8; ++e) acc[e] = 0.f;
        const int tl0 = t0 - st;
        { int lo = tl0 - half; lo = lo < 0 ? 0 : lo; int hi = tl0 + win - half - 1; hi = hi > L - 1 ? L - 1 : hi;
          u32x4 w[16];
#pragma unroll
          for (int k = 0; k < 16; ++k) { const int r = lo + k; w[k] = (r <= hi) ? *(const u32x4*)(Hs + (size_t)r * D) : (u32x4){0u, 0u, 0u, 0u}; }
#pragma unroll
          for (int k = 0; k < 16; ++k) acc8(acc, w[k], 1.0f); }
        for (int i0 = 0; i0 < 32; i0 += 8) {
            u32x4 cen[8], inn[8], outt[8];
#pragma unroll
            for (int k = 0; k < 8; ++k) { const int tl = tl0 + i0 + k;
                cen[k] = *(const u32x4*)(Hs + (size_t)tl * D);
                const int ri = tl + win - half, ro = tl - half;
                inn[k] = (ri < L) ? *(const u32x4*)(Hs + (size_t)ri * D) : (u32x4){0u, 0u, 0u, 0u};
                outt[k] = (ro >= 0) ? *(const u32x4*)(Hs + (size_t)ro * D) : (u32x4){0u, 0u, 0u, 0u}; }
#pragma unroll
            for (int k = 0; k < 8; ++k) { const int tl = tl0 + i0 + k; int lo = tl - half; lo = lo < 0 ? 0 : lo; int hi = tl + win - half - 1; hi = hi > L - 1 ? L - 1 : hi;
                const float inv = 1.0f / (float)(hi - lo + 1); const u32x4 c = cen[k];
                u32x4 o; o.x = pk2(acc[0] * inv - bf_lo(c.x), acc[1] * inv - bf_hi(c.x)); o.y = pk2(acc[2] * inv - bf_lo(c.y), acc[3] * inv - bf_hi(c.y));
                o.z = pk2(acc[4] * inv - bf_lo(c.z), acc[5] * inv - bf_hi(c.z)); o.w = pk2(acc[6] * inv - bf_lo(c.w), acc[7] * inv - bf_hi(c.w));
                *(u32x4*)(P + (size_t)(st + tl) * D + col) = o;
                acc8(acc, inn[k], 1.0f); acc8(acc, outt[k], -1.0f); }
        }
    }
}

__device__ __forceinline__ float gelu_tanh(float x) { return pg8::gelu_tanh_f(x); }
__device__ __forceinline__ void unpack8(const u32x4 w, float (&v)[8]) { v[0] = bf_lo(w.x); v[1] = bf_hi(w.x); v[2] = bf_lo(w.y); v[3] = bf_hi(w.y); v[4] = bf_lo(w.z); v[5] = bf_hi(w.z); v[6] = bf_lo(w.w); v[7] = bf_hi(w.w); }
__device__ __forceinline__ void ffn_fix_phase(const Frame& F, const bf16_t* EA, const bf16_t* EB, bf16_t* U, const float* cw, const float* cb) {
    const int lane = F.lane;
    for (int it = F.gw; it < 384 * 2 * 11; it += F.NGW) {
        const int cbk = it % 11, e = (it / 11) & 1, hb = it / 22, c0 = cbk * 512 + lane * 8;
        const int row = hb * 128 + (e ? 127 : 0), s = seq_of_row(row), pos = row - seq_start(s), L = seq_len(s);
        const u32x4 z4 = (u32x4){0u, 0u, 0u, 0u};
        u32x4 rp, rc, rn, rg;
        if (e == 0) { rp = pos > 0 ? *(const u32x4*)(EA + ((size_t)(hb - 1) * 4 + 3) * DFF + c0) : z4; rc = *(const u32x4*)(EA + ((size_t)hb * 4 + 0) * DFF + c0); rn = *(const u32x4*)(EA + ((size_t)hb * 4 + 1) * DFF + c0);
                      rg = *(const u32x4*)(EB + ((size_t)hb * 2 + 0) * DFF + c0); }
        else { rp = *(const u32x4*)(EA + ((size_t)hb * 4 + 2) * DFF + c0); rc = *(const u32x4*)(EA + ((size_t)hb * 4 + 3) * DFF + c0); rn = pos < L - 1 ? *(const u32x4*)(EA + ((size_t)(hb + 1) * 4 + 0) * DFF + c0) : z4;
               rg = *(const u32x4*)(EB + ((size_t)hb * 2 + 1) * DFF + c0); }
        float prev[8], cur[8], nxt[8], gv[8], o[8];
        unpack8(rp, prev); unpack8(rc, cur); unpack8(rn, nxt); unpack8(rg, gv);
#pragma unroll
        for (int k = 0; k < 8; ++k) { const float y = cw[c0 + k] * prev[k] + cw[DFF + c0 + k] * cur[k] + cw[2 * DFF + c0 + k] * nxt[k] + cb[c0 + k]; o[k] = gelu_tanh(y) * gv[k]; }
        u32x4 w; w.x = pk2(o[0], o[1]); w.y = pk2(o[2], o[3]); w.z = pk2(o[4], o[5]); w.w = pk2(o[6], o[7]);
        *(u32x4*)(U + (size_t)row * DFF + c0) = w;
    }
}

__device__ __forceinline__ void qk_norm_rope_phase(const Frame& F, bf16_t* QKV, const float* qg, const float* kg) {
    const int lane = F.lane, l16 = lane & 15, axis = l16 >> 3, half = (l16 >> 2) & 1, sub = lane >> 4;
    float gq[8], gk[8], inv[8];
#pragma unroll
    for (int j = 0; j < 8; ++j) { gq[j] = qg[l16 * 8 + j]; gk[j] = kg[l16 * 8 + j]; const int i = (l16 & 3) * 8 + j; inv[j] = expf(-9.210340371976184f * (float)(2 * i) / 64.0f) * 0.15915494309189535f; }
    u32x4 raw[5], nxt[5];
#pragma unroll
    for (int st = 0; st < 5; ++st) { raw[st] = (u32x4){0u, 0u, 0u, 0u}; nxt[st] = (u32x4){0u, 0u, 0u, 0u}; }
    if (F.gw < T) {
#pragma unroll
        for (int st = 0; st < 5; ++st) raw[st] = *(const u32x4*)(QKV + (size_t)F.gw * 3072 + (st * 4 + sub) * 128 + l16 * 8); }
    for (int t = F.gw; t < T; t += F.NGW) {
        if (t + F.NGW < T) {
#pragma unroll
            for (int st = 0; st < 5; ++st) nxt[st] = *(const u32x4*)(QKV + (size_t)(t + F.NGW) * 3072 + (st * 4 + sub) * 128 + l16 * 8); }
        const int s = seq_of_row(t), tl = t - seq_start(s); const float pos = (float)(axis == 0 ? (tl >> 6) : (tl & 63));
        float cs[8], sn[8];
#pragma unroll
        for (int j = 0; j < 8; ++j) { const float rev = pos * inv[j]; cs[j] = __builtin_amdgcn_cosf(rev); sn[j] = __builtin_amdgcn_sinf(rev); }
#pragma unroll
        for (int st = 0; st < 5; ++st) {
            const int hh = st * 4 + sub; bf16_t* p = QKV + (size_t)t * 3072 + hh * 128 + l16 * 8;
            float v[8]; unpack8(raw[st], v);
            float ss = 0.f;
#pragma unroll
            for (int j = 0; j < 8; ++j) ss += v[j] * v[j];
            ss += __shfl_xor(ss, 1); ss += __shfl_xor(ss, 2); ss += __shfl_xor(ss, 4); ss += __shfl_xor(ss, 8);
            const float rstd = 1.0f / sqrtf(ss * (1.0f / 128.0f) + EPS);
            float o[8];
#pragma unroll
            for (int j = 0; j < 8; ++j) { const float y = v[j] * rstd * (hh < 16 ? gq[j] : gk[j]); const float pr = __shfl_xor(y, 4);
                o[j] = half == 0 ? (y * cs[j] - pr * sn[j]) : (y * cs[j] + pr * sn[j]); }
            u32x4 w; w.x = pk2(o[0], o[1]); w.y = pk2(o[2], o[3]); w.z = pk2(o[4], o[5]); w.w = pk2(o[6], o[7]);
            *(u32x4*)p = w;
        }
#pragma unroll
        for (int st = 0; st < 5; ++st) raw[st] = nxt[st];
    }
}

__device__ __forceinline__ void attn_unit(const Frame& F, const bf16_t* QKV, bf16_t* O, int s, int head, int qb) {
    const int st = seq_start(s), L = seq_len(s), kvh = head >> 2;
    const bf16_t* Qb = QKV + (size_t)(st + qb * 256) * 3072 + head * 128;
    const bf16_t* Kh = QKV + (size_t)st * 3072 + 2048 + kvh * 128;
    const bf16_t* Vh = QKV + (size_t)st * 3072 + 2560 + kvh * 128;
    bf16_t* Ob = O + (size_t)(st + qb * 256) * D + head * 128;
    __syncthreads();
    att::attn_dense_body(Qb, Kh, Vh, Ob, L, (char*)F.lds);
}
__device__ __forceinline__ void attn_phase(const Frame& F, const bf16_t* QKV, bf16_t* O) {
    const int per = F.G / 8;
    if (F.G == 256) {
        const int xg = F.vcu / per, r = F.vcu % per;
        for (int j = 0; j < 4; ++j) {
            const int kvh = xg >> 1, idx = (xg & 1) * 128 + j * 32 + r, hg = idx >> 6, qb = idx & 63;
            attn_unit(F, QKV, O, 4, kvh * 4 + hg, qb);
        }
        for (int i = 0; i < 8; ++i) {
            const int grp = xg * 2 + (i >> 2), s = grp >> 2, kvh = grp & 3, idx = (i & 3) * 32 + r, hg = idx >> 5, qb = idx & 31;
            attn_unit(F, QKV, O, s, kvh * 4 + hg, qb);
        }
    } else {
        for (int u = F.vcu; u < 64 * 16 + 4 * 32 * 16; u += F.G) {
            if (u < 1024) attn_unit(F, QKV, O, 4, u >> 6, u & 63);
            else { const int v = u - 1024; attn_unit(F, QKV, O, v >> 9, (v >> 5) & 15, v & 31); }
        }
    }
    __syncthreads();
}
namespace hy {
__device__ constexpr float TWC[16] = {1.0f, 0.98078528040323043f, 0.92387953251128674f, 0.83146961230254524f, 0.70710678118654752f, 0.55557023301960218f, 0.38268343236508977f, 0.19509032201612825f,
                                      0.0f, -0.19509032201612825f, -0.38268343236508977f, -0.55557023301960218f, -0.70710678118654752f, -0.83146961230254524f, -0.92387953251128674f, -0.98078528040323043f};
__device__ constexpr float TWS[16] = {0.0f, 0.19509032201612825f, 0.38268343236508977f, 0.55557023301960218f, 0.70710678118654752f, 0.83146961230254524f, 0.92387953251128674f, 0.98078528040323043f,
                                      1.0f, 0.98078528040323043f, 0.92387953251128674f, 0.83146961230254524f, 0.70710678118654752f, 0.55557023301960218f, 0.38268343236508977f, 0.19509032201612825f};
__device__ __forceinline__ f32x2 cmul(f32x2 a, f32x2 b) {
    f32x2 r;
    asm("v_pk_mul_f32 %0, %1, %2 op_sel:[0,0] op_sel_hi:[0,1]\n\t"
        "v_pk_fma_f32 %0, %1, %2, %0 op_sel:[1,1,0] op_sel_hi:[1,0,1] neg_lo:[1,0,0]"
        : "=&v"(r) : "v"(a), "v"(b));
    return r;
}
__device__ __forceinline__ f32x2 cmulc(f32x2 a, f32x2 b) {
    f32x2 r;
    asm("v_pk_mul_f32 %0, %1, %2 op_sel:[0,0] op_sel_hi:[0,1] neg_hi:[0,1]\n\t"
        "v_pk_fma_f32 %0, %1, %2, %0 op_sel:[1,1,0] op_sel_hi:[1,0,1]"
        : "=&v"(r) : "v"(a), "v"(b));
    return r;
}
__device__ __forceinline__ f32x2 pk_add_pm(f32x2 a, f32x2 b) { f32x2 r; asm("v_pk_add_f32 %0, %1, %2 neg_hi:[0,1]" : "=v"(r) : "v"(a), "v"(b)); return r; }
__device__ __forceinline__ f32x2 pk_add_mp(f32x2 a, f32x2 b) { f32x2 r; asm("v_pk_add_f32 %0, %1, %2 neg_lo:[0,1]" : "=v"(r) : "v"(a), "v"(b)); return r; }
__device__ __forceinline__ f32x2 pk_addc(f32x2 a, f32x2 b)   { f32x2 r; asm("v_pk_add_f32 %0, %1, %2 neg_hi:[1,1]" : "=v"(r) : "v"(a), "v"(b)); return r; }
__device__ __forceinline__ f32x2 cconj(f32x2 a) { return (f32x2){a.x, -a.y}; }
__device__ __forceinline__ f32x2 twid(float rev) {
    float c = __builtin_amdgcn_cosf(rev), s = __builtin_amdgcn_sinf(rev);
    asm volatile("s_nop 1" : "+v"(c), "+v"(s));
    return (f32x2){c, -s};
}
__device__ __forceinline__ f32x2 twid_sc(float rev) {
    float c = __builtin_amdgcn_cosf(rev), s = __builtin_amdgcn_sinf(rev);
    asm volatile("s_nop 1" : "+v"(c), "+v"(s));
    return (f32x2){s, c};
}

template <int R, bool INV> __device__ __forceinline__ void dft(f32x2 (&v)[R]) {
    if constexpr (R == 2) { const f32x2 a = v[0], b = v[1]; v[0] = a + b; v[1] = a - b; }
    else {
        constexpr int H = R / 2; f32x2 u[H], w[H];
#pragma unroll
        for (int j = 0; j < H; ++j) { const f32x2 a = v[j], b = v[j + H]; u[j] = a + b; const f32x2 t = a - b;
            const int k = j * (32 / R);
            if (j == 0) w[j] = t;
            else if (4 * j == R) w[j] = INV ? (f32x2){-t.y, t.x} : (f32x2){t.y, -t.x};
            else w[j] = INV ? (f32x2){t.x * TWC[k] - t.y * TWS[k], t.y * TWC[k] + t.x * TWS[k]} : (f32x2){t.x * TWC[k] + t.y * TWS[k], t.y * TWC[k] - t.x * TWS[k]}; }
        dft<H, INV>(u); dft<H, INV>(w);
#pragma unroll
        for (int p = 0; p < H; ++p) { v[2 * p] = u[p]; v[2 * p + 1] = w[p]; }
    }
}
__device__ __forceinline__ int PADI(int p) { return p + (p >> 4) + (p >> 10); }
__device__ __forceinline__ unsigned PADI(unsigned p) { return p + (p >> 4) + (p >> 10); }

__host__ __device__ constexpr int POFF(int x) { return x + (x >> 4) + (x >> 10); }
template <int LOGM> __host__ __device__ constexpr int ZS() { return POFF(1 << LOGM); }
template <int R> __device__ __forceinline__ void twid_powers(f32x2 w1, f32x2 (&w)[R]) {
    w[1] = w1;
#pragma unroll
    for (int p = 2; p < R; ++p) w[p] = (p & 1) ? cmul(w[p - 1], w1) : cmul(w[p >> 1], w[p >> 1]);
}
template <int LOGM, int LOGNS, int LOGR, bool INV, int NZ, bool HALF = false> __device__ __forceinline__ void fft_stage(LAS f32x2* Z, int tid) {
    asm volatile("" : "+v"(tid));
    constexpr int R = 1 << LOGR, LOGSUB = LOGNS - LOGR, SUB = 1 << LOGSUB, NBF = 1 << (LOGM - LOGR);
    constexpr float INVNS = 1.0f / (float)(1 << LOGNS);
#pragma unroll 1
    for (int bf = tid; bf < NBF; bf += NTHREADS) {
        const int j = bf & (SUB - 1), blk = bf >> LOGSUB, base = (blk << LOGNS) + j;
        LAS f32x2* Zb = Z + PADI(base);
        f32x2 v[NZ][R];
#pragma unroll
        for (int z = 0; z < NZ; ++z)
#pragma unroll
            for (int q = 0; q < R; ++q) v[z][q] = (HALF && !INV && q >= R / 2) ? (f32x2){0.f, 0.f} : Zb[z * ZS<LOGM>() + POFF(q << LOGSUB)];
        f32x2 w[R];
        if constexpr (LOGSUB > 0) { const f32x2 t = twid((float)j * INVNS); twid_powers<R>(INV ? cconj(t) : t, w); }
#pragma unroll
        for (int z = 0; z < NZ; ++z) {
            if constexpr (!INV) {
                dft<R, false>(v[z]);
                if constexpr (LOGSUB > 0) {
#pragma unroll
                    for (int p = 1; p < R; ++p) v[z][p] = cmul(v[z][p], w[p]);
                }
            } else {
                if constexpr (LOGSUB > 0) {
#pragma unroll
                    for (int p = 1; p < R; ++p) v[z][p] = cmul(v[z][p], w[p]);
                }
                dft<R, true>(v[z]);
            }
#pragma unroll
            for (int q = 0; q < R; ++q) if (!(HALF && INV && q >= R / 2)) Zb[z * ZS<LOGM>() + POFF(q << LOGSUB)] = v[z][q];
        }
    }
    __syncthreads();
}
template <int LOGM> struct Cfg;
template <> struct Cfg<13> { static constexpr int L1 = 3, L2 = 3, L3 = 3, L4 = 4; };
template <> struct Cfg<14> { static constexpr int L1 = 3, L2 = 3, L3 = 4, L4 = 4; };
template <int LOGM, int NZ, bool PADDED = false> __device__ __forceinline__ void fft_fwd(LAS f32x2* Z, int tid) {
    using C = Cfg<LOGM>;
    fft_stage<LOGM, LOGM, C::L1, false, NZ, PADDED>(Z, tid);
    fft_stage<LOGM, LOGM - C::L1, C::L2, false, NZ>(Z, tid);
    fft_stage<LOGM, LOGM - C::L1 - C::L2, C::L3, false, NZ>(Z, tid);
    fft_stage<LOGM, C::L4, C::L4, false, NZ>(Z, tid);
}
template <int LOGM, int NZ, bool PADDED = false> __device__ __forceinline__ void fft_inv(LAS f32x2* Z, int tid) {
    using C = Cfg<LOGM>;
    fft_stage<LOGM, C::L4, C::L4, true, NZ>(Z, tid);
    fft_stage<LOGM, LOGM - C::L1 - C::L2, C::L3, true, NZ>(Z, tid);
    fft_stage<LOGM, LOGM - C::L1, C::L2, true, NZ>(Z, tid);
    fft_stage<LOGM, LOGM, C::L1, true, NZ, PADDED>(Z, tid);
}
template <int LOGM> __host__ __device__ constexpr int drev(int k) {
    using C = Cfg<LOGM>;
    const int k1 = k & ((1 << C::L1) - 1), k2 = (k >> C::L1) & ((1 << C::L2) - 1), k3 = (k >> (C::L1 + C::L2)) & ((1 << C::L3) - 1), k4 = k >> (C::L1 + C::L2 + C::L3);
    return (k1 << (C::L2 + C::L3 + C::L4)) | (k2 << (C::L3 + C::L4)) | (k3 << C::L4) | k4;
}

template <int LOGM, int NZ> __device__ __forceinline__ void kernel_fft_unit(const Frame& F, float* row0, size_t rstride) {
    constexpr int M = 1 << LOGM, NC = M / 2 / NTHREADS; LAS f32x2* Z = (LAS f32x2*)F.lds; int tid = threadIdx.x; asm volatile("" : "+v"(tid));
    __syncthreads();
#pragma unroll
    for (int z = 0; z < NZ; ++z) { const float* row = row0 + z * rstride; unsigned t0 = (unsigned)tid; asm volatile("" : "+v"(t0)); f32x2 lo[NC]; float re[NC], im[NC];
#pragma unroll
      for (int c = 0; c < NC; ++c) { const unsigned n = t0 + NTHREADS * c; lo[c] = ((const f32x2*)row)[n];
          const unsigned n2 = n + M / 2;
          re[c] = (n2 == (unsigned)(M / 2)) ? 0.f : row[M + (2 * M - 2 * n2)]; im[c] = row[M + (2 * M - 2 * n2 - 1)]; }
#pragma unroll
      for (int c = 0; c < NC; ++c) { LAS f32x2* Zi = Z + PADI(t0);
          Zi[z * ZS<LOGM>() + POFF(NTHREADS * c)] = lo[c]; Zi[z * ZS<LOGM>() + POFF(NTHREADS * c + M / 2)] = (f32x2){re[c], im[c]}; } }
    __syncthreads();
    fft_fwd<LOGM, NZ>(Z, tid);
    { unsigned tk = (unsigned)tid; asm volatile("" : "+v"(tk));
      constexpr int CS = 4 / NZ, TOP = M / 512 - 1;
      const int pmAi = PADI(drev<LOGM>(512 - (int)tk));
      const LAS f32x2* Zk = Z + PADI(drev<LOGM>((int)tk));
      const LAS f32x2* ZmO = Z + pmAi;
      const LAS f32x2* ZmE = Z + ((LOGM == 14 && tk == 0u) ? pmAi - 271 : pmAi);
      const LAS f32x2* Zm0 = Z + ((tk == 0u) ? 0 : pmAi + POFF(drev<LOGM>(512 * TOP)));
      const float a0 = (float)tk * (1.0f / (float)(2 * M));
#pragma unroll
      for (int c0 = 0; c0 < NC; c0 += CS) {
          f32x2 A[4], B[4], V[4], E2[4], D2[4], P[4];
#pragma unroll
          for (int cc = 0; cc < CS; ++cc) { const int c = c0 + cc; const f32x2 v = twid_sc(a0 + (float)c * (512.0f / (float)(2 * M)));
              const LAS f32x2* Zm = (c == 0) ? Zm0 : (((c & 1) || LOGM == 13) ? ZmO : ZmE); const int dm = (c == 0) ? 0 : POFF(drev<LOGM>(512 * (TOP - c)));
#pragma unroll
              for (int z = 0; z < NZ; ++z) { const int sl = cc * NZ + z; V[sl] = v; A[sl] = Zk[z * ZS<LOGM>() + POFF(drev<LOGM>(512 * c))]; B[sl] = Zm[z * ZS<LOGM>() + dm]; } }
#pragma unroll
          for (int sl = 0; sl < 4; ++sl) E2[sl] = pk_add_pm(A[sl], B[sl]);
#pragma unroll
          for (int sl = 0; sl < 4; ++sl) D2[sl] = pk_add_mp(A[sl], B[sl]);
#pragma unroll
          for (int sl = 0; sl < 4; ++sl) P[sl] = cmul(V[sl], D2[sl]);
#pragma unroll
          for (int sl = 0; sl < 4; ++sl) A[sl] = E2[sl] - P[sl];
#pragma unroll
          for (int sl = 0; sl < 4; ++sl) B[sl] = pk_addc(E2[sl], P[sl]);
#pragma unroll
          for (int cc = 0; cc < CS; ++cc) { const unsigned k = tk + NTHREADS * (unsigned)(c0 + cc);
#pragma unroll
              for (int z = 0; z < NZ; ++z) { float* row = row0 + z * rstride; const int sl = cc * NZ + z;
                  *(f32x2*)(row + 2u * k) = A[sl]; *(f32x2*)(row + 2u * ((unsigned)M - k)) = B[sl]; } }
      }
      if (tid == 0) {
          const f32x2 v = twid_sc(0.25f);
#pragma unroll
          for (int z = 0; z < NZ; ++z) { float* row = row0 + z * rstride; const f32x2 a = Z[z * ZS<LOGM>() + PADI(drev<LOGM>(M / 2))];
              const f32x2 e2 = pk_add_pm(a, a), d2 = pk_add_mp(a, a), pp = cmul(v, d2);
              *(f32x2*)(row + M) = pk_addc(e2, pp); }
      }
    }
}

template <int LOGM, int NZ> __device__ __forceinline__ void conv_unit(const Frame& F, const bf16_t* vrow, const bf16_t* g0row, const bf16_t* g1row, size_t sstride, const float* k0row, const float* k1row,
                                                                      float skip0, float skip1, bf16_t* orow, size_t ostride) {
    constexpr int M = 1 << LOGM, NC = M / 2 / NTHREADS; LAS f32x2* Z = (LAS f32x2*)F.lds; int tid = threadIdx.x; asm volatile("" : "+v"(tid));
    float zz[NZ][2 * NC];
    __syncthreads();
#pragma unroll
    for (int z = 0; z < NZ; ++z) { unsigned t0 = (unsigned)tid; asm volatile("" : "+v"(t0)); const unsigned* vp = (const unsigned*)(vrow + z * sstride);
#pragma unroll
      for (int c = 0; c < NC; ++c) { const unsigned n = t0 + NTHREADS * c; const unsigned w = vp[n]; zz[z][2 * c] = bf_lo(w); zz[z][2 * c + 1] = bf_hi(w);
          (Z + PADI(t0))[z * ZS<LOGM>() + POFF(NTHREADS * c)] = (f32x2){zz[z][2 * c], zz[z][2 * c + 1]}; } }
    __syncthreads();
#pragma unroll
    for (int o = 0; o < 2; ++o) {
        const float* kf = o ? k1row : k0row; const bf16_t* grow = o ? g1row : g0row; const float skip = o ? skip1 : skip0;
        f32x2 Kk[NC], Km[NC]; const f32x2 Kh = ((const f32x2*)kf)[M / 2];
        { unsigned tk = (unsigned)tid; asm volatile("" : "+v"(tk));
#pragma unroll
          for (int c = 0; c < NC; ++c) { const unsigned k = tk + NTHREADS * c; Kk[c] = ((const f32x2*)kf)[k]; Km[c] = ((const f32x2*)kf)[(unsigned)M - k]; } }
        unsigned gwv[NZ][NC];
#pragma unroll
        for (int z = 0; z < NZ; ++z) { unsigned t1 = (unsigned)tid; asm volatile("" : "+v"(t1)); const unsigned* gp = (const unsigned*)(grow + z * sstride);
#pragma unroll
          for (int c = 0; c < NC; ++c) gwv[z][c] = gp[t1 + NTHREADS * c]; }
        fft_fwd<LOGM, NZ, true>(Z, tid);
        { unsigned tk = (unsigned)tid; asm volatile("" : "+v"(tk));
          constexpr int CS = 4 / NZ, TOP = M / 512 - 1;
          const int pmAi = PADI(drev<LOGM>(512 - (int)tk));
          LAS f32x2* Zk = Z + PADI(drev<LOGM>((int)tk));
          LAS f32x2* ZmO = Z + pmAi;
          LAS f32x2* ZmE = Z + ((LOGM == 14 && tk == 0u) ? pmAi - 271 : pmAi);
          LAS f32x2* Zm0 = Z + ((tk == 0u) ? 0 : pmAi + POFF(drev<LOGM>(512 * TOP)));
          const float a0 = (float)tk * (1.0f / (float)(2 * M));
#pragma unroll
          for (int c0 = 0; c0 < NC; c0 += CS) {
              f32x2 A[4], B[4], V[4], KK[4], KM[4], E[4], Dm[4], P[4], X1[4], X2[4], Yk[4], Ym[4];
#pragma unroll
              for (int cc = 0; cc < CS; ++cc) { const int c = c0 + cc; const f32x2 v = twid_sc(a0 + (float)c * (512.0f / (float)(2 * M)));
                  LAS f32x2* Zm = (c == 0) ? Zm0 : (((c & 1) || LOGM == 13) ? ZmO : ZmE); const int dm = (c == 0) ? 0 : POFF(drev<LOGM>(512 * (TOP - c)));
#pragma unroll
                  for (int z = 0; z < NZ; ++z) { const int sl = cc * NZ + z; V[sl] = v; KK[sl] = Kk[c]; KM[sl] = Km[c]; A[sl] = Zk[z * ZS<LOGM>() + POFF(drev<LOGM>(512 * c))]; B[sl] = Zm[z * ZS<LOGM>() + dm]; } }
#pragma unroll
              for (int sl = 0; sl < 4; ++sl) E[sl] = pk_add_pm(A[sl], B[sl]);
#pragma unroll
              for (int sl = 0; sl < 4; ++sl) Dm[sl] = pk_add_mp(A[sl], B[sl]);
#pragma unroll
              for (int sl = 0; sl < 4; ++sl) P[sl] = cmul(V[sl], Dm[sl]);
#pragma unroll
              for (int sl = 0; sl < 4; ++sl) X1[sl] = E[sl] - P[sl];
#pragma unroll
              for (int sl = 0; sl < 4; ++sl) X2[sl] = E[sl] + P[sl];
#pragma unroll
              for (int sl = 0; sl < 4; ++sl) Yk[sl] = cmul(X1[sl], KK[sl]);
#pragma unroll
              for (int sl = 0; sl < 4; ++sl) Ym[sl] = cmulc(X2[sl], KM[sl]);
#pragma unroll
              for (int sl = 0; sl < 4; ++sl) E[sl] = Yk[sl] + Ym[sl];
#pragma unroll
              for (int sl = 0; sl < 4; ++sl) Dm[sl] = Yk[sl] - Ym[sl];
#pragma unroll
              for (int sl = 0; sl < 4; ++sl) P[sl] = cmulc(Dm[sl], V[sl]);
#pragma unroll
              for (int sl = 0; sl < 4; ++sl) A[sl] = E[sl] - P[sl];
#pragma unroll
              for (int sl = 0; sl < 4; ++sl) B[sl] = pk_addc(E[sl], P[sl]);
#pragma unroll
              for (int cc = 0; cc < CS; ++cc) { const int c = c0 + cc;
                  LAS f32x2* Zm = (c == 0) ? Zm0 : (((c & 1) || LOGM == 13) ? ZmO : ZmE); const int dm = (c == 0) ? 0 : POFF(drev<LOGM>(512 * (TOP - c)));
#pragma unroll
                  for (int z = 0; z < NZ; ++z) { const int sl = cc * NZ + z; Zm[z * ZS<LOGM>() + dm] = B[sl]; Zk[z * ZS<LOGM>() + POFF(drev<LOGM>(512 * c))] = A[sl]; } }
          }
          if (tid == 0) {
              const f32x2 v = twid_sc(0.25f);
#pragma unroll
              for (int z = 0; z < NZ; ++z) { LAS f32x2* zp = Z + z * ZS<LOGM>() + PADI(drev<LOGM>(M / 2)); const f32x2 a = *zp;
                  const f32x2 e = pk_add_pm(a, a), dm = pk_add_mp(a, a), pp = cmul(v, dm), yk = cmul(e - pp, Kh), ym = cmulc(e + pp, Kh);
                  const f32x2 ye = yk + ym, qq = cmulc(yk - ym, v);
                  *zp = ye - qq; }
          } }
        __syncthreads();
        fft_inv<LOGM, NZ, true>(Z, tid);
        constexpr float SC = 0.125f / (float)M;
#pragma unroll
        for (int z = 0; z < NZ; ++z) { unsigned t1 = (unsigned)tid; asm volatile("" : "+v"(t1)); unsigned* op = (unsigned*)(orow + z * ostride);
#pragma unroll
          for (int c = 0; c < NC; ++c) { const unsigned n = t1 + NTHREADS * c; LAS f32x2* Zo = Z + PADI(t1) + z * ZS<LOGM>() + POFF(NTHREADS * c); const f32x2 y = *Zo; const unsigned gw = gwv[z][c];
            zz[z][2 * c] = bf_lo(gw) * (y.x * SC + zz[z][2 * c] * skip); zz[z][2 * c + 1] = bf_hi(gw) * (y.y * SC + zz[z][2 * c + 1] * skip);
            if (o == 0) *Zo = (f32x2){zz[z][2 * c], zz[z][2 * c + 1]};
            else op[n] = pk2(zz[z][2 * c], zz[z][2 * c + 1]); } }
        __syncthreads();
    }
}
}

__device__ __forceinline__ void hy_fix_phase(const Frame& F, const Args& a) {
    bf16_t* UT = (bf16_t*)(a.ws + WS_UT); const bf16_t* EU = (const bf16_t*)(a.ws + WS_EU); const float* cw = a.in[I_HCW];
    for (int it = F.gw; it < 383 * 96; it += F.NGW) {
        const int hb = it / 96, col = (it % 96) * 64 + F.lane, rl = hb * 128 + 127, s = seq_of_row(rl);
        if (seq_of_row(rl + 1) != s) continue;
        const int L = seq_len(s), tl = rl - seq_start(s);
        const float ul = bf1(EU[((size_t)hb * 2 + 1) * (3 * D) + col]), uf = bf1(EU[((size_t)(hb + 1) * 2 + 0) * (3 * D) + col]);
        bf16_t* p = UT + (size_t)seq_start(s) * (3 * D) + (size_t)col * L + tl;
        p[0] = f2bf(bf1(p[0]) + cw[2 * 3 * D + col] * uf);
        p[1] = f2bf(bf1(p[1]) + cw[col] * ul);
    }
}
__device__ __forceinline__ void hy_transpose_back_item(const Frame& F, const Args& a, int q, int item, LAS float* tile) {
    const bf16_t* ZT = (const bf16_t*)(a.ws + WS_ZT); bf16_t* ZZ = (bf16_t*)(a.ws + WS_H);
    const int lane = F.lane, cb8 = item & 7, rb = item >> 3, t0 = rb * 64, s = seq_of_row(t0), tl0 = t0 - seq_start(s), L = seq_len(s);
    const bf16_t* src = ZT + (size_t)seq_start(s) * 512 + (size_t)(cb8 * 64) * L + tl0;
    LDS_WAIT();
#pragma unroll
    for (int it = 0; it < 8; ++it) { const int ch = it * 8 + (lane >> 3), tk = (lane & 7) * 8; float v[8]; unpack8(*(const u32x4*)(src + (size_t)ch * L + tk), v);
#pragma unroll
        for (int e = 0; e < 8; ++e) tile[ch * 65 + tk + e] = v[e]; }
    LDS_WAIT();
#pragma unroll
    for (int it = 0; it < 8; ++it) { const int tk = it * 8 + (lane >> 3), c0 = (lane & 7) * 8; float v[8];
#pragma unroll
        for (int e = 0; e < 8; ++e) v[e] = tile[(c0 + e) * 65 + tk];
        u32x4 w; w.x = pk2(v[0], v[1]); w.y = pk2(v[2], v[3]); w.z = pk2(v[4], v[5]); w.w = pk2(v[6], v[7]);
        *(u32x4*)(ZZ + (size_t)(t0 + tk) * D + q * 512 + cb8 * 64 + c0) = w; }
}
__device__ __forceinline__ void hy_filter_item(const Frame& F, const Args& a, int q, int item) {
    const bf16_t* W3T = (const bf16_t*)(a.ws + WS_W3T); const bf16_t* A2 = (const bf16_t*)(a.ws + WS_A2); float* FK = (float*)(a.ws + WS_FK);
    const int lane = F.lane, r32 = lane & 31, hi = lane >> 5, cb = item & 63, tg = item >> 6, od = cb >> 4, cblk = cb & 15, o = od >> 1, dir = od & 1;
    const int wcol0 = od * D + q * 512 + cblk * 32;
    bf16x8 afr[4];
#pragma unroll
    for (int s = 0; s < 4; ++s) afr[s] = *(const bf16x8*)(W3T + (size_t)(wcol0 + r32) * 64 + 16 * s + 8 * hi);
    float delta[16];
#pragma unroll
    for (int r = 0; r < 16; ++r) { const int d = q * 512 + cblk * 32 + att::crow(r, hi); delta[r] = 3.0701134573253945f + (float)d * (12.280453829301578f / 2047.0f); }
    bf16x8 bfa[8][4];
#pragma unroll
    for (int i = 0; i < 8; ++i)
#pragma unroll
        for (int s = 0; s < 4; ++s) bfa[i][s] = *(const bf16x8*)(A2 + (size_t)((tg * 8 + i) * 32 + r32) * 64 + 16 * s + 8 * hi);
#pragma unroll
    for (int i = 0; i < 8; ++i) {
        const int tt0 = (tg * 8 + i) * 32, ls = tt0 >= LP, n = tt0 - (ls ? LP : 0) + r32, L = ls ? LS : LP;
        f32x16 acc = {};
#pragma unroll
        for (int s = 0; s < 4; ++s) acc = __builtin_amdgcn_mfma_f32_32x32x16_bf16(afr[s], bfa[i][s], acc, 0, 0, 0);
        const float tn = (float)n / (float)(L - 1);
        float* base = FK + (ls ? FK_SAMPLE_OFF : (size_t)0) + (size_t)dir * L + n;
        const size_t pitch = ls ? FK_PITCH_S : FK_PITCH_P;
#pragma unroll
        for (int r = 0; r < 16; ++r) { const int c = cblk * 32 + att::crow(r, hi);
            base[(size_t)(o * 512 + c) * pitch] = acc[r] * (__expf(-tn * delta[r]) + 0.05f); }
    }
}
__device__ __forceinline__ void hy_phase_a(const Frame& F, const Args& a, int q, bool do_back = true) {
    LAS float* tile = (LAS float*)(F.lds + F.wave * 17408);
    if (q < 4) for (int it = F.gw; it < 64 * 96; it += F.NGW) hy_filter_item(F, a, q, it);
    if (q > 0 && do_back) for (int it = F.gw; it < 768 * 8; it += F.NGW) hy_transpose_back_item(F, a, q - 1, it, tile);
}
__device__ __forceinline__ void hy_phase_c(const Frame& F, const Args& a, int q) {
    const bf16_t* UT = (const bf16_t*)(a.ws + WS_UT); float* FK = (float*)(a.ws + WS_FK); bf16_t* ZT = (bf16_t*)(a.ws + WS_ZT);
    const float* skip = a.in[I_HSKIP];
    for (int c = F.vcu; c < 512; c += F.G) {
        hy::kernel_fft_unit<14, 1>(F, FK + FK_SAMPLE_OFF + (size_t)c * FK_PITCH_S, 0);
        hy::kernel_fft_unit<14, 1>(F, FK + FK_SAMPLE_OFF + (size_t)(512 + c) * FK_PITCH_S, 0);
        hy::kernel_fft_unit<13, 2>(F, FK + (size_t)c * FK_PITCH_P, (size_t)512 * FK_PITCH_P);
        VM_WAIT(); __syncthreads();
        if (F.wave == 0) { __builtin_amdgcn_fence(__ATOMIC_ACQUIRE, "agent"); VM_WAIT(); }
        __syncthreads();
        const int d = q * 512 + c; const float s0 = skip[d], s1 = skip[D + d];
        { const bf16_t* ub = UT + (size_t)seq_start(4) * (3 * D);
          hy::conv_unit<14, 1>(F, ub + (size_t)d * LS, ub + (size_t)(D + d) * LS, ub + (size_t)(2 * D + d) * LS, 0,
                               FK + FK_SAMPLE_OFF + (size_t)c * FK_PITCH_S, FK + FK_SAMPLE_OFF + (size_t)(512 + c) * FK_PITCH_S, s0, s1, ZT + (size_t)seq_start(4) * 512 + (size_t)c * LS, 0); }
#pragma unroll 1
        for (int s = 0; s < 4; s += 2) { const bf16_t* ub = UT + (size_t)seq_start(s) * (3 * D);
          hy::conv_unit<13, 2>(F, ub + (size_t)d * LP, ub + (size_t)(D + d) * LP, ub + (size_t)(2 * D + d) * LP, (size_t)LP * (3 * D),
                               FK + (size_t)c * FK_PITCH_P, FK + (size_t)(512 + c) * FK_PITCH_P, s0, s1, ZT + (size_t)seq_start(s) * 512 + (size_t)c * LP, (size_t)LP * 512); }
    }
    __syncthreads();
}
#ifndef MK_MULTI_LAUNCH
#define MK_MULTI_LAUNCH 0
#endif
#ifndef PROBE
#define PROBE 0
#endif
#ifndef EN_MASK
#define EN_MASK 0xff
#endif
#define EN_GEMM ((EN_MASK) & 1)
#define EN_ATT  ((EN_MASK) & 2)
#define EN_HYA  ((EN_MASK) & 4)
#define EN_HYB  ((EN_MASK) & 8)
#define EN_HYC  ((EN_MASK) & 16)
#define EN_MISC ((EN_MASK) & 32)
constexpr int NPH = 41;
constexpr int CW_BAR = 4096;

__device__ __forceinline__ const float* modrow(const Args& a, int layer) { return (const float*)(a.ws + WS_MOD) + (size_t)layer * NB * 6 * D; }

__global__ void __launch_bounds__(NTHREADS, 2) fwd_kernel(Args a) {
    extern __shared__ __attribute__((aligned(16))) unsigned char lds_raw[];
    Frame F0;
    Frame& F = F0;
    F.lds = (LAS unsigned char*)lds_raw;
    F.tid = threadIdx.x; F.lane = F.tid & 63; F.wave = __builtin_amdgcn_readfirstlane(F.tid >> 6);
    F.G = gridDim.x; { const int bx = blockIdx.x; F.vcu = (F.G % 8 == 0) ? (bx % 8) * (F.G / 8) + bx / 8 : bx; }
    F.gw = F.vcu * NWAVES + F.wave; F.NGW = F.G * NWAVES;
    volatile LAS unsigned* MISC = (volatile LAS unsigned*)(F.lds + MISC_OFF);
    if (F.tid < 64) MISC[F.tid] = 0u;
    __syncthreads();
    unsigned* ctl = (unsigned*)(a.ws + WS_CTL);
    const int lo = a.ph_lo, hi = a.ph_hi;
    XcdBarrier bar; bar.bar = ctl + CW_BAR + a.li * XCD_BAR_WORDS; bar.x = 0; bar.st = MISC + 8;
    if (hi - lo > 1) bar = xcd_barrier_post(ctl + CW_BAR + a.li * XCD_BAR_WORDS, MISC + 8);
    int ph = 0;
#define PH_BEGIN if (ph >= lo && ph < hi) { Frame F = F0; { int t_ = threadIdx.x; asm volatile("" : "+v"(t_)); F.tid = t_; F.lane = t_ & 63; }
#define PH_END   if (ph + 1 < hi) { xcd_barrier(bar); if (PROBE == 9) xcd_barrier(bar); } } ++ph;

    bf16_t* const H = (bf16_t*)(a.ws + WS_H); bf16_t* const M1 = (bf16_t*)(a.ws + WS_M1);
    float* const out = a.out;
    const int bx = (int)blockIdx.x;

    bf16_t* const XB = (bf16_t*)(a.ws + WS_XB);
#define NORM_N1(layer) do { NormP p{a.in[I_XP], a.in[I_XS], nullptr, nullptr, nullptr, nullptr, nullptr, 0, nullptr, modrow(a, layer), D, 0, a.in[I_NMPRE] + (layer) * D, H}; if (EN_MISC) norm_phase(F, p); } while (0)
#define NORM_N2(layer, MPTR) do { NormP p{a.in[I_XP], a.in[I_XS], (layer) == 0 ? nullptr : XB, nullptr, XB, MPTR, modrow(a, layer), 2 * D, a.in[I_NMPOST] + (layer) * D, modrow(a, layer), 4 * D, 3 * D, a.in[I_NFPRE] + (layer) * D, H}; \
        if (EN_MISC) norm_phase(F, p); if (PROBE == 4) { NormP p2 = p; p2.xbout = (bf16_t*)(a.ws + 512 * MiB); p2.H = (bf16_t*)(a.ws + 704 * MiB); norm_phase(F, p2); } } while (0)
#define NORM_N3(layer) do { NormP p{nullptr, nullptr, XB, (layer) + 1 < NLAYER ? nullptr : out, (layer) + 1 < NLAYER ? XB : nullptr, M1, modrow(a, layer), 5 * D, a.in[I_NFPOST] + (layer) * D, modrow(a, (layer) + 1 < NLAYER ? (layer) + 1 : (layer)), D, 0, \
        a.in[I_NMPRE] + ((layer) + 1 < NLAYER ? (layer) + 1 : (layer)) * D, (layer) + 1 < NLAYER ? H : nullptr}; if (EN_MISC) norm_phase(F, p); \
        if (PROBE == 4 && (layer) + 1 < NLAYER) { NormP p2 = p; p2.xbout = (bf16_t*)(a.ws + 512 * MiB); p2.H = (bf16_t*)(a.ws + 704 * MiB); norm_phase(F, p2); } } while (0)
#define GEMM_PHASE(Aptr, Bptr, LDA, LDB, KK, AGRP, MM, NN, Optr, LDC, BIAS, SCALE) do { pg8::Gemm g{Aptr, Bptr, LDA, LDB, KK, AGRP}; pg8::StaticOrder S; S.init(MM, NN, F.G, bx); \
        pg8::EpiBf16 E{Optr, LDC, BIAS, SCALE}; for (int rep8 = 0; rep8 < ((PROBE == 8 && (KK) != DFF) ? 2 : 1); ++rep8) { if (EN_GEMM) pg8::gemm_phase<false, pg8::EpiBf16, pg8::StaticOrder>(F.lds, g, S, E); } } while (0)
#define FFN_LAYER(layer) do { \
        PH_BEGIN for (int rep = 0; rep < (PROBE == 1 ? 2 : 1); ++rep) { pg8::Gemm g{H, (const bf16_t*)(a.ws + WS_WUP), D, D, D, 0}; pg8::StaticOrder S; S.init(T, 2 * DFF, F.G, bx); \
            pg8::EpiGlu E{(bf16_t*)(a.ws + WS_U), (bf16_t*)(a.ws + WS_EA), (bf16_t*)(a.ws + WS_EB), a.in[I_FCW] + (size_t)(layer) * 3 * DFF, a.in[I_FCB] + (size_t)(layer) * DFF, DFF}; \
            if (EN_GEMM) pg8::gemm_phase<true, pg8::EpiGlu, pg8::StaticOrder>(F.lds, g, S, E); } PH_END \
        PH_BEGIN if (EN_MISC) ffn_fix_phase(F, (const bf16_t*)(a.ws + WS_EA), (const bf16_t*)(a.ws + WS_EB), (bf16_t*)(a.ws + WS_U), a.in[I_FCW] + (size_t)(layer) * 3 * DFF, a.in[I_FCB] + (size_t)(layer) * DFF); PH_END \
        PH_BEGIN for (int rep = 0; rep < (PROBE == 1 ? 2 : 1); ++rep) { GEMM_PHASE((const bf16_t*)(a.ws + WS_U), (const bf16_t*)(a.ws + WS_WDN), DFF, DFF, DFF, 0, T, D, M1, D, nullptr, nullptr); } PH_END \
        PH_BEGIN NORM_N3(layer); if ((layer) + 1 < NLAYER) { __syncthreads(); prep_ffn_weights(F, a, (layer) + 1); if (PROBE == 7) prep_ffn_weights(F, a, (layer) + 1); } PH_END \
    } while (0)
#define POOL_LAYER(layer, j) do { \
        PH_BEGIN for (int rep = 0; rep < ((PROBE == 4 || PROBE == 11) ? 2 : 1); ++rep) { if (EN_MISC) pool_phase(F, H, (bf16_t*)(a.ws + WS_P)); } PH_END \
        PH_BEGIN GEMM_PHASE((const bf16_t*)(a.ws + WS_P), (const bf16_t*)(a.ws + WS_POOLW) + (size_t)(j) * D * 512, D, 512, 512, 2, T, D, M1, D, nullptr, a.in[I_POOLS] + (j) * D); PH_END \
    } while (0)

    PH_BEGIN for (int rep = 0; rep < (PROBE == 7 ? 2 : 1); ++rep) { if (EN_MISC) prologue_phase(F, a); __syncthreads(); } PH_END

    PH_BEGIN NORM_N1(0); __syncthreads(); prep_ffn_weights(F, a, 0); if (PROBE == 7) prep_ffn_weights(F, a, 0); PH_END
    POOL_LAYER(0, 0);
    PH_BEGIN NORM_N2(0, M1); PH_END
    FFN_LAYER(0);

    PH_BEGIN { pg8::Gemm g{H, (const bf16_t*)(a.ws + WS_HYWIN), D, D, D, 0}; pg8::StaticOrder S; S.init(T, 3 * D, F.G, bx);
        pg8::EpiHyT E{(bf16_t*)(a.ws + WS_UT), (bf16_t*)(a.ws + WS_EU), a.in[I_HBIN], a.in[I_HCW], a.in[I_HCB], 3 * D};
        for (int rep8 = 0; rep8 < (PROBE == 8 ? 2 : 1); ++rep8) { if (EN_GEMM) pg8::gemm_phase<true, pg8::EpiHyT, pg8::StaticOrder>(F.lds, g, S, E); } } PH_END
    for (int q = 0; q < 4; ++q) {
        PH_BEGIN if (EN_HYA) { if (q == 0) hy_fix_phase(F, a); hy_phase_a(F, a, q); } PH_END
        PH_BEGIN if (EN_HYC) hy_phase_c(F, a, q); PH_END
    }
    PH_BEGIN if (EN_HYA) hy_phase_a(F, a, 4); PH_END
    PH_BEGIN GEMM_PHASE(H, (const bf16_t*)(a.ws + WS_HYWOUT), D, D, D, 0, T, D, (bf16_t*)(a.ws + WS_M1H), D, nullptr, nullptr); PH_END
    PH_BEGIN NORM_N2(1, (const bf16_t*)(a.ws + WS_M1H)); PH_END
    FFN_LAYER(1);

    PH_BEGIN GEMM_PHASE(H, (const bf16_t*)(a.ws + WS_ATQKV), D, D, D, 0, T, 3072, (bf16_t*)(a.ws + WS_QKV), 3072, nullptr, nullptr); PH_END
    PH_BEGIN if (EN_MISC) qk_norm_rope_phase(F, (bf16_t*)(a.ws + WS_QKV), a.in[I_AQG], a.in[I_AKG]); PH_END
    PH_BEGIN for (int rep = 0; rep < (PROBE == 2 ? 2 : 1); ++rep) { if (EN_ATT) attn_phase(F, (const bf16_t*)(a.ws + WS_QKV), (bf16_t*)(a.ws + WS_O)); } PH_END
    PH_BEGIN GEMM_PHASE((const bf16_t*)(a.ws + WS_O), (const bf16_t*)(a.ws + WS_ATWO), D, D, D, 0, T, D, M1, D, nullptr, nullptr); PH_END
    PH_BEGIN NORM_N2(2, M1); PH_END
    FFN_LAYER(2);

    POOL_LAYER(3, 1);
    PH_BEGIN NORM_N2(3, M1); PH_END
    FFN_LAYER(3);
}

__global__ void k_fail_fill(float* out, size_t n) { for (size_t i = (size_t)blockIdx.x * blockDim.x + threadIdx.x; i < n; i += (size_t)gridDim.x * blockDim.x) out[i] = __builtin_nanf(""); }

extern "C" void kernel_launch(void* const* d_in, const int* in_sizes, int n_in, void* d_out, int out_size, void* d_ws, size_t ws_size, hipStream_t stream) {
    static int grid = 0;
    if (grid == 0) {
        int dev = 0, cus = 0, per_cu = 0;
        if (n_in != 32 || out_size != T * D || ws_size < WS_END) {
            fprintf(stderr, "kernel_launch: shape/workspace mismatch: n_in %d out %d ws %zu (need %zu)\n", n_in, out_size, ws_size, (size_t)WS_END); grid = -1; }
        else if (hipGetDevice(&dev) != hipSuccess || hipDeviceGetAttribute(&cus, hipDeviceAttributeMultiprocessorCount, dev) != hipSuccess) grid = -1;
        else if (hipFuncSetAttribute((const void*)fwd_kernel, hipFuncAttributeMaxDynamicSharedMemorySize, LDS_BYTES) != hipSuccess) grid = -1;
        else {
            if (hipOccupancyMaxActiveBlocksPerMultiprocessor(&per_cu, (const void*)fwd_kernel, NTHREADS, LDS_BYTES) != hipSuccess || per_cu < 1)
                fprintf(stderr, "kernel_launch: occupancy query reports %d workgroups per CU\n", per_cu);
            (void)hipGetLastError();
            grid = cus;
        }
    }
    if (grid < 0) { hipLaunchKernelGGL(k_fail_fill, dim3(1024), dim3(256), 0, stream, (float*)d_out, (size_t)out_size); return; }
    (void)hipMemsetAsync((char*)d_ws + WS_CTL, 0, CTL_ZERO_BYTES, stream);
    Args a{};
    for (int i = 0; i < 32; ++i) a.in[i] = (const float*)d_in[i];
    a.out = (float*)d_out; a.ws = (unsigned char*)d_ws;
#if MK_MULTI_LAUNCH
    for (int k = 0; k < NPH; ++k) { a.ph_lo = k; a.ph_hi = k + 1; a.li = k; a.pad = 0;
        hipLaunchKernelGGL(fwd_kernel, dim3(grid), dim3(NTHREADS), LDS_BYTES, stream, a); }
#else
    a.ph_lo = 0; a.ph_hi = NPH; a.li = 0; a.pad = 0;
    hipLaunchKernelGGL(fwd_kernel, dim3(grid), dim3(NTHREADS), LDS_BYTES, stream, a);
#endif
    const hipError_t le = hipPeekAtLastError();
    if (le != hipSuccess) fprintf(stderr, "kernel_launch: launch failed: %s\n", hipGetErrorName(le));
}
```

```cpp
#include <hip/hip_runtime.h>
#include <cstdio>
#include <cstdint>

#define LAS __attribute__((address_space(3)))
#define GAS __attribute__((address_space(1)))
typedef unsigned short bf16_t;
typedef short bf16x8 __attribute__((ext_vector_type(8)));
typedef short s16x4 __attribute__((ext_vector_type(4)));
typedef float f32x2 __attribute__((ext_vector_type(2)));
typedef float f32x4 __attribute__((ext_vector_type(4)));
typedef float f32x16 __attribute__((ext_vector_type(16)));
typedef unsigned u32x2 __attribute__((ext_vector_type(2)));
typedef unsigned u32x4 __attribute__((ext_vector_type(4)));

constexpr int D = 2048, T = 49152, DFF = 5632, NLAYER = 4, NB = 5;
constexpr int LP = 8192, LS = 16384, TP = 32768;
constexpr float EPS = 1e-6f;
__device__ __forceinline__ int seq_of_row(int r) { return r < TP ? (r >> 13) : 4; }
__device__ __forceinline__ int seq_start(int s) { return s << 13; }
__device__ __forceinline__ int seq_len(int s) { return s < 4 ? LP : LS; }

__device__ __forceinline__ unsigned cvt_pk_bf16(float lo, float hi) { unsigned r; asm volatile("v_cvt_pk_bf16_f32 %0, %1, %2" : "=v"(r) : "v"(lo), "v"(hi)); return r; }
__device__ __forceinline__ float bf_lo(unsigned w) { return __uint_as_float(w << 16); }
__device__ __forceinline__ float bf_hi(unsigned w) { return __uint_as_float(w & 0xffff0000u); }
__device__ __forceinline__ float bf1(bf16_t h) { return __uint_as_float(((unsigned)h) << 16); }
__device__ __forceinline__ bf16_t f2bf(float f) { return (bf16_t)(cvt_pk_bf16(f, 0.f) & 0xffffu); }
__device__ __forceinline__ float wave_sum(float v) {
#pragma unroll
    for (int o = 1; o < 64; o <<= 1) v += __shfl_xor(v, o);
    return v;
}

namespace pg8 {
constexpr int BM = 256, BK = 64, HALF = 128, HTB = HALF * BK * 2, STAGE_BYTES = 8 * HTB, NXCD = 8, WGM = 8;
__host__ __device__ __forceinline__ int lds_byte(int r, int c) { const int st = (r >> 4) * 2 + (c >> 5), rr = r & 15, cc = c & 31, ob = rr * 64 + cc * 2; return st * 1024 + (ob ^ (((ob >> 9) & 1) << 5)); }
__host__ __device__ __forceinline__ void stage_rc(int b, int& R, int& C) { const int st = b / 1024, sb = b % 1024, swz = sb ^ (((sb >> 9) & 1) << 5); R = (st >> 1) * 16 + swz / 64; C = (st & 1) * 32 + (swz % 64) / 2; }
__host__ __device__ __forceinline__ int perm32(int rho) { const int n = rho >> 4, i = rho & 15; return 8 * (i >> 2) + 4 * n + (i & 3); }

struct Unit { int pm, pn; };
struct Gemm { const bf16_t* A; const bf16_t* Bt; int lda, ldb, K, agrp; };

struct StaticOrder {
    int nM, nN, nwg, G, c;
    __device__ void init(int M, int N, int G_, int c_) { nM = M / BM; nN = N / BM; nwg = nM * nN; G = G_; c = c_; }
    __device__ bool next(int i, Unit& u) const {
        const long L = (long)i * G + c; if (L >= nwg) return false;
        int wgid = (int)L; { const int q = nwg / NXCD, r = nwg % NXCD, xcd = wgid % NXCD, off = wgid / NXCD; wgid = (xcd < r ? xcd * (q + 1) : r * (q + 1) + (xcd - r) * q) + off; }
        const int nig = WGM * nN, gid = wgid / nig, fm = gid * WGM, gsz = (nM - fm) < WGM ? (nM - fm) : WGM;
        u.pm = fm + ((wgid % nig) % gsz); u.pn = (wgid % nig) / gsz; return true;
    }
};

struct EpiBf16 {
    bf16_t* O; int ldc; const float* bias; const float* scale;
    __device__ __forceinline__ void prefetch(LAS unsigned char*, const Unit&, int, int) const {}
    __device__ __forceinline__ void operator()(const f32x4 (&acc)[2][2][4][2], const Unit& u, int wr, int wc, int fr, int fq, const LAS unsigned char*) const {
        asm volatile("" ::: "memory");
        const int row0 = u.pm * BM + wr * 64 + fr, col0 = u.pn * BM + wc * 32 + 8 * fq;
        f32x4 bv[2][2], sv[2][2];
#pragma unroll
        for (int bj = 0; bj < 2; ++bj)
#pragma unroll
            for (int n = 0; n < 2; ++n) {
                bv[bj][n] = bias ? *(const f32x4*)(bias + col0 + bj * HALF + 4 * n) : (f32x4){0.f, 0.f, 0.f, 0.f};
                sv[bj][n] = scale ? *(const f32x4*)(scale + col0 + bj * HALF + 4 * n) : (f32x4){1.f, 1.f, 1.f, 1.f}; }
#pragma unroll
        for (int ai = 0; ai < 2; ++ai)
#pragma unroll
            for (int m = 0; m < 4; ++m) { bf16_t* rowp = O + (size_t)(row0 + ai * HALF + m * 16) * ldc + col0;
#pragma unroll
                for (int bj = 0; bj < 2; ++bj) { f32x4 v0 = acc[ai][bj][m][0], v1 = acc[ai][bj][m][1];
                    if (bias) { v0 += bv[bj][0]; v1 += bv[bj][1]; }
                    if (scale) { v0 *= sv[bj][0]; v1 *= sv[bj][1]; }
                    u32x4 w; w.x = cvt_pk_bf16(v0[0], v0[1]); w.y = cvt_pk_bf16(v0[2], v0[3]); w.z = cvt_pk_bf16(v1[0], v1[1]); w.w = cvt_pk_bf16(v1[2], v1[3]);
                    *(u32x4*)(rowp + bj * HALF) = w; } }
    }
};

__device__ __forceinline__ float gelu_tanh_f(float x) {
    const float arg = x * __builtin_fmaf(x * x, -0.10294323970f, -2.30220819814f);
    return x * __builtin_amdgcn_rcpf(1.0f + __builtin_amdgcn_exp2f(arg));
}
__device__ __forceinline__ f32x2 gelu_tanh_2(f32x2 x) {
    const f32x2 arg = x * __builtin_elementwise_fma(x * x, (f32x2){-0.10294323970f, -0.10294323970f}, (f32x2){-2.30220819814f, -2.30220819814f});
    const f32x2 d = (f32x2){__builtin_amdgcn_exp2f(arg.x), __builtin_amdgcn_exp2f(arg.y)} + (f32x2){1.0f, 1.0f};
    return x * (f32x2){__builtin_amdgcn_rcpf(d.x), __builtin_amdgcn_rcpf(d.y)};
}
__device__ __forceinline__ float dpp_shr1(float v) { return __int_as_float(__builtin_amdgcn_update_dpp(0, __float_as_int(v), 0x111, 0xf, 0xf, false)); }
__device__ __forceinline__ float dpp_shl1(float v) { return __int_as_float(__builtin_amdgcn_update_dpp(0, __float_as_int(v), 0x101, 0xf, 0xf, false)); }
__device__ __forceinline__ u32x4 pack8(const f32x4 a, const f32x4 b) { u32x4 w; w.x = cvt_pk_bf16(a[0], a[1]); w.y = cvt_pk_bf16(a[2], a[3]); w.z = cvt_pk_bf16(b[0], b[1]); w.w = cvt_pk_bf16(b[2], b[3]); return w; }
struct EpiGlu {
    bf16_t* U; bf16_t* EA; bf16_t* EB; const float* cw; const float* cb; int dff;
    __device__ __forceinline__ void prefetch(LAS unsigned char* wslot, const Unit& u, int wc, int lane) const {
        const int chw = u.pn * HALF + wc * 32 + (lane & 31);
        const float* g0 = (lane < 32) ? cw + chw : cw + dff + chw;
        const float* g1 = (lane < 32) ? cw + 2 * dff + chw : cb + chw;
        __builtin_amdgcn_global_load_lds((const unsigned*)g0, (LAS unsigned*)wslot, 4, 0, 0);
        __builtin_amdgcn_global_load_lds((const unsigned*)g1, (LAS unsigned*)(wslot + 256), 4, 0, 0);
    }
    __device__ __forceinline__ void operator()(const f32x4 (&acc)[2][2][4][2], const Unit& u, int wr, int wc, int fr, int fq, const LAS unsigned char* wslot) const {
        asm volatile("" ::: "memory");
        const int ch0 = u.pn * HALF + wc * 32 + 8 * fq;
        f32x4 w0[2], w1[2], w2[2], bb[2], pv[2], nx[2];
        const LAS float* wsl = (const LAS float*)wslot + 8 * fq;
#pragma unroll
        for (int n = 0; n < 2; ++n) { w0[n] = *(const LAS f32x4*)(wsl + 4 * n); w1[n] = *(const LAS f32x4*)(wsl + 32 + 4 * n); w2[n] = *(const LAS f32x4*)(wsl + 64 + 4 * n); bb[n] = *(const LAS f32x4*)(wsl + 96 + 4 * n);
#pragma unroll
            for (int j = 0; j < 4; ++j) { pv[n][j] = dpp_shr1(acc[1][0][3][n][j]); nx[n][j] = dpp_shl1(acc[0][0][0][n][j]); } }
        const size_t tok0 = (size_t)u.pm * BM + 128 * wr + 8 * fr;
#pragma unroll
        for (int k = 0; k < 8; ++k) {
            f32x4 o[2];
            {
                f32x2 y[4], yg[4], tt[4], dd[4], rr[4];
#pragma unroll
                for (int q = 0; q < 4; ++q) { const int n = q >> 1;
                    const f32x4 ap4 = (k == 0) ? pv[n] : acc[(k - 1) >> 2][0][(k - 1) & 3][n], ac4 = acc[k >> 2][0][k & 3][n], an4 = (k == 7) ? nx[n] : acc[(k + 1) >> 2][0][(k + 1) & 3][n], gt4 = acc[k >> 2][1][k & 3][n];
                    const f32x2 ap = (q & 1) ? ap4.hi : ap4.lo, ac = (q & 1) ? ac4.hi : ac4.lo, an = (q & 1) ? an4.hi : an4.lo, gt = (q & 1) ? gt4.hi : gt4.lo;
                    const f32x2 c0 = (q & 1) ? w0[n].hi : w0[n].lo, c1 = (q & 1) ? w1[n].hi : w1[n].lo, c2 = (q & 1) ? w2[n].hi : w2[n].lo, cb2 = (q & 1) ? bb[n].hi : bb[n].lo;
                    y[q] = __builtin_elementwise_fma(c2, an, __builtin_elementwise_fma(c1, ac, __builtin_elementwise_fma(c0, ap, cb2)));
                    yg[q] = y[q] * gt; }
#pragma unroll
                for (int q = 0; q < 4; ++q) tt[q] = y[q] * y[q];
#pragma unroll
                for (int q = 0; q < 4; ++q) tt[q] = __builtin_elementwise_fma(tt[q], (f32x2){-0.10294323970f, -0.10294323970f}, (f32x2){-2.30220819814f, -2.30220819814f});
#pragma unroll
                for (int q = 0; q < 4; ++q) tt[q] = y[q] * tt[q];
#pragma unroll
                for (int q = 0; q < 4; ++q) dd[q] = (f32x2){__builtin_amdgcn_exp2f(tt[q].x), __builtin_amdgcn_exp2f(tt[q].y)};
#pragma unroll
                for (int q = 0; q < 4; ++q) dd[q] = dd[q] + (f32x2){1.0f, 1.0f};
#pragma unroll
                for (int q = 0; q < 4; ++q) rr[q] = (f32x2){__builtin_amdgcn_rcpf(dd[q].x), __builtin_amdgcn_rcpf(dd[q].y)};
#pragma unroll
                for (int q = 0; q < 4; ++q) rr[q] = yg[q] * rr[q];
                o[0] = (f32x4){rr[0].x, rr[0].y, rr[1].x, rr[1].y}; o[1] = (f32x4){rr[2].x, rr[2].y, rr[3].x, rr[3].y};
            }
            const bool edge = (k == 0 && fr == 0) || (k == 7 && fr == 15);
            if (!edge) *(u32x4*)(U + (tok0 + k) * dff + ch0) = pack8(o[0], o[1]);
        }
        const size_t hb = (size_t)u.pm * 2 + wr;
        if (fr == 0) { *(u32x4*)(EA + (hb * 4 + 0) * dff + ch0) = pack8(acc[0][0][0][0], acc[0][0][0][1]); *(u32x4*)(EA + (hb * 4 + 1) * dff + ch0) = pack8(acc[0][0][1][0], acc[0][0][1][1]);
                       *(u32x4*)(EB + (hb * 2 + 0) * dff + ch0) = pack8(acc[0][1][0][0], acc[0][1][0][1]); }
        if (fr == 15) { *(u32x4*)(EA + (hb * 4 + 2) * dff + ch0) = pack8(acc[1][0][2][0], acc[1][0][2][1]); *(u32x4*)(EA + (hb * 4 + 3) * dff + ch0) = pack8(acc[1][0][3][0], acc[1][0][3][1]);
                        *(u32x4*)(EB + (hb * 2 + 1) * dff + ch0) = pack8(acc[1][1][3][0], acc[1][1][3][1]); }
    }
};

struct EpiHyT {
    bf16_t* UT; bf16_t* EU; const float* bin; const float* cw; const float* cb; int ncol;
    __device__ __forceinline__ void prefetch(LAS unsigned char* wslot, const Unit& u, int wc, int lane) const {
        const int c = u.pn * BM + (lane >> 5) * HALF + wc * 32 + (lane & 31);
        __builtin_amdgcn_global_load_lds((const unsigned*)(bin + c), (LAS unsigned*)wslot, 4, 0, 0);
        __builtin_amdgcn_global_load_lds((const unsigned*)(cw + c), (LAS unsigned*)(wslot + 256), 4, 0, 0);
        __builtin_amdgcn_global_load_lds((const unsigned*)(cw + ncol + c), (LAS unsigned*)(wslot + 512), 4, 0, 0);
        __builtin_amdgcn_global_load_lds((const unsigned*)(cw + 2 * ncol + c), (LAS unsigned*)(wslot + 768), 4, 0, 0);
        __builtin_amdgcn_global_load_lds((const unsigned*)(cb + c), (LAS unsigned*)(wslot + 1024), 4, 0, 0);
    }
    __device__ __forceinline__ void operator()(const f32x4 (&acc)[2][2][4][2], const Unit& u, int wr, int wc, int fr, int fq, const LAS unsigned char* wslot) const {
        asm volatile("" ::: "memory");
        const int row0 = u.pm * BM + 128 * wr, s = seq_of_row(row0), L = seq_len(s), tl0 = row0 - seq_start(s) + 8 * fr;
        bf16_t* base = UT + (size_t)seq_start(s) * ncol + tl0;
        const size_t hb = (size_t)u.pm * 2 + wr;
#pragma unroll
        for (int bj = 0; bj < 2; ++bj)
#pragma unroll
            for (int n = 0; n < 2; ++n) {
                const int c0 = u.pn * BM + bj * HALF + wc * 32 + 8 * fq + 4 * n;
                const LAS float* wsl = (const LAS float*)wslot + bj * 32 + 8 * fq + 4 * n;
                const f32x4 bi = *(const LAS f32x4*)wsl, w0 = *(const LAS f32x4*)(wsl + 64), w1 = *(const LAS f32x4*)(wsl + 128), w2 = *(const LAS f32x4*)(wsl + 192), bb = *(const LAS f32x4*)(wsl + 256);
                f32x4 x[8];
#pragma unroll
                for (int k = 0; k < 8; ++k) x[k] = acc[k >> 2][bj][k & 3][n] + bi;
                f32x4 pv, nx;
#pragma unroll
                for (int j = 0; j < 4; ++j) { pv[j] = dpp_shr1(x[7][j]); nx[j] = dpp_shl1(x[0][j]); }
#pragma unroll
                for (int j = 0; j < 4; ++j) {
                    float y[8];
#pragma unroll
                    for (int k = 0; k < 8; ++k) { const float ap = (k == 0) ? pv[j] : x[k - 1][j], an = (k == 7) ? nx[j] : x[k + 1][j]; y[k] = __builtin_fmaf(w2[j], an, __builtin_fmaf(w1[j], x[k][j], __builtin_fmaf(w0[j], ap, bb[j]))); }
                    u32x4 w; w.x = cvt_pk_bf16(y[0], y[1]); w.y = cvt_pk_bf16(y[2], y[3]); w.z = cvt_pk_bf16(y[4], y[5]); w.w = cvt_pk_bf16(y[6], y[7]);
                    *(u32x4*)(base + (size_t)(c0 + j) * L) = w;
                }
                if (fr == 0) { u32x2 w; w.x = cvt_pk_bf16(x[0][0], x[0][1]); w.y = cvt_pk_bf16(x[0][2], x[0][3]); *(u32x2*)(EU + (hb * 2 + 0) * ncol + c0) = w; }
                if (fr == 15) { u32x2 w; w.x = cvt_pk_bf16(x[7][0], x[7][1]); w.y = cvt_pk_bf16(x[7][2], x[7][3]); *(u32x2*)(EU + (hb * 2 + 1) * ncol + c0) = w; }
            }
    }
};

template <bool ROWPERM, class Epi, class Sched>
__device__ __forceinline__ void gemm_phase(LAS unsigned char* lds, const Gemm g, const Sched& S, const Epi& E) {
    int tid = threadIdx.x; asm volatile("" : "+v"(tid));
    const int wid = __builtin_amdgcn_readfirstlane(tid >> 6), lane = tid & 63, wr = wid >> 2, wc = wid & 3, fr = lane & 15, fq = lane >> 4;
    const int K = g.K, nt = K / BK;
    unsigned voffA[2], voffB[2];
#pragma unroll
    for (int i = 0; i < 2; ++i) { int R, C; stage_rc(tid * 16 + i * 8192, R, C); const int Rb = (R & ~31) + perm32(R & 31);
        const int Ra = ROWPERM ? (128 * (R >> 6) + 8 * (R & 15) + ((R >> 4) & 3)) : R;
        voffA[i] = (unsigned)(Ra * g.lda + C) * 2u; voffB[i] = (unsigned)(Rb * g.ldb + C) * 2u; }
    const size_t kstep = (size_t)(BK * 2);
    const size_t hstepA = (size_t)(ROWPERM ? 4 : HALF) * g.lda * 2, hstepB = (size_t)HALF * g.ldb * 2;
    const unsigned ldsw = (unsigned)wid * 1024u;
    const int aoff = lds_byte(wr * 64 + fr, fq * 8), boff = lds_byte(wc * 32 + fr, fq * 8);
#define PG8_SA(b, h) (((b) * 2 + (h)) * HTB)
#define PG8_SB(b, h) ((4 + (b) * 2 + (h)) * HTB)
#define PG8_STAGE(bufoff, gbase, voff) do { _Pragma("unroll") for (int _i = 0; _i < 2; ++_i) \
        __builtin_amdgcn_global_load_lds((const unsigned*)((const char*)(gbase) + (voff)[_i]), (LAS unsigned*)(lds + (bufoff) + ldsw + _i * 8192), 16, 0, 0); } while (0)
#define PG8_LDA(dst, b, h) do { _Pragma("unroll") for (int m = 0; m < 4; ++m) _Pragma("unroll") for (int k = 0; k < 2; ++k) dst[m][k] = *(const LAS bf16x8*)(lds + PG8_SA(b, h) + aoff + m * 2048 + k * 1024); } while (0)
#define PG8_LDB(dst, b, h) do { _Pragma("unroll") for (int n = 0; n < 2; ++n) _Pragma("unroll") for (int k = 0; k < 2; ++k) dst[n][k] = *(const LAS bf16x8*)(lds + PG8_SB(b, h) + boff + n * 2048 + k * 1024); } while (0)
#define PG8_MMA(ai, bj, At, Bt) do { __builtin_amdgcn_s_setprio(1); _Pragma("unroll") for (int m = 0; m < 4; ++m) _Pragma("unroll") for (int n = 0; n < 2; ++n) _Pragma("unroll") for (int k = 0; k < 2; ++k) \
        acc[ai][bj][m][n] = __builtin_amdgcn_mfma_f32_16x16x32_bf16(Bt[n][k], At[m][k], acc[ai][bj][m][n], 0, 0, 0); __builtin_amdgcn_s_setprio(0); } while (0)
#define PG8_WAIT_V(n) asm volatile("s_waitcnt vmcnt(" #n ")" ::: "memory")
#define PG8_WAIT_L(n) asm volatile("s_waitcnt lgkmcnt(" #n ")" ::: "memory")
#define PG8_BAR __builtin_amdgcn_s_barrier()
#define PG8_SCHED __builtin_amdgcn_sched_barrier(0)
#define PG8_ABASE(u) ((const char*)g.A + ((size_t)(u).pm * BM * g.lda + (g.agrp ? (size_t)((u).pn / g.agrp) * K : (size_t)0)) * 2)
#define PG8_BBASE(u) ((const char*)g.Bt + (size_t)(u).pn * BM * g.ldb * 2)
    Unit cur, nxt; int ui = 0;
    if (!S.next(0, cur)) return;
    f32x4 acc[2][2][4][2];
#pragma unroll
    for (int a = 0; a < 2; ++a)
#pragma unroll
        for (int b = 0; b < 2; ++b)
#pragma unroll
            for (int m = 0; m < 4; ++m)
#pragma unroll
                for (int n = 0; n < 2; ++n) acc[a][b][m][n] = (f32x4){0.f, 0.f, 0.f, 0.f};
    bf16x8 At[4][2], B0[2][2], B1[2][2];
    const char* cA = PG8_ABASE(cur); const char* cB = PG8_BBASE(cur);
    PG8_STAGE(PG8_SB(0, 0), cB, voffB); PG8_STAGE(PG8_SA(0, 0), cA, voffA); PG8_STAGE(PG8_SB(0, 1), cB + hstepB, voffB); PG8_STAGE(PG8_SA(0, 1), cA + hstepA, voffA);
    if (wr == 1) PG8_BAR;
    PG8_WAIT_V(4); PG8_BAR;
    PG8_STAGE(PG8_SB(1, 0), cB + kstep, voffB); PG8_STAGE(PG8_SA(1, 0), cA + kstep, voffA); PG8_STAGE(PG8_SB(1, 1), cB + hstepB + kstep, voffB);
    PG8_WAIT_V(6); PG8_BAR;
    LAS unsigned char* const wslot = lds + STAGE_BYTES + wid * 1536;
    for (;;) {
        E.prefetch(wslot, cur, wc, lane);
        const bool has_next = S.next(ui + 1, nxt);
        const char* nA = has_next ? PG8_ABASE(nxt) : cA; const char* nB = has_next ? PG8_BBASE(nxt) : cB;
        for (int t = 0; t < nt; t += 2) {
            const bool last = (t == nt - 2);
            const char* a1 = cA + (size_t)(t + 1) * kstep;
            const char* a2 = last ? nA : cA + (size_t)(t + 2) * kstep; const char* b2 = last ? nB : cB + (size_t)(t + 2) * kstep;
            const char* a3 = a2 + kstep; const char* b3 = b2 + kstep;
            PG8_LDB(B0, 0, 0); PG8_SCHED; PG8_LDA(At, 0, 0); PG8_STAGE(PG8_SA(1, 1), a1 + hstepA, voffA);
            PG8_WAIT_L(8); PG8_BAR; PG8_WAIT_L(0); PG8_MMA(0, 0, At, B0); PG8_BAR; PG8_SCHED;
            PG8_LDB(B1, 0, 1); PG8_STAGE(PG8_SB(0, 0), b2, voffB);
            PG8_BAR; PG8_WAIT_L(0); PG8_MMA(0, 1, At, B1); PG8_BAR;
            PG8_LDA(At, 0, 1); PG8_STAGE(PG8_SA(0, 0), a2, voffA);
            PG8_BAR; PG8_WAIT_L(0); PG8_MMA(1, 0, At, B0); PG8_BAR; PG8_SCHED;
            PG8_STAGE(PG8_SB(0, 1), b2 + hstepB, voffB);
            PG8_WAIT_V(6); PG8_BAR; PG8_MMA(1, 1, At, B1); PG8_BAR;
            PG8_LDB(B0, 1, 0); PG8_SCHED; PG8_LDA(At, 1, 0); PG8_STAGE(PG8_SA(0, 1), a2 + hstepA, voffA);
            PG8_WAIT_L(8); PG8_BAR; PG8_WAIT_L(0); PG8_MMA(0, 0, At, B0); PG8_BAR; PG8_SCHED;
            PG8_LDB(B1, 1, 1); PG8_STAGE(PG8_SB(1, 0), b3, voffB);
            PG8_BAR; PG8_WAIT_L(0); PG8_MMA(0, 1, At, B1); PG8_BAR;
            PG8_LDA(At, 1, 1); PG8_STAGE(PG8_SA(1, 0), a3, voffA);
            PG8_BAR; PG8_WAIT_L(0); PG8_MMA(1, 0, At, B0); PG8_BAR; PG8_SCHED;
            PG8_STAGE(PG8_SB(1, 1), b3 + hstepB, voffB);
            PG8_WAIT_V(6); PG8_BAR; PG8_MMA(1, 1, At, B1); PG8_BAR;
        }
        E(acc, cur, wr, wc, fr, fq, wslot);
        if (!has_next) break;
#pragma unroll
        for (int a = 0; a < 2; ++a)
#pragma unroll
            for (int b = 0; b < 2; ++b)
#pragma unroll
                for (int m = 0; m < 4; ++m)
#pragma unroll
                    for (int n = 0; n < 2; ++n) acc[a][b][m][n] = (f32x4){0.f, 0.f, 0.f, 0.f};
        cur = nxt; cA = nA; cB = nB; ++ui;
    }
    PG8_WAIT_V(0);
    if (wr == 0) PG8_BAR;
    PG8_BAR;
#undef PG8_SA
#undef PG8_SB
#undef PG8_STAGE
#undef PG8_LDA
#undef PG8_LDB
#undef PG8_MMA
#undef PG8_WAIT_V
#undef PG8_WAIT_L
#undef PG8_BAR
#undef PG8_SCHED
#undef PG8_ABASE
#undef PG8_BBASE
}
}
namespace att {
constexpr int HD = 128, NW = 8, QBLK = 32, KVBLK = 64;
constexpr float SCALE = 0.088388347648318440f;
constexpr float THR = 8.f;
constexpr int LDQ = 3072, LDK = 3072, LDO = 2048;
constexpr int SHM_V = KVBLK * HD * 2, SHM_K = KVBLK * HD * 2, SHM_ATTN = 2 * SHM_V + 2 * SHM_K + NW * 64 * 4;
#define KSWZ(row, colB) ((row) * 256 + ((colB) ^ (((row) & 7) << 4)))
#define SBAR() __builtin_amdgcn_sched_barrier(0)
__device__ __forceinline__ int crow(int r, int hi) { return (r & 3) + 8 * (r >> 2) + 4 * hi; }

__device__ __forceinline__ void partialSM(f32x16& p0, f32x16& p1, float& m_reg, float& mn, float& alpha) {
  constexpr float C = SCALE * 1.4426950408889634f;
  float pmax = p0[0];
#pragma unroll
  for (int r = 1; r < 16; ++r) pmax = fmaxf(pmax, p0[r]);
#pragma unroll
  for (int r = 0; r < 16; ++r) pmax = fmaxf(pmax, p1[r]);
  { auto rr = __builtin_amdgcn_permlane32_swap(__float_as_uint(pmax), __float_as_uint(pmax), false, false);
    pmax = fmaxf(__uint_as_float(rr[0]), __uint_as_float(rr[1])); }
  if (__builtin_expect(__all(pmax - m_reg <= THR / SCALE), 1)) { mn = m_reg; alpha = 1.f; }
  else { mn = fmaxf(m_reg, pmax); alpha = __builtin_amdgcn_exp2f((m_reg - mn) * C); m_reg = mn; }
  float mnC = -mn * C;
#pragma unroll
  for (int r = 0; r < 16; ++r) p0[r] = fmaf(p0[r], C, mnC);
#pragma unroll
  for (int r = 0; r < 16; ++r) p1[r] = fmaf(p1[r], C, mnC);
#pragma unroll
  for (int r = 0; r < 16; ++r) p0[r] = __builtin_amdgcn_exp2f(p0[r]);
}
__device__ __forceinline__ void finishSM(f32x16& p0, f32x16& p1, float alpha, float& l_reg, bf16x8& pa0, bf16x8& pa1, bf16x8& pa2, bf16x8& pa3) {
#pragma unroll
  for (int r = 0; r < 16; ++r) p1[r] = __builtin_amdgcn_exp2f(p1[r]);
  float ps = 0;
#pragma unroll
  for (int r = 0; r < 16; ++r) ps += p0[r];
#pragma unroll
  for (int r = 0; r < 16; ++r) ps += p1[r];
  { auto rr = __builtin_amdgcn_permlane32_swap(__float_as_uint(ps), __float_as_uint(ps), false, false);
    ps = __uint_as_float(rr[0]) + __uint_as_float(rr[1]); }
  l_reg = l_reg * alpha + ps;
#define PK4(P, BASE, OUT) do { unsigned a0 = cvt_pk_bf16(P[BASE + 0], P[BASE + 1]), a1 = cvt_pk_bf16(P[BASE + 2], P[BASE + 3]);   \
    unsigned b0 = cvt_pk_bf16(P[BASE + 4], P[BASE + 5]), b1 = cvt_pk_bf16(P[BASE + 6], P[BASE + 7]);                              \
    auto r0 = __builtin_amdgcn_permlane32_swap(a0, b0, false, false); auto r1 = __builtin_amdgcn_permlane32_swap(a1, b1, false, false); \
    u32x4 w = {r0[0], r1[0], r0[1], r1[1]}; OUT = *reinterpret_cast<bf16x8*>(&w); } while (0)
  PK4(p0, 0, pa0); PK4(p0, 8, pa1); PK4(p1, 0, pa2); PK4(p1, 8, pa3);
#undef PK4
}
__device__ __forceinline__ void qkt(f32x16& p0, f32x16& p1, const bf16_t* Ks, const bf16x8* qr, int r32, int hi) {
  p0 = f32x16{}; p1 = f32x16{};
#pragma unroll
  for (int d0 = 0; d0 < 8; ++d0) { int cb = (d0 * 16 + hi * 8) * 2;
    bf16x8 b0 = *reinterpret_cast<const bf16x8*>((const char*)Ks + KSWZ(r32, cb));
    bf16x8 b1 = *reinterpret_cast<const bf16x8*>((const char*)Ks + KSWZ(32 + r32, cb));
    p0 = __builtin_amdgcn_mfma_f32_32x32x16_bf16(b0, qr[d0], p0, 0, 0, 0);
    p1 = __builtin_amdgcn_mfma_f32_32x32x16_bf16(b1, qr[d0], p1, 0, 0, 0); }
}
__device__ __forceinline__ int v_st(int k, int c) { const int kk = (k & ~0xC) | ((k & 4) << 1) | ((k & 8) >> 1); return ((kk >> 3) * 4 + (c >> 5)) * 512 + ((kk & 7) * 32 + (c & 31)) * 2; }
__device__ __forceinline__ int v_rd_base(int lane) { return ((lane & 3) << 3) | (((lane >> 2) & 3) << 6) | (((lane >> 4) & 1) << 5) | (((lane >> 5) & 1) << 8); }
constexpr int v_rd_off(int d0, int ks, int half) { return d0 * 512 + ks * 4096 + half * 2048; }
template <int OFF> __device__ __forceinline__ s16x4 tr_read(int vb) {
  s16x4 r; asm volatile("ds_read_b64_tr_b16 %0, %1 offset:%2" : "=&v"(r) : "v"(vb), "i"(OFF) : "memory"); return r;
}
template <int D0> __device__ __forceinline__ void pv_one(f32x16& od, int vb, bf16x8 pa0, bf16x8 pa1, bf16x8 pa2, bf16x8 pa3) {
  const s16x4 l0 = tr_read<v_rd_off(D0, 0, 0)>(vb), h0 = tr_read<v_rd_off(D0, 0, 1)>(vb), l1 = tr_read<v_rd_off(D0, 1, 0)>(vb), h1 = tr_read<v_rd_off(D0, 1, 1)>(vb);
  const s16x4 l2 = tr_read<v_rd_off(D0, 2, 0)>(vb), h2 = tr_read<v_rd_off(D0, 2, 1)>(vb), l3 = tr_read<v_rd_off(D0, 3, 0)>(vb), h3 = tr_read<v_rd_off(D0, 3, 1)>(vb);
  asm volatile("s_waitcnt lgkmcnt(0)" ::: "memory"); SBAR();
#define PK(L, H) (bf16x8){L[0], L[1], L[2], L[3], H[0], H[1], H[2], H[3]}
  od = __builtin_amdgcn_mfma_f32_32x32x16_bf16(PK(l0, h0), pa0, od, 0, 0, 0);
  od = __builtin_amdgcn_mfma_f32_32x32x16_bf16(PK(l1, h1), pa1, od, 0, 0, 0);
  od = __builtin_amdgcn_mfma_f32_32x32x16_bf16(PK(l2, h2), pa2, od, 0, 0, 0);
  od = __builtin_amdgcn_mfma_f32_32x32x16_bf16(PK(l3, h3), pa3, od, 0, 0, 0);
#undef PK
}
__device__ __forceinline__ void pv_d0(f32x16* o, int vb, bf16x8 pa0, bf16x8 pa1, bf16x8 pa2, bf16x8 pa3) {
  pv_one<0>(o[0], vb, pa0, pa1, pa2, pa3); pv_one<1>(o[1], vb, pa0, pa1, pa2, pa3); pv_one<2>(o[2], vb, pa0, pa1, pa2, pa3); pv_one<3>(o[3], vb, pa0, pa1, pa2, pa3);
}

__device__ __forceinline__ void attn_dense_body(const bf16_t* __restrict__ Qb, const bf16_t* __restrict__ Kh, const bf16_t* __restrict__ Vh,
                                                bf16_t* __restrict__ Ob, int seq, char* lds) {
  int tid = threadIdx.x; asm volatile("" : "+v"(tid));
  const int wid = tid >> 6, lane = tid & 63, r32 = lane & 31, hi = lane >> 5;
  bf16_t* V_lds = (bf16_t*)lds; bf16_t* K_lds = (bf16_t*)(lds + 2 * SHM_V);
  float* ws = (float*)(lds + 2 * SHM_V + 2 * SHM_K) + wid * 64; float* li_l = ws; float* al_l = ws + 32;
  float m_reg = -1e30f, l_reg = 0; f32x16 o[4] = {}; bf16x8 qr[8];
  const bf16_t* Qw = Qb + (long)(wid * QBLK + r32) * LDQ + hi * 8;
#pragma unroll
  for (int d0 = 0; d0 < 8; ++d0) qr[d0] = *reinterpret_cast<const bf16x8*>(Qw + d0 * 16);
  const int sr = tid >> 4, sc = (tid & 15) * 8, vst0 = v_st(sr, sc), vst1 = v_st(32 + sr, sc);
  const int vb0 = (int)(uintptr_t)V_lds + v_rd_base(lane);
  struct { bf16x8 vs0, vs1, ks0, ks1; } sr_[2];
#define SLOAD(i, k0) do { sr_[i].vs0 = *reinterpret_cast<const bf16x8*>(&Vh[(long)((k0) + sr) * LDK + sc]); sr_[i].vs1 = *reinterpret_cast<const bf16x8*>(&Vh[(long)((k0) + 32 + sr) * LDK + sc]); \
    sr_[i].ks0 = *reinterpret_cast<const bf16x8*>(&Kh[(long)((k0) + sr) * LDK + sc]); sr_[i].ks1 = *reinterpret_cast<const bf16x8*>(&Kh[(long)((k0) + 32 + sr) * LDK + sc]); } while (0)
#define SWRITE(b, i) do { *(bf16x8*)((char*)V_lds + (b) * SHM_V + vst0) = sr_[i].vs0;          \
    *(bf16x8*)((char*)V_lds + (b) * SHM_V + vst1) = sr_[i].vs1; int kc = sc * 2;               \
    *(bf16x8*)((char*)K_lds + (b) * SHM_K + KSWZ(sr, kc)) = sr_[i].ks0;                       \
    *(bf16x8*)((char*)K_lds + (b) * SHM_K + KSWZ(32 + sr, kc)) = sr_[i].ks1; } while (0)
#define SWAIT() asm volatile("s_waitcnt vmcnt(4)" ::: "memory")
#define RESC(a) do { if (__any((a) < 1.f)) { const float _al = (a); \
    _Pragma("unroll") for (int d = 0; d < 4; ++d) _Pragma("unroll") for (int r = 0; r < 16; ++r) o[d][r] *= _al; } } while (0)
  f32x16 pA0, pA1, pB0, pB1; float mnA, mnB, alA, alB; bf16x8 pa0, pa1, pa2, pa3; const int NT = seq / KVBLK;
  constexpr int SE = 0, SO = 1;
  SLOAD(SE, 0); asm volatile("s_waitcnt vmcnt(0)" ::: "memory"); SWRITE(0, SE); __syncthreads();
  qkt(pA0, pA1, K_lds, qr, r32, hi); partialSM(pA0, pA1, m_reg, mnA, alA);
  SLOAD(SO, KVBLK); if (2 < NT) SLOAD(SE, 2 * KVBLK);
  SWAIT(); SWRITE(1, SO); __syncthreads();
  for (int j = 1; j + 1 < NT; j += 2) {
    SBAR(); qkt(pB0, pB1, (bf16_t*)((char*)K_lds + SHM_K), qr, r32, hi);
    finishSM(pA0, pA1, alA, l_reg, pa0, pa1, pa2, pa3); SBAR();
    SLOAD(SO, (j + 2) * KVBLK); SBAR();
    pv_d0(o, vb0, pa0, pa1, pa2, pa3); partialSM(pB0, pB1, m_reg, mnB, alB);
    __syncthreads(); SWAIT(); SWRITE(0, SE);
    RESC(alB); __syncthreads();
    SBAR(); qkt(pA0, pA1, K_lds, qr, r32, hi);
    finishSM(pB0, pB1, alB, l_reg, pa0, pa1, pa2, pa3); SBAR();
    if (j + 3 < NT) SLOAD(SE, (j + 3) * KVBLK); SBAR();
    pv_d0(o, vb0 + (int)SHM_V, pa0, pa1, pa2, pa3); partialSM(pA0, pA1, m_reg, mnA, alA);
    __syncthreads(); SWAIT(); SWRITE(1, SO);
    RESC(alA); __syncthreads();
  }
  SBAR(); qkt(pB0, pB1, (bf16_t*)((char*)K_lds + SHM_K), qr, r32, hi);
  finishSM(pA0, pA1, alA, l_reg, pa0, pa1, pa2, pa3); SBAR();
  pv_d0(o, vb0, pa0, pa1, pa2, pa3); partialSM(pB0, pB1, m_reg, mnB, alB);
  __syncthreads(); RESC(alB);
  finishSM(pB0, pB1, alB, l_reg, pa0, pa1, pa2, pa3); SBAR();
  pv_d0(o, vb0 + (int)SHM_V, pa0, pa1, pa2, pa3);
  const float rl = __builtin_amdgcn_rcpf(l_reg);
  bf16_t* Ow = Ob + (long)(wid * QBLK + r32) * LDO + hi * 8;
#pragma unroll
  for (int d0 = 0; d0 < 4; ++d0)
#pragma unroll
    for (int g = 0; g < 4; g += 2) {
      unsigned ax = cvt_pk_bf16(o[d0][4 * g + 0] * rl, o[d0][4 * g + 1] * rl), ay = cvt_pk_bf16(o[d0][4 * g + 2] * rl, o[d0][4 * g + 3] * rl);
      unsigned bx = cvt_pk_bf16(o[d0][4 * g + 4] * rl, o[d0][4 * g + 5] * rl), by = cvt_pk_bf16(o[d0][4 * g + 6] * rl, o[d0][4 * g + 7] * rl);
      { auto r0 = __builtin_amdgcn_permlane32_swap(ax, bx, false, false); ax = r0[0]; bx = r0[1]; }
      { auto r1 = __builtin_amdgcn_permlane32_swap(ay, by, false, false); ay = r1[0]; by = r1[1]; }
      u32x4 w = {ax, ay, bx, by};
      *reinterpret_cast<u32x4*>(Ow + d0 * 32 + 8 * g) = w;
    }
#undef SLOAD
#undef SWRITE
#undef SWAIT
#undef RESC
}
#undef KSWZ
#undef SBAR
}
#define XB_TMO      128
#define XB_XCNT(j)  (256  + 64 * (j))
#define XB_XSUB(j)  (1280 + 64 * (j))
#define XB_XGEN(j)  (2304 + 64 * (j))
#define XB_TOP      3328
#define XB_TOPGEN   3392
#define XCD_BAR_WORDS 3456
#define XB_SPIN_CAP (1u << 22)

__device__ __forceinline__ unsigned xb_ld(unsigned* p)              { return __hip_atomic_load(p, __ATOMIC_RELAXED, __HIP_MEMORY_SCOPE_AGENT); }
__device__ __forceinline__ unsigned xb_add(unsigned* p, unsigned v) { return __hip_atomic_fetch_add(p, v, __ATOMIC_RELAXED, __HIP_MEMORY_SCOPE_AGENT); }
__device__ __forceinline__ unsigned xb_xcc_id() { return (unsigned)__builtin_amdgcn_s_getreg((3 << 11) | 20) & 0xFu; }
#define XB_SPIN(cond, bar) do { unsigned _sp = 0; while (cond) { __builtin_amdgcn_s_sleep(1); \
    if ((++_sp & 255u) == 0u) { if (xb_ld(&(bar)[XB_TMO])) break; if (_sp > XB_SPIN_CAP) { atomicAdd(&(bar)[XB_TMO], 1u); break; } } } } while (0)

struct XcdBarrier { unsigned* bar; unsigned x; volatile LAS unsigned* st; };

__device__ __forceinline__ XcdBarrier xcd_barrier_post(unsigned* bar, volatile LAS unsigned* st) {
    XcdBarrier b; b.bar = bar; b.x = xb_xcc_id(); b.st = st;
    if (threadIdx.x == 0) (void)xb_add(&bar[XB_XCNT(b.x)], 1u);
    return b;
}
__device__ __forceinline__ void xcd_barrier_complete(unsigned* bar, unsigned x, unsigned& nloc, unsigned& nx) {
    const unsigned G = gridDim.x * gridDim.y * gridDim.z;
    unsigned sum, cnt, mine, sp = 0u;
    for (;;) {
        sum = 0u; cnt = 0u; mine = 0u;
#pragma unroll
        for (unsigned j = 0; j < 16; ++j) { const unsigned c = xb_ld(&bar[XB_XCNT(j)]); sum += c; cnt += (c > 0u) ? 1u : 0u; mine = (j == x) ? c : mine; }
        if (sum == G) break;
        __builtin_amdgcn_s_sleep(1);
        if ((++sp & 255u) == 0u) { if (xb_ld(&bar[XB_TMO])) break; if (sp > XB_SPIN_CAP) { atomicAdd(&bar[XB_TMO], 1u); break; } }
    }
    nloc = mine > 0u ? mine : 1u; nx = cnt > 0u ? cnt : 1u;
}
__device__ __forceinline__ void xcd_barrier(const XcdBarrier& b) {
    asm volatile("s_waitcnt vmcnt(0)" ::: "memory");
    __syncthreads();
    if (threadIdx.x == 0) {
        unsigned* bar = b.bar;
        __builtin_amdgcn_s_waitcnt(0);
        unsigned nloc = b.st[0], nx = b.st[1];
        if (nloc == 0u) { xcd_barrier_complete(bar, b.x, nloc, nx); b.st[0] = nloc; b.st[1] = nx; }
        const unsigned old = xb_add(&bar[XB_XSUB(b.x)], 1u);
        const unsigned gen = old / nloc;
        if (old + 1u == (gen + 1u) * nloc) {
            __builtin_amdgcn_fence(__ATOMIC_RELEASE, "agent");
            asm volatile("s_waitcnt vmcnt(0)" ::: "memory");
            const unsigned og = xb_add(&bar[XB_TOP], 1u);
            const unsigned tg = og / nx;
            if (og + 1u == (tg + 1u) * nx) xb_add(&bar[XB_TOPGEN], 1u);
            else XB_SPIN(xb_ld(&bar[XB_TOPGEN]) == tg, bar);
            __builtin_amdgcn_fence(__ATOMIC_ACQUIRE, "agent");
            xb_add(&bar[XB_XGEN(b.x)], 1u);
            asm volatile("s_waitcnt vmcnt(0)" ::: "memory");
        } else {
            XB_SPIN(xb_ld(&bar[XB_XGEN(b.x)]) == gen, bar);
            __builtin_amdgcn_fence(__ATOMIC_ACQUIRE, "agent");
            asm volatile("s_waitcnt vmcnt(0)" ::: "memory");
        }
    }
    __syncthreads();
}
#define LDS_WAIT() asm volatile("s_waitcnt lgkmcnt(0)" ::: "memory")
#define VM_WAIT() asm volatile("s_waitcnt vmcnt(0)" ::: "memory")
constexpr int NWAVES = 8, NTHREADS = 512;
constexpr int LDS_BYTES = 147456;
constexpr int MISC_OFF = 140 * 1024;

struct Args { const float* in[32]; float* out; unsigned char* ws; int ph_lo, ph_hi, li, pad; };
struct Frame { LAS unsigned char* lds; int tid, lane, wave, vcu, G, gw, NGW; };

enum { I_XP = 0, I_XS, I_CP, I_CS, I_MODW, I_MODB, I_NMPRE, I_NMPOST, I_NFPRE, I_NFPOST, I_FUP, I_FCW, I_FCB, I_FDN, I_POOLW, I_POOLS,
       I_HWIN, I_HBIN, I_HCW, I_HCB, I_HFW1, I_HFB1, I_HFW2, I_HFB2, I_HFW3, I_HFREQ, I_HSKIP, I_HWOUT, I_AQKV, I_AQG, I_AKG, I_AWO };

constexpr size_t MiB = 1u << 20;
constexpr size_t WS_CTL = 0, CTL_ZERO_BYTES = 1 * MiB;
constexpr size_t WS_MOD = 1 * MiB;
constexpr size_t WS_A2 = 2 * MiB;
constexpr size_t WS_W3T = 5 * MiB;
constexpr size_t WS_POOLW = 6 * MiB;
constexpr size_t WS_HYWIN = 10 * MiB;
constexpr size_t WS_HYWOUT = 34 * MiB;
constexpr size_t WS_ATQKV = 42 * MiB;
constexpr size_t WS_ATWO = 54 * MiB;
constexpr size_t WS_WUP = 62 * MiB;
constexpr size_t WS_WDN = 106 * MiB;
constexpr size_t WS_H = 128 * MiB;
constexpr size_t WS_M1 = 320 * MiB;
constexpr size_t WS_BIG = 512 * MiB;
constexpr size_t WS_U = WS_BIG, WS_EA = WS_BIG + 528 * MiB, WS_EB = WS_BIG + 548 * MiB;
constexpr size_t WS_QKV = WS_BIG, WS_O = WS_BIG + 288 * MiB;
constexpr size_t WS_P = WS_BIG;
constexpr size_t WS_UT = 320 * MiB;
constexpr size_t WS_EU = 896 * MiB;
constexpr size_t WS_FK = 906 * MiB;
constexpr size_t WS_ZT = 1099 * MiB;
constexpr size_t WS_M1H = WS_M1;
constexpr size_t WS_XB = 1147 * MiB;
constexpr size_t WS_END = 1339 * MiB;
constexpr int FK_PITCH_P = 2 * LP + 32, FK_PITCH_S = 2 * LS + 32;
constexpr size_t FK_SAMPLE_OFF = (size_t)2 * 512 * FK_PITCH_P;

__device__ __forceinline__ unsigned pk2(float lo, float hi) { return cvt_pk_bf16(lo, hi); }
template <bool GLUMAP = false>
__device__ __forceinline__ void transpose_item(const float* W, int N, bf16_t* WT, int ldk, LAS float* scr, int item, int lane) {
    const int nblk = N / 32, kb = item / nblk, nb = item % nblk, k0 = 64 * kb, n0 = 32 * nb;
    const int d0 = GLUMAP ? (((n0 % DFF) / 128) * 256 + (n0 / DFF) * 128 + (n0 % 128)) : n0;
    { f32x4 v[8]; const int kr = lane >> 3, ch = (lane & 7) * 4;
#pragma unroll
      for (int i = 0; i < 8; ++i) v[i] = *(const f32x4*)(W + (size_t)(k0 + kr + 8 * i) * N + n0 + ch);
#pragma unroll
      for (int i = 0; i < 8; ++i) { LAS float* d = scr + (kr + 8 * i) * 33 + ch; d[0] = v[i].x; d[1] = v[i].y; d[2] = v[i].z; d[3] = v[i].w; } }
    LDS_WAIT();
    const int c = lane & 7;
#pragma unroll
    for (int j = 0; j < 4; ++j) { const int n = (lane >> 3) + 8 * j; const LAS float* s = scr + (8 * c) * 33 + n;
        u32x4 o; o.x = pk2(s[0 * 33], s[1 * 33]); o.y = pk2(s[2 * 33], s[3 * 33]); o.z = pk2(s[4 * 33], s[5 * 33]); o.w = pk2(s[6 * 33], s[7 * 33]);
        *(u32x4*)(WT + (size_t)(d0 + n) * ldk + k0 + 8 * c) = o; }
    LDS_WAIT();
}
template <bool GLUMAP = false>
__device__ __forceinline__ void prep_matrix(const Frame& F, const float* W, int K, int N, bf16_t* WT) {
    LAS float* scr = (LAS float*)(F.lds + F.wave * 8448);
    const int nitems = (K / 64) * (N / 32);
    for (int it = F.gw; it < nitems; it += F.NGW) transpose_item<GLUMAP>(W, N, WT, K, scr, it, F.lane);
}
__device__ __forceinline__ void prep_ffn_weights(const Frame& F, const Args& a, int layer) {
    prep_matrix<true>(F, a.in[I_FUP] + (size_t)layer * D * 2 * DFF, D, 2 * DFF, (bf16_t*)(a.ws + WS_WUP));
    prep_matrix(F, a.in[I_FDN] + (size_t)layer * DFF * D, DFF, D, (bf16_t*)(a.ws + WS_WDN));
}

__device__ __forceinline__ void mod_phase(const Frame& F, const Args& a) {
    LAS float* cact = (LAS float*)F.lds;
    LAS float* red = (LAS float*)(F.lds + 40960);
    for (int i = F.tid; i < NB * D; i += NTHREADS) { const int b = i / D, k = i % D; const float c = b < 4 ? a.in[I_CP][b * D + k] : a.in[I_CS][k]; cact[i] = c / (1.0f + __expf(-c)); }
    __syncthreads();
    const int rg = F.tid >> 4, cl = F.tid & 15;
    for (int u = F.vcu; u < NLAYER * 192; u += F.G) {
        const int layer = u / 192, col0 = (u % 192) * 64;
        const float* W = a.in[I_MODW] + (size_t)layer * D * 6 * D + col0 + cl * 4;
        f32x4 acc[NB];
#pragma unroll
        for (int b = 0; b < NB; ++b) acc[b] = (f32x4){0.f, 0.f, 0.f, 0.f};
#pragma unroll 8
        for (int k = rg; k < D; k += 32) { const f32x4 w = *(const f32x4*)(W + (size_t)k * 6 * D);
#pragma unroll
            for (int b = 0; b < NB; ++b) acc[b] += w * cact[b * D + k]; }
#pragma unroll
        for (int b = 0; b < NB; ++b) *(LAS f32x4*)(red + (rg * NB + b) * 64 + cl * 4) = acc[b];
        __syncthreads();
        if (F.tid < NB * 64) { const int b = F.tid >> 6, c = F.tid & 63; float s = 0.f;
            for (int r = 0; r < 32; ++r) s += red[(r * NB + b) * 64 + c];
            ((float*)(a.ws + WS_MOD))[((size_t)layer * NB + b) * 6 * D + col0 + c] = s + a.in[I_MODB][(size_t)layer * 6 * D + col0 + c]; }
        __syncthreads();
    }
}

__device__ __forceinline__ void hyena_features(const Frame& F, const Args& a) {
    const float* w1 = a.in[I_HFW1]; const float* b1 = a.in[I_HFB1]; const float* w2 = a.in[I_HFW2]; const float* b2 = a.in[I_HFB2]; const float* fr = a.in[I_HFREQ];
    bf16_t* A2 = (bf16_t*)(a.ws + WS_A2);
    const int lane = F.lane; const float freq = fr[lane], bb1 = b1[lane], bb2 = b2[lane];
    for (int t = F.gw; t < LP + LS; t += F.NGW) {
        const int ls = t >= LP, n = ls ? t - LP : t, L = ls ? LS : LP;
        const float tn = (float)n / (float)(L - 1), w = 6.283185307179586f * (float)n / (float)L;
        float z = 0.f;
        if (lane == 0) z = tn;
        else if (lane <= 32) { const int k = (lane - 1) & 15; const float f = 1e-4f + (float)k * ((15.0f - 1e-4f) / 15.0f); const float ang = f * w; z = lane <= 16 ? cosf(ang) : -sinf(ang); }
        float s1 = bb1;
#pragma unroll
        for (int i = 0; i < 33; ++i) s1 += __shfl(z, i) * w1[i * 64 + lane];
        const float a1 = sinf(freq * s1);
        float s2 = bb2;
#pragma unroll 16
        for (int i = 0; i < 64; ++i) s2 += __shfl(a1, i) * w2[i * 64 + lane];
        A2[(size_t)t * 64 + lane] = f2bf(sinf(freq * s2));
    }
}

__device__ __forceinline__ void prologue_phase(const Frame& F, const Args& a) {
    prep_matrix(F, a.in[I_HWIN], D, 3 * D, (bf16_t*)(a.ws + WS_HYWIN));
    prep_matrix(F, a.in[I_HWOUT], D, D, (bf16_t*)(a.ws + WS_HYWOUT));
    prep_matrix(F, a.in[I_AQKV], D, 3072, (bf16_t*)(a.ws + WS_ATQKV));
    prep_matrix(F, a.in[I_AWO], D, D, (bf16_t*)(a.ws + WS_ATWO));
    prep_matrix(F, a.in[I_HFW3], 64, 8192, (bf16_t*)(a.ws + WS_W3T));
    for (int jg = 0; jg < 8; ++jg)
        prep_matrix(F, a.in[I_POOLW] + (size_t)jg * 512 * 512, 512, 512, (bf16_t*)(a.ws + WS_POOLW) + (size_t)jg * 512 * 512);
    __syncthreads();
    hyena_features(F, a);
    __syncthreads();
    mod_phase(F, a);
}

struct NormP { const float* xp; const float* xs; const bf16_t* xb; float* xout; bf16_t* xbout; const bf16_t* m; const float* modg; int gate_off; const float* gpost;
               const float* modh; int sc_off, sh_off; const float* gpre; bf16_t* H; };
__device__ __forceinline__ void norm_load_row(const NormP& p, int r, int lane, f32x4 (&xn)[8], u32x4 (&xh)[4], u32x4 (&mn)[4]) {
    if (p.xb) {
#pragma unroll
        for (int j = 0; j < 4; ++j) xh[j] = *(const u32x4*)(p.xb + (size_t)r * D + lane * 8 + 512 * j);
    } else { const float* xr = r < TP ? p.xp + (size_t)r * D : p.xs + (size_t)(r - TP) * D;
#pragma unroll
        for (int j = 0; j < 4; ++j) { xn[2 * j] = *(const f32x4*)(xr + lane * 8 + 512 * j); xn[2 * j + 1] = *(const f32x4*)(xr + lane * 8 + 512 * j + 4); } }
    if (p.m) {
#pragma unroll
        for (int j = 0; j < 4; ++j) mn[j] = *(const u32x4*)(p.m + (size_t)r * D + lane * 8 + 512 * j); }
}
__device__ __forceinline__ void unpack4x2(const u32x4 w, f32x4& a, f32x4& b) { a = (f32x4){bf_lo(w.x), bf_hi(w.x), bf_lo(w.y), bf_hi(w.y)}; b = (f32x4){bf_lo(w.z), bf_hi(w.z), bf_lo(w.w), bf_hi(w.w)}; }
__device__ __forceinline__ u32x4 pack4x2(const f32x4 a, const f32x4 b) { u32x4 w; w.x = pk2(a.x, a.y); w.y = pk2(a.z, a.w); w.z = pk2(b.x, b.y); w.w = pk2(b.z, b.w); return w; }
__device__ __forceinline__ void norm_phase(const Frame& F, const NormP p) {
    LAS float* va = (LAS float*)F.lds; LAS float* vb = va + D; LAS float* vc = vb + D;
    const int lane = F.lane;
    for (int blk = F.vcu; blk < T / 64; blk += F.G) {
        const int r0 = blk * 64, b = seq_of_row(r0);
        f32x4 xn[2][8]; u32x4 xh[2][4], mn[2][4];
#pragma unroll
        for (int q = 0; q < 2; ++q) {
#pragma unroll
            for (int j = 0; j < 8; ++j) xn[q][j] = (f32x4){0.f, 0.f, 0.f, 0.f};
#pragma unroll
            for (int j = 0; j < 4; ++j) { xh[q][j] = (u32x4){0u, 0u, 0u, 0u}; mn[q][j] = (u32x4){0u, 0u, 0u, 0u}; }
            norm_load_row(p, r0 + F.wave * 8 + q, lane, xn[q], xh[q], mn[q]); }
        __syncthreads();
        for (int c = F.tid; c < D; c += NTHREADS) {
            if (p.m) va[c] = p.modg[(size_t)b * 6 * D + p.gate_off + c] * p.gpost[c];
            if (p.H) { vb[c] = p.gpre[c] * (1.0f + p.modh[(size_t)b * 6 * D + p.sc_off + c]); vc[c] = p.modh[(size_t)b * 6 * D + p.sh_off + c]; }
        }
        __syncthreads();
#pragma unroll
        for (int i = 0; i < 8; ++i) {
            const int r = r0 + F.wave * 8 + i, q = i & 1;
            f32x4 x[8]; u32x4 mw[4];
#pragma unroll
            for (int j = 0; j < 4; ++j) { if (p.xb) unpack4x2(xh[q][j], x[2 * j], x[2 * j + 1]); else { x[2 * j] = xn[q][2 * j]; x[2 * j + 1] = xn[q][2 * j + 1]; } mw[j] = mn[q][j]; }
            if (i < 6) norm_load_row(p, r + 2, lane, xn[q], xh[q], mn[q]);
            if (p.m) {
                f32x4 mv[8]; float ss = 0.f;
#pragma unroll
                for (int j = 0; j < 4; ++j) unpack4x2(mw[j], mv[2 * j], mv[2 * j + 1]);
#pragma unroll
                for (int j = 0; j < 8; ++j) ss += (mv[j].x * mv[j].x + mv[j].y * mv[j].y) + (mv[j].z * mv[j].z + mv[j].w * mv[j].w);
                const float rstd = 1.0f / sqrtf(wave_sum(ss) * (1.0f / D) + EPS);
#pragma unroll
                for (int j = 0; j < 8; ++j) { const f32x4 g = *(const LAS f32x4*)(va + lane * 8 + 512 * (j >> 1) + 4 * (j & 1)); x[j] += g * (mv[j] * rstd); }
                if (p.xout) { float* xo = p.xout + (size_t)r * D;
#pragma unroll
                    for (int j = 0; j < 8; ++j) *(f32x4*)(xo + lane * 8 + 512 * (j >> 1) + 4 * (j & 1)) = x[j]; }
                if (p.xbout) { bf16_t* xo = p.xbout + (size_t)r * D;
#pragma unroll
                    for (int j = 0; j < 4; ++j) *(u32x4*)(xo + lane * 8 + 512 * j) = pack4x2(x[2 * j], x[2 * j + 1]); }
            }
            if (p.H) {
                float ss = 0.f;
#pragma unroll
                for (int j = 0; j < 8; ++j) ss += (x[j].x * x[j].x + x[j].y * x[j].y) + (x[j].z * x[j].z + x[j].w * x[j].w);
                const float rstd = 1.0f / sqrtf(wave_sum(ss) * (1.0f / D) + EPS);
                bf16_t* hr = p.H + (size_t)r * D;
#pragma unroll
                for (int j = 0; j < 4; ++j) { f32x4 h[2];
#pragma unroll
                    for (int e = 0; e < 2; ++e) { const int off = lane * 8 + 512 * j + 4 * e; const f32x4 g = *(const LAS f32x4*)(vb + off), s = *(const LAS f32x4*)(vc + off); h[e] = (x[2 * j + e] * rstd) * g + s; }
                    *(u32x4*)(hr + lane * 8 + 512 * j) = pack4x2(h[0], h[1]); }
            }
        }
    }
    __syncthreads();
}

__device__ __forceinline__ void acc8(float (&acc)[8], const u32x4 w, float sg) {
    acc[0] += sg * bf_lo(w.x); acc[1] += sg * bf_hi(w.x); acc[2] += sg * bf_lo(w.y); acc[3] += sg * bf_hi(w.y); acc[4] += sg * bf_lo(w.z); acc[5] += sg * bf_hi(w.z); acc[6] += sg * bf_lo(w.w); acc[7] += sg * bf_hi(w.w); }
__device__ __forceinline__ void pool_phase(const Frame& F, const bf16_t* H, bf16_t* P) {
    const int lane = F.lane;
    for (int u = F.gw; u < (T / 32) * 4; u += F.NGW) {
        const int g = u & 3, seg = u >> 2, t0 = seg * 32, s = seq_of_row(t0), st = seq_start(s), L = seq_len(s);
        const int win = 2 << g, half = win >> 1, col = g * 512 + lane * 8;
        const bf16_t* Hs = H + (size_t)st * D + col;
        float acc[8];
#pragma unroll
        for (int e = 0; e < 8; ++e) acc[e] = 0.f;
        const int tl0 = t0 - st;
        { int lo = tl0 - half; lo = lo < 0 ? 0 : lo; int hi = tl0 + win - half - 1; hi = hi > L - 1 ? L - 1 : hi;
          u32x4 w[16];
#pragma unroll
          for (int k = 0; k < 16; ++k) { const int r = lo + k; w[k] = (r <= hi) ? *(const u32x4*)(Hs + (size_t)r * D) : (u32x4){0u, 0u, 0u, 0u}; }
#pragma unroll
          for (int k = 0; k < 16; ++k) acc8(acc, w[k], 1.0f); }
        for (int i0 = 0; i0 < 32; i0 += 8) {
            u32x4 cen[8], inn[8], outt[8];
#pragma unroll
            for (int k = 0; k < 8; ++k) { const int tl = tl0 + i0 + k;
                cen[k] = *(const u32x4*)(Hs + (size_t)tl * D);
                const int ri = tl + win - half, ro = tl - half;
                inn[k] = (ri < L) ? *(const u32x4*)(Hs + (size_t)ri * D) : (u32x4){0u, 0u, 0u, 0u};
                outt[k] = (ro >= 0) ? *(const u32x4*)(Hs + (size_t)ro * D) : (u32x4){0u, 0u, 0u, 0u}; }
#pragma unroll
            for (int k = 0; k < 8; ++k) { const int tl = tl0 + i0 + k; int lo = tl - half; lo = lo < 0 ? 0 : lo; int hi = tl + win - half - 1; hi = hi > L - 1 ? L - 1 : hi;
                const float inv = 1.0f / (float)(hi - lo + 1); const u32x4 c = cen[k];
                u32x4 o; o.x = pk2(acc[0] * inv - bf_lo(c.x), acc[1] * inv - bf_hi(c.x)); o.y = pk2(acc[2] * inv - bf_lo(c.y), acc[3] * inv - bf_hi(c.y));
                o.z = pk2(acc[4] * inv - bf_lo(c.z), acc[5] * inv - bf_hi(c.z)); o.w = pk2(acc[6] * inv - bf_lo(c.w), acc[7] * inv - bf_hi(c.w));
                *(u32x4*)(P + (size_t)(st + tl) * D + col) = o;
                acc8(acc, inn[k], 1.0f); acc8(acc, outt[k], -1.0f); }
        }
    }
}

__device__ __forceinline__ float gelu_tanh(float x) { return pg8::gelu_tanh_f(x); }
__device__ __forceinline__ void unpack8(const u32x4 w, float (&v)[8]) { v[0] = bf_lo(w.x); v[1] = bf_hi(w.x); v[2] = bf_lo(w.y); v[3] = bf_hi(w.y); v[4] = bf_lo(w.z); v[5] = bf_hi(w.z); v[6] = bf_lo(w.w); v[7] = bf_hi(w.w); }
__device__ __forceinline__ void ffn_fix_phase(const Frame& F, const bf16_t* EA, const bf16_t* EB, bf16_t* U, const float* cw, const float* cb) {
    const int lane = F.lane;
    for (int it = F.gw; it < 384 * 2 * 11; it += F.NGW) {
        const int cbk = it % 11, e = (it / 11) & 1, hb = it / 22, c0 = cbk * 512 + lane * 8;
        const int row = hb * 128 + (e ? 127 : 0), s = seq_of_row(row), pos = row - seq_start(s), L = seq_len(s);
        const u32x4 z4 = (u32x4){0u, 0u, 0u, 0u};
        u32x4 rp, rc, rn, rg;
        if (e == 0) { rp = pos > 0 ? *(const u32x4*)(EA + ((size_t)(hb - 1) * 4 + 3) * DFF + c0) : z4; rc = *(const u32x4*)(EA + ((size_t)hb * 4 + 0) * DFF + c0); rn = *(const u32x4*)(EA + ((size_t)hb * 4 + 1) * DFF + c0);
                      rg = *(const u32x4*)(EB + ((size_t)hb * 2 + 0) * DFF + c0); }
        else { rp = *(const u32x4*)(EA + ((size_t)hb * 4 + 2) * DFF + c0); rc = *(const u32x4*)(EA + ((size_t)hb * 4 + 3) * DFF + c0); rn = pos < L - 1 ? *(const u32x4*)(EA + ((size_t)(hb + 1) * 4 + 0) * DFF + c0) : z4;
               rg = *(const u32x4*)(EB + ((size_t)hb * 2 + 1) * DFF + c0); }
        float prev[8], cur[8], nxt[8], gv[8], o[8];
        unpack8(rp, prev); unpack8(rc, cur); unpack8(rn, nxt); unpack8(rg, gv);
#pragma unroll
        for (int k = 0; k < 8; ++k) { const float y = cw[c0 + k] * prev[k] + cw[DFF + c0 + k] * cur[k] + cw[2 * DFF + c0 + k] * nxt[k] + cb[c0 + k]; o[k] = gelu_tanh(y) * gv[k]; }
        u32x4 w; w.x = pk2(o[0], o[1]); w.y = pk2(o[2], o[3]); w.z = pk2(o[4], o[5]); w.w = pk2(o[6], o[7]);
        *(u32x4*)(U + (size_t)row * DFF + c0) = w;
    }
}

__device__ __forceinline__ void qk_norm_rope_phase(const Frame& F, bf16_t* QKV, const float* qg, const float* kg) {
    const int lane = F.lane, l16 = lane & 15, axis = l16 >> 3, half = (l16 >> 2) & 1, sub = lane >> 4;
    float gq[8], gk[8], inv[8];
#pragma unroll
    for (int j = 0; j < 8; ++j) { gq[j] = qg[l16 * 8 + j]; gk[j] = kg[l16 * 8 + j]; const int i = (l16 & 3) * 8 + j; inv[j] = expf(-9.210340371976184f * (float)(2 * i) / 64.0f) * 0.15915494309189535f; }
    u32x4 raw[5], nxt[5];
#pragma unroll
    for (int st = 0; st < 5; ++st) { raw[st] = (u32x4){0u, 0u, 0u, 0u}; nxt[st] = (u32x4){0u, 0u, 0u, 0u}; }
    if (F.gw < T) {
#pragma unroll
        for (int st = 0; st < 5; ++st) raw[st] = *(const u32x4*)(QKV + (size_t)F.gw * 3072 + (st * 4 + sub) * 128 + l16 * 8); }
    for (int t = F.gw; t < T; t += F.NGW) {
        if (t + F.NGW < T) {
#pragma unroll
            for (int st = 0; st < 5; ++st) nxt[st] = *(const u32x4*)(QKV + (size_t)(t + F.NGW) * 3072 + (st * 4 + sub) * 128 + l16 * 8); }
        const int s = seq_of_row(t), tl = t - seq_start(s); const float pos = (float)(axis == 0 ? (tl >> 6) : (tl & 63));
        float cs[8], sn[8];
#pragma unroll
        for (int j = 0; j < 8; ++j) { const float rev = pos * inv[j]; cs[j] = __builtin_amdgcn_cosf(rev); sn[j] = __builtin_amdgcn_sinf(rev); }
#pragma unroll
        for (int st = 0; st < 5; ++st) {
            const int hh = st * 4 + sub; bf16_t* p = QKV + (size_t)t * 3072 + hh * 128 + l16 * 8;
            float v[8]; unpack8(raw[st], v);
            float ss = 0.f;
#pragma unroll
            for (int j = 0; j < 8; ++j) ss += v[j] * v[j];
            ss += __shfl_xor(ss, 1); ss += __shfl_xor(ss, 2); ss += __shfl_xor(ss, 4); ss += __shfl_xor(ss, 8);
            const float rstd = 1.0f / sqrtf(ss * (1.0f / 128.0f) + EPS);
            float o[8];
#pragma unroll
            for (int j = 0; j < 8; ++j) { const float y = v[j] * rstd * (hh < 16 ? gq[j] : gk[j]); const float pr = __shfl_xor(y, 4);
                o[j] = half == 0 ? (y * cs[j] - pr * sn[j]) : (y * cs[j] + pr * sn[j]); }
            u32x4 w; w.x = pk2(o[0], o[1]); w.y = pk2(o[2], o[3]); w.z = pk2(o[4], o[5]); w.w = pk2(o[6], o[7]);
            *(u32x4*)p = w;
        }
#pragma unroll
        for (int st = 0; st < 5; ++st) raw[st] = nxt[st];
    }
}

__device__ __forceinline__ void attn_unit(const Frame& F, const bf16_t* QKV, bf16_t* O, int s, int head, int qb) {
    const int st = seq_start(s), L = seq_len(s), kvh = head >> 2;
    const bf16_t* Qb = QKV + (size_t)(st + qb * 256) * 3072 + head * 128;
    const bf16_t* Kh = QKV + (size_t)st * 3072 + 2048 + kvh * 128;
    const bf16_t* Vh = QKV + (size_t)st * 3072 + 2560 + kvh * 128;
    bf16_t* Ob = O + (size_t)(st + qb * 256) * D + head * 128;
    __syncthreads();
    att::attn_dense_body(Qb, Kh, Vh, Ob, L, (char*)F.lds);
}
__device__ __forceinline__ void attn_phase(const Frame& F, const bf16_t* QKV, bf16_t* O) {
    const int per = F.G / 8;
    if (F.G == 256) {
        const int xg = F.vcu / per, r = F.vcu % per;
        for (int j = 0; j < 4; ++j) {
            const int kvh = xg >> 1, idx = (xg & 1) * 128 + j * 32 + r, hg = idx >> 6, qb = idx & 63;
            attn_unit(F, QKV, O, 4, kvh * 4 + hg, qb);
        }
        for (int i = 0; i < 8; ++i) {
            const int grp = xg * 2 + (i >> 2), s = grp >> 2, kvh = grp & 3, idx = (i & 3) * 32 + r, hg = idx >> 5, qb = idx & 31;
            attn_unit(F, QKV, O, s, kvh * 4 + hg, qb);
        }
    } else {
        for (int u = F.vcu; u < 64 * 16 + 4 * 32 * 16; u += F.G) {
            if (u < 1024) attn_unit(F, QKV, O, 4, u >> 6, u & 63);
            else { const int v = u - 1024; attn_unit(F, QKV, O, v >> 9, (v >> 5) & 15, v & 31); }
        }
    }
    __syncthreads();
}
namespace hy {
__device__ constexpr float TWC[16] = {1.0f, 0.98078528040323043f, 0.92387953251128674f, 0.83146961230254524f, 0.70710678118654752f, 0.55557023301960218f, 0.38268343236508977f, 0.19509032201612825f,
                                      0.0f, -0.19509032201612825f, -0.38268343236508977f, -0.55557023301960218f, -0.70710678118654752f, -0.83146961230254524f, -0.92387953251128674f, -0.98078528040323043f};
__device__ constexpr float TWS[16] = {0.0f, 0.19509032201612825f, 0.38268343236508977f, 0.55557023301960218f, 0.70710678118654752f, 0.83146961230254524f, 0.92387953251128674f, 0.98078528040323043f,
                                      1.0f, 0.98078528040323043f, 0.92387953251128674f, 0.83146961230254524f, 0.70710678118654752f, 0.55557023301960218f, 0.38268343236508977f, 0.19509032201612825f};
__device__ __forceinline__ f32x2 cmul(f32x2 a, f32x2 b) {
    f32x2 r;
    asm("v_pk_mul_f32 %0, %1, %2 op_sel:[0,0] op_sel_hi:[0,1]\n\t"
        "v_pk_fma_f32 %0, %1, %2, %0 op_sel:[1,1,0] op_sel_hi:[1,0,1] neg_lo:[1,0,0]"
        : "=&v"(r) : "v"(a), "v"(b));
    return r;
}
__device__ __forceinline__ f32x2 cmulc(f32x2 a, f32x2 b) {
    f32x2 r;
    asm("v_pk_mul_f32 %0, %1, %2 op_sel:[0,0] op_sel_hi:[0,1] neg_hi:[0,1]\n\t"
        "v_pk_fma_f32 %0, %1, %2, %0 op_sel:[1,1,0] op_sel_hi:[1,0,1]"
        : "=&v"(r) : "v"(a), "v"(b));
    return r;
}
__device__ __forceinline__ f32x2 pk_add_pm(f32x2 a, f32x2 b) { f32x2 r; asm("v_pk_add_f32 %0, %1, %2 neg_hi:[0,1]" : "=v"(r) : "v"(a), "v"(b)); return r; }
__device__ __forceinline__ f32x2 pk_add_mp(f32x2 a, f32x2 b) { f32x2 r; asm("v_pk_add_f32 %0, %1, %2 neg_lo:[0,1]" : "=v"(r) : "v"(a), "v"(b)); return r; }
__device__ __forceinline__ f32x2 pk_addc(f32x2 a, f32x2 b)   { f32x2 r; asm("v_pk_add_f32 %0, %1, %2 neg_hi:[1,1]" : "=v"(r) : "v"(a), "v"(b)); return r; }
__device__ __forceinline__ f32x2 cconj(f32x2 a) { return (f32x2){a.x, -a.y}; }
__device__ __forceinline__ f32x2 twid(float rev) {
    float c = __builtin_amdgcn_cosf(rev), s = __builtin_amdgcn_sinf(rev);
    asm volatile("s_nop 1" : "+v"(c), "+v"(s));
    return (f32x2){c, -s};
}
__device__ __forceinline__ f32x2 twid_sc(float rev) {
    float c = __builtin_amdgcn_cosf(rev), s = __builtin_amdgcn_sinf(rev);
    asm volatile("s_nop 1" : "+v"(c), "+v"(s));
    return (f32x2){s, c};
}

template <int R, bool INV> __device__ __forceinline__ void dft(f32x2 (&v)[R]) {
    if constexpr (R == 2) { const f32x2 a = v[0], b = v[1]; v[0] = a + b; v[1] = a - b; }
    else {
        constexpr int H = R / 2; f32x2 u[H], w[H];
#pragma unroll
        for (int j = 0; j < H; ++j) { const f32x2 a = v[j], b = v[j + H]; u[j] = a + b; const f32x2 t = a - b;
            const int k = j * (32 / R);
            if (j == 0) w[j] = t;
            else if (4 * j == R) w[j] = INV ? (f32x2){-t.y, t.x} : (f32x2){t.y, -t.x};
            else w[j] = INV ? (f32x2){t.x * TWC[k] - t.y * TWS[k], t.y * TWC[k] + t.x * TWS[k]} : (f32x2){t.x * TWC[k] + t.y * TWS[k], t.y * TWC[k] - t.x * TWS[k]}; }
        dft<H, INV>(u); dft<H, INV>(w);
#pragma unroll
        for (int p = 0; p < H; ++p) { v[2 * p] = u[p]; v[2 * p + 1] = w[p]; }
    }
}
__device__ __forceinline__ int PADI(int p) { return p + (p >> 4) + (p >> 10); }
__device__ __forceinline__ unsigned PADI(unsigned p) { return p + (p >> 4) + (p >> 10); }

__host__ __device__ constexpr int POFF(int x) { return x + (x >> 4) + (x >> 10); }
template <int LOGM> __host__ __device__ constexpr int ZS() { return POFF(1 << LOGM); }
template <int R> __device__ __forceinline__ void twid_powers(f32x2 w1, f32x2 (&w)[R]) {
    w[1] = w1;
#pragma unroll
    for (int p = 2; p < R; ++p) w[p] = (p & 1) ? cmul(w[p - 1], w1) : cmul(w[p >> 1], w[p >> 1]);
}
template <int LOGM, int LOGNS, int LOGR, bool INV, int NZ, bool HALF = false> __device__ __forceinline__ void fft_stage(LAS f32x2* Z, int tid) {
    asm volatile("" : "+v"(tid));
    constexpr int R = 1 << LOGR, LOGSUB = LOGNS - LOGR, SUB = 1 << LOGSUB, NBF = 1 << (LOGM - LOGR);
    constexpr float INVNS = 1.0f / (float)(1 << LOGNS);
#pragma unroll 1
    for (int bf = tid; bf < NBF; bf += NTHREADS) {
        const int j = bf & (SUB - 1), blk = bf >> LOGSUB, base = (blk << LOGNS) + j;
        LAS f32x2* Zb = Z + PADI(base);
        f32x2 v[NZ][R];
#pragma unroll
        for (int z = 0; z < NZ; ++z)
#pragma unroll
            for (int q = 0; q < R; ++q) v[z][q] = (HALF && !INV && q >= R / 2) ? (f32x2){0.f, 0.f} : *(volatile LAS f32x2*)&Zb[z * ZS<LOGM>() + POFF(q << LOGSUB)];
        f32x2 w[R];
        if constexpr (LOGSUB > 0) { const f32x2 t = twid((float)j * INVNS); twid_powers<R>(INV ? cconj(t) : t, w); }
#pragma unroll
        for (int z = 0; z < NZ; ++z) {
            if constexpr (!INV) {
                dft<R, false>(v[z]);
                if constexpr (LOGSUB > 0) {
#pragma unroll
                    for (int p = 1; p < R; ++p) v[z][p] = cmul(v[z][p], w[p]);
                }
            } else {
                if constexpr (LOGSUB > 0) {
#pragma unroll
                    for (int p = 1; p < R; ++p) v[z][p] = cmul(v[z][p], w[p]);
                }
                dft<R, true>(v[z]);
            }
#pragma unroll
            for (int q = 0; q < R; ++q) if (!(HALF && INV && q >= R / 2)) Zb[z * ZS<LOGM>() + POFF(q << LOGSUB)] = v[z][q];
        }
    }
    __syncthreads();
}
template <int LOGM> struct Cfg;
template <> struct Cfg<13> { static constexpr int L1 = 3, L2 = 3, L3 = 3, L4 = 4; };
template <> struct Cfg<14> { static constexpr int L1 = 3, L2 = 3, L3 = 4, L4 = 4; };
template <int LOGM, int NZ, bool PADDED = false> __device__ __forceinline__ void fft_fwd(LAS f32x2* Z, int tid) {
    using C = Cfg<LOGM>;
    fft_stage<LOGM, LOGM, C::L1, false, NZ, PADDED>(Z, tid);
    fft_stage<LOGM, LOGM - C::L1, C::L2, false, NZ>(Z, tid);
    fft_stage<LOGM, LOGM - C::L1 - C::L2, C::L3, false, NZ>(Z, tid);
    fft_stage<LOGM, C::L4, C::L4, false, NZ>(Z, tid);
}
template <int LOGM, int NZ, bool PADDED = false> __device__ __forceinline__ void fft_inv(LAS f32x2* Z, int tid) {
    using C = Cfg<LOGM>;
    fft_stage<LOGM, C::L4, C::L4, true, NZ>(Z, tid);
    fft_stage<LOGM, LOGM - C::L1 - C::L2, C::L3, true, NZ>(Z, tid);
    fft_stage<LOGM, LOGM - C::L1, C::L2, true, NZ>(Z, tid);
    fft_stage<LOGM, LOGM, C::L1, true, NZ, PADDED>(Z, tid);
}
template <int LOGM> __host__ __device__ constexpr int drev(int k) {
    using C = Cfg<LOGM>;
    const int k1 = k & ((1 << C::L1) - 1), k2 = (k >> C::L1) & ((1 << C::L2) - 1), k3 = (k >> (C::L1 + C::L2)) & ((1 << C::L3) - 1), k4 = k >> (C::L1 + C::L2 + C::L3);
    return (k1 << (C::L2 + C::L3 + C::L4)) | (k2 << (C::L3 + C::L4)) | (k3 << C::L4) | k4;
}

template <int LOGM, int NZ> __device__ __forceinline__ void kernel_fft_unit(const Frame& F, float* row0, size_t rstride) {
    constexpr int M = 1 << LOGM, NC = M / 2 / NTHREADS; LAS f32x2* Z = (LAS f32x2*)F.lds; int tid = threadIdx.x; asm volatile("" : "+v"(tid));
    __syncthreads();
#pragma unroll
    for (int z = 0; z < NZ; ++z) { const float* row = row0 + z * rstride; unsigned t0 = (unsigned)tid; asm volatile("" : "+v"(t0)); f32x2 lo[NC]; float re[NC], im[NC];
#pragma unroll
      for (int c = 0; c < NC; ++c) { const unsigned n = t0 + NTHREADS * c; lo[c] = ((const f32x2*)row)[n];
          const unsigned n2 = n + M / 2;
          re[c] = (n2 == (unsigned)(M / 2)) ? 0.f : row[M + (2 * M - 2 * n2)]; im[c] = row[M + (2 * M - 2 * n2 - 1)]; }
#pragma unroll
      for (int c = 0; c < NC; ++c) { LAS f32x2* Zi = Z + PADI(t0);
          Zi[z * ZS<LOGM>() + POFF(NTHREADS * c)] = lo[c]; Zi[z * ZS<LOGM>() + POFF(NTHREADS * c + M / 2)] = (f32x2){re[c], im[c]}; } }
    __syncthreads();
    fft_fwd<LOGM, NZ>(Z, tid);
    { unsigned tk = (unsigned)tid; asm volatile("" : "+v"(tk));
      constexpr int CS = 4 / NZ, TOP = M / 512 - 1;
      const int pmAi = PADI(drev<LOGM>(512 - (int)tk));
      const LAS f32x2* Zk = Z + PADI(drev<LOGM>((int)tk));
      const LAS f32x2* ZmO = Z + pmAi;
      const LAS f32x2* ZmE = Z + ((LOGM == 14 && tk == 0u) ? pmAi - 271 : pmAi);
      const LAS f32x2* Zm0 = Z + ((tk == 0u) ? 0 : pmAi + POFF(drev<LOGM>(512 * TOP)));
      const float a0 = (float)tk * (1.0f / (float)(2 * M));
#pragma unroll
      for (int c0 = 0; c0 < NC; c0 += CS) {
          f32x2 A[4], B[4], V[4], E2[4], D2[4], P[4];
#pragma unroll
          for (int cc = 0; cc < CS; ++cc) { const int c = c0 + cc; const f32x2 v = twid_sc(a0 + (float)c * (512.0f / (float)(2 * M)));
              const LAS f32x2* Zm = (c == 0) ? Zm0 : (((c & 1) || LOGM == 13) ? ZmO : ZmE); const int dm = (c == 0) ? 0 : POFF(drev<LOGM>(512 * (TOP - c)));
#pragma unroll
              for (int z = 0; z < NZ; ++z) { const int sl = cc * NZ + z; V[sl] = v; A[sl] = Zk[z * ZS<LOGM>() + POFF(drev<LOGM>(512 * c))]; B[sl] = Zm[z * ZS<LOGM>() + dm]; } }
#pragma unroll
          for (int sl = 0; sl < 4; ++sl) E2[sl] = pk_add_pm(A[sl], B[sl]);
#pragma unroll
          for (int sl = 0; sl < 4; ++sl) D2[sl] = pk_add_mp(A[sl], B[sl]);
#pragma unroll
          for (int sl = 0; sl < 4; ++sl) P[sl] = cmul(V[sl], D2[sl]);
#pragma unroll
          for (int sl = 0; sl < 4; ++sl) A[sl] = E2[sl] - P[sl];
#pragma unroll
          for (int sl = 0; sl < 4; ++sl) B[sl] = pk_addc(E2[sl], P[sl]);
#pragma unroll
          for (int cc = 0; cc < CS; ++cc) { const unsigned k = tk + NTHREADS * (unsigned)(c0 + cc);
#pragma unroll
              for (int z = 0; z < NZ; ++z) { float* row = row0 + z * rstride; const int sl = cc * NZ + z;
                  *(f32x2*)(row + 2u * k) = A[sl]; *(f32x2*)(row + 2u * ((unsigned)M - k)) = B[sl]; } }
      }
      if (tid == 0) {
          const f32x2 v = twid_sc(0.25f);
#pragma unroll
          for (int z = 0; z < NZ; ++z) { float* row = row0 + z * rstride; const f32x2 a = Z[z * ZS<LOGM>() + PADI(drev<LOGM>(M / 2))];
              const f32x2 e2 = pk_add_pm(a, a), d2 = pk_add_mp(a, a), pp = cmul(v, d2);
              *(f32x2*)(row + M) = pk_addc(e2, pp); }
      }
    }
}

template <int LOGM, int NZ> __device__ __forceinline__ void conv_unit(const Frame& F, const bf16_t* vrow, const bf16_t* g0row, const bf16_t* g1row, size_t sstride, const float* k0row, const float* k1row,
                                                                      float skip0, float skip1, bf16_t* orow, size_t ostride) {
    constexpr int M = 1 << LOGM, NC = M / 2 / NTHREADS; LAS f32x2* Z = (LAS f32x2*)F.lds; int tid = threadIdx.x; asm volatile("" : "+v"(tid));
    float zz[NZ][2 * NC];
    __syncthreads();
#pragma unroll
    for (int z = 0; z < NZ; ++z) { unsigned t0 = (unsigned)tid; asm volatile("" : "+v"(t0)); const unsigned* vp = (const unsigned*)(vrow + z * sstride);
#pragma unroll
      for (int c = 0; c < NC; ++c) { const unsigned n = t0 + NTHREADS * c; const unsigned w = vp[n]; zz[z][2 * c] = bf_lo(w); zz[z][2 * c + 1] = bf_hi(w);
          (Z + PADI(t0))[z * ZS<LOGM>() + POFF(NTHREADS * c)] = (f32x2){zz[z][2 * c], zz[z][2 * c + 1]}; } }
    __syncthreads();
#pragma unroll
    for (int o = 0; o < 2; ++o) {
        const float* kf = o ? k1row : k0row; const bf16_t* grow = o ? g1row : g0row; const float skip = o ? skip1 : skip0;
        f32x2 Kk[NC], Km[NC]; const f32x2 Kh = ((const f32x2*)kf)[M / 2];
        { unsigned tk = (unsigned)tid; asm volatile("" : "+v"(tk));
#pragma unroll
          for (int c = 0; c < NC; ++c) { const unsigned k = tk + NTHREADS * c; Kk[c] = ((const f32x2*)kf)[k]; Km[c] = ((const f32x2*)kf)[(unsigned)M - k]; } }
        unsigned gwv[NZ][NC];
#pragma unroll
        for (int z = 0; z < NZ; ++z) { unsigned t1 = (unsigned)tid; asm volatile("" : "+v"(t1)); const unsigned* gp = (const unsigned*)(grow + z * sstride);
#pragma unroll
          for (int c = 0; c < NC; ++c) gwv[z][c] = gp[t1 + NTHREADS * c]; }
        fft_fwd<LOGM, NZ, true>(Z, tid);
        { unsigned tk = (unsigned)tid; asm volatile("" : "+v"(tk));
          constexpr int CS = 4 / NZ, TOP = M / 512 - 1;
          const int pmAi = PADI(drev<LOGM>(512 - (int)tk));
          LAS f32x2* Zk = Z + PADI(drev<LOGM>((int)tk));
          LAS f32x2* ZmO = Z + pmAi;
          LAS f32x2* ZmE = Z + ((LOGM == 14 && tk == 0u) ? pmAi - 271 : pmAi);
          LAS f32x2* Zm0 = Z + ((tk == 0u) ? 0 : pmAi + POFF(drev<LOGM>(512 * TOP)));
          const float a0 = (float)tk * (1.0f / (float)(2 * M));
#pragma unroll
          for (int c0 = 0; c0 < NC; c0 += CS) {
              f32x2 A[4], B[4], V[4], KK[4], KM[4], E[4], Dm[4], P[4], X1[4], X2[4], Yk[4], Ym[4];
#pragma unroll
              for (int cc = 0; cc < CS; ++cc) { const int c = c0 + cc; const f32x2 v = twid_sc(a0 + (float)c * (512.0f / (float)(2 * M)));
                  LAS f32x2* Zm = (c == 0) ? Zm0 : (((c & 1) || LOGM == 13) ? ZmO : ZmE); const int dm = (c == 0) ? 0 : POFF(drev<LOGM>(512 * (TOP - c)));
#pragma unroll
                  for (int z = 0; z < NZ; ++z) { const int sl = cc * NZ + z; V[sl] = v; KK[sl] = Kk[c]; KM[sl] = Km[c]; A[sl] = Zk[z * ZS<LOGM>() + POFF(drev<LOGM>(512 * c))]; B[sl] = Zm[z * ZS<LOGM>() + dm]; } }
#pragma unroll
              for (int sl = 0; sl < 4; ++sl) E[sl] = pk_add_pm(A[sl], B[sl]);
#pragma unroll
              for (int sl = 0; sl < 4; ++sl) Dm[sl] = pk_add_mp(A[sl], B[sl]);
#pragma unroll
              for (int sl = 0; sl < 4; ++sl) P[sl] = cmul(V[sl], Dm[sl]);
#pragma unroll
              for (int sl = 0; sl < 4; ++sl) X1[sl] = E[sl] - P[sl];
#pragma unroll
              for (int sl = 0; sl < 4; ++sl) X2[sl] = E[sl] + P[sl];
#pragma unroll
              for (int sl = 0; sl < 4; ++sl) Yk[sl] = cmul(X1[sl], KK[sl]);
#pragma unroll
              for (int sl = 0; sl < 4; ++sl) Ym[sl] = cmulc(X2[sl], KM[sl]);
#pragma unroll
              for (int sl = 0; sl < 4; ++sl) E[sl] = Yk[sl] + Ym[sl];
#pragma unroll
              for (int sl = 0; sl < 4; ++sl) Dm[sl] = Yk[sl] - Ym[sl];
#pragma unroll
              for (int sl = 0; sl < 4; ++sl) P[sl] = cmulc(Dm[sl], V[sl]);
#pragma unroll
              for (int sl = 0; sl < 4; ++sl) A[sl] = E[sl] - P[sl];
#pragma unroll
              for (int sl = 0; sl < 4; ++sl) B[sl] = pk_addc(E[sl], P[sl]);
#pragma unroll
              for (int cc = 0; cc < CS; ++cc) { const int c = c0 + cc;
                  LAS f32x2* Zm = (c == 0) ? Zm0 : (((c & 1) || LOGM == 13) ? ZmO : ZmE); const int dm = (c == 0) ? 0 : POFF(drev<LOGM>(512 * (TOP - c)));
#pragma unroll
                  for (int z = 0; z < NZ; ++z) { const int sl = cc * NZ + z; Zm[z * ZS<LOGM>() + dm] = B[sl]; Zk[z * ZS<LOGM>() + POFF(drev<LOGM>(512 * c))] = A[sl]; } }
          }
          if (tid == 0) {
              const f32x2 v = twid_sc(0.25f);
#pragma unroll
              for (int z = 0; z < NZ; ++z) { LAS f32x2* zp = Z + z * ZS<LOGM>() + PADI(drev<LOGM>(M / 2)); const f32x2 a = *zp;
                  const f32x2 e = pk_add_pm(a, a), dm = pk_add_mp(a, a), pp = cmul(v, dm), yk = cmul(e - pp, Kh), ym = cmulc(e + pp, Kh);
                  const f32x2 ye = yk + ym, qq = cmulc(yk - ym, v);
                  *zp = ye - qq; }
          } }
        __syncthreads();
        fft_inv<LOGM, NZ, true>(Z, tid);
        constexpr float SC = 0.125f / (float)M;
#pragma unroll
        for (int z = 0; z < NZ; ++z) { unsigned t1 = (unsigned)tid; asm volatile("" : "+v"(t1)); unsigned* op = (unsigned*)(orow + z * ostride);
#pragma unroll
          for (int c = 0; c < NC; ++c) { const unsigned n = t1 + NTHREADS * c; LAS f32x2* Zo = Z + PADI(t1) + z * ZS<LOGM>() + POFF(NTHREADS * c); const f32x2 y = *Zo; const unsigned gw = gwv[z][c];
            zz[z][2 * c] = bf_lo(gw) * (y.x * SC + zz[z][2 * c] * skip); zz[z][2 * c + 1] = bf_hi(gw) * (y.y * SC + zz[z][2 * c + 1] * skip);
            if (o == 0) *Zo = (f32x2){zz[z][2 * c], zz[z][2 * c + 1]};
            else op[n] = pk2(zz[z][2 * c], zz[z][2 * c + 1]); } }
        __syncthreads();
    }
}
}

__device__ __forceinline__ void hy_fix_phase(const Frame& F, const Args& a) {
    bf16_t* UT = (bf16_t*)(a.ws + WS_UT); const bf16_t* EU = (const bf16_t*)(a.ws + WS_EU); const float* cw = a.in[I_HCW];
    for (int it = F.gw; it < 383 * 96; it += F.NGW) {
        const int hb = it / 96, col = (it % 96) * 64 + F.lane, rl = hb * 128 + 127, s = seq_of_row(rl);
        if (seq_of_row(rl + 1) != s) continue;
        const int L = seq_len(s), tl = rl - seq_start(s);
        const float ul = bf1(EU[((size_t)hb * 2 + 1) * (3 * D) + col]), uf = bf1(EU[((size_t)(hb + 1) * 2 + 0) * (3 * D) + col]);
        bf16_t* p = UT + (size_t)seq_start(s) * (3 * D) + (size_t)col * L + tl;
        p[0] = f2bf(bf1(p[0]) + cw[2 * 3 * D + col] * uf);
        p[1] = f2bf(bf1(p[1]) + cw[col] * ul);
    }
}
__device__ __forceinline__ void hy_transpose_back_item(const Frame& F, const Args& a, int q, int item, LAS float* tile) {
    const bf16_t* ZT = (const bf16_t*)(a.ws + WS_ZT); bf16_t* ZZ = (bf16_t*)(a.ws + WS_H);
    const int lane = F.lane, cb8 = item & 7, rb = item >> 3, t0 = rb * 64, s = seq_of_row(t0), tl0 = t0 - seq_start(s), L = seq_len(s);
    const bf16_t* src = ZT + (size_t)seq_start(s) * 512 + (size_t)(cb8 * 64) * L + tl0;
    LDS_WAIT();
#pragma unroll
    for (int it = 0; it < 8; ++it) { const int ch = it * 8 + (lane >> 3), tk = (lane & 7) * 8; float v[8]; unpack8(*(const u32x4*)(src + (size_t)ch * L + tk), v);
#pragma unroll
        for (int e = 0; e < 8; ++e) tile[ch * 65 + tk + e] = v[e]; }
    LDS_WAIT();
#pragma unroll
    for (int it = 0; it < 8; ++it) { const int tk = it * 8 + (lane >> 3), c0 = (lane & 7) * 8; float v[8];
#pragma unroll
        for (int e = 0; e < 8; ++e) v[e] = tile[(c0 + e) * 65 + tk];
        u32x4 w; w.x = pk2(v[0], v[1]); w.y = pk2(v[2], v[3]); w.z = pk2(v[4], v[5]); w.w = pk2(v[6], v[7]);
        *(u32x4*)(ZZ + (size_t)(t0 + tk) * D + q * 512 + cb8 * 64 + c0) = w; }
}
__device__ __forceinline__ void hy_filter_item(const Frame& F, const Args& a, int q, int item) {
    const bf16_t* W3T = (const bf16_t*)(a.ws + WS_W3T); const bf16_t* A2 = (const bf16_t*)(a.ws + WS_A2); float* FK = (float*)(a.ws + WS_FK);
    const int lane = F.lane, r32 = lane & 31, hi = lane >> 5, cb = item & 63, tg = item >> 6, od = cb >> 4, cblk = cb & 15, o = od >> 1, dir = od & 1;
    const int wcol0 = od * D + q * 512 + cblk * 32;
    bf16x8 afr[4];
#pragma unroll
    for (int s = 0; s < 4; ++s) afr[s] = *(const bf16x8*)(W3T + (size_t)(wcol0 + r32) * 64 + 16 * s + 8 * hi);
    float delta[16];
#pragma unroll
    for (int r = 0; r < 16; ++r) { const int d = q * 512 + cblk * 32 + att::crow(r, hi); delta[r] = 3.0701134573253945f + (float)d * (12.280453829301578f / 2047.0f); }
    bf16x8 bfa[8][4];
#pragma unroll
    for (int i = 0; i < 8; ++i)
#pragma unroll
        for (int s = 0; s < 4; ++s) bfa[i][s] = *(const bf16x8*)(A2 + (size_t)((tg * 8 + i) * 32 + r32) * 64 + 16 * s + 8 * hi);
#pragma unroll
    for (int i = 0; i < 8; ++i) {
        const int tt0 = (tg * 8 + i) * 32, ls = tt0 >= LP, n = tt0 - (ls ? LP : 0) + r32, L = ls ? LS : LP;
        f32x16 acc = {};
#pragma unroll
        for (int s = 0; s < 4; ++s) acc = __builtin_amdgcn_mfma_f32_32x32x16_bf16(afr[s], bfa[i][s], acc, 0, 0, 0);
        const float tn = (float)n / (float)(L - 1);
        float* base = FK + (ls ? FK_SAMPLE_OFF : (size_t)0) + (size_t)dir * L + n;
        const size_t pitch = ls ? FK_PITCH_S : FK_PITCH_P;
#pragma unroll
        for (int r = 0; r < 16; ++r) { const int c = cblk * 32 + att::crow(r, hi);
            base[(size_t)(o * 512 + c) * pitch] = acc[r] * (__expf(-tn * delta[r]) + 0.05f); }
    }
}
__device__ __forceinline__ void hy_phase_a(const Frame& F, const Args& a, int q, bool do_back = true) {
    LAS float* tile = (LAS float*)(F.lds + F.wave * 17408);
    if (q < 4) for (int it = F.gw; it < 64 * 96; it += F.NGW) hy_filter_item(F, a, q, it);
    if (q > 0 && do_back) for (int it = F.gw; it < 768 * 8; it += F.NGW) hy_transpose_back_item(F, a, q - 1, it, tile);
}
__device__ __forceinline__ void hy_phase_c(const Frame& F, const Args& a, int q) {
    const bf16_t* UT = (const bf16_t*)(a.ws + WS_UT); float* FK = (float*)(a.ws + WS_FK); bf16_t* ZT = (bf16_t*)(a.ws + WS_ZT);
    const float* skip = a.in[I_HSKIP];
    for (int c = F.vcu; c < 512; c += F.G) {
        hy::kernel_fft_unit<14, 1>(F, FK + FK_SAMPLE_OFF + (size_t)c * FK_PITCH_S, 0);
        hy::kernel_fft_unit<14, 1>(F, FK + FK_SAMPLE_OFF + (size_t)(512 + c) * FK_PITCH_S, 0);
        hy::kernel_fft_unit<13, 2>(F, FK + (size_t)c * FK_PITCH_P, (size_t)512 * FK_PITCH_P);
        VM_WAIT(); __syncthreads();
        if (F.wave == 0) { __builtin_amdgcn_fence(__ATOMIC_ACQUIRE, "agent"); VM_WAIT(); }
        __syncthreads();
        const int d = q * 512 + c; const float s0 = skip[d], s1 = skip[D + d];
        { const bf16_t* ub = UT + (size_t)seq_start(4) * (3 * D);
          hy::conv_unit<14, 1>(F, ub + (size_t)d * LS, ub + (size_t)(D + d) * LS, ub + (size_t)(2 * D + d) * LS, 0,
                               FK + FK_SAMPLE_OFF + (size_t)c * FK_PITCH_S, FK + FK_SAMPLE_OFF + (size_t)(512 + c) * FK_PITCH_S, s0, s1, ZT + (size_t)seq_start(4) * 512 + (size_t)c * LS, 0); }
#pragma unroll 1
        for (int s = 0; s < 4; s += 2) { const bf16_t* ub = UT + (size_t)seq_start(s) * (3 * D);
          hy::conv_unit<13, 2>(F, ub + (size_t)d * LP, ub + (size_t)(D + d) * LP, ub + (size_t)(2 * D + d) * LP, (size_t)LP * (3 * D),
                               FK + (size_t)c * FK_PITCH_P, FK + (size_t)(512 + c) * FK_PITCH_P, s0, s1, ZT + (size_t)seq_start(s) * 512 + (size_t)c * LP, (size_t)LP * 512); }
    }
    __syncthreads();
}
#ifndef MK_MULTI_LAUNCH
#define MK_MULTI_LAUNCH 0
#endif
#ifndef PROBE
#define PROBE 0
#endif
#ifndef EN_MASK
#define EN_MASK 0xff
#endif
#define EN_GEMM ((EN_MASK) & 1)
#define EN_ATT  ((EN_MASK) & 2)
#define EN_HYA  ((EN_MASK) & 4)
#define EN_HYB  ((EN_MASK) & 8)
#define EN_HYC  ((EN_MASK) & 16)
#define EN_MISC ((EN_MASK) & 32)
constexpr int NPH = 41;
constexpr int CW_BAR = 4096;

__device__ __forceinline__ const float* modrow(const Args& a, int layer) { return (const float*)(a.ws + WS_MOD) + (size_t)layer * NB * 6 * D; }

__global__ void __launch_bounds__(NTHREADS, 2) fwd_kernel(Args a) {
    extern __shared__ __attribute__((aligned(16))) unsigned char lds_raw[];
    Frame F0;
    Frame& F = F0;
    F.lds = (LAS unsigned char*)lds_raw;
    F.tid = threadIdx.x; F.lane = F.tid & 63; F.wave = __builtin_amdgcn_readfirstlane(F.tid >> 6);
    F.G = gridDim.x; { const int bx = blockIdx.x; F.vcu = (F.G % 8 == 0) ? (bx % 8) * (F.G / 8) + bx / 8 : bx; }
    F.gw = F.vcu * NWAVES + F.wave; F.NGW = F.G * NWAVES;
    volatile LAS unsigned* MISC = (volatile LAS unsigned*)(F.lds + MISC_OFF);
    if (F.tid < 64) MISC[F.tid] = 0u;
    __syncthreads();
    unsigned* ctl = (unsigned*)(a.ws + WS_CTL);
    const int lo = a.ph_lo, hi = a.ph_hi;
    XcdBarrier bar; bar.bar = ctl + CW_BAR + a.li * XCD_BAR_WORDS; bar.x = 0; bar.st = MISC + 8;
    if (hi - lo > 1) bar = xcd_barrier_post(ctl + CW_BAR + a.li * XCD_BAR_WORDS, MISC + 8);
    int ph = 0;
#define PH_BEGIN if (ph >= lo && ph < hi) { Frame F = F0; { int t_ = threadIdx.x; asm volatile("" : "+v"(t_)); F.tid = t_; F.lane = t_ & 63; }
#define PH_END   if (ph + 1 < hi) { xcd_barrier(bar); if (PROBE == 9) xcd_barrier(bar); } } ++ph;

    bf16_t* const H = (bf16_t*)(a.ws + WS_H); bf16_t* const M1 = (bf16_t*)(a.ws + WS_M1);
    float* const out = a.out;
    const int bx = (int)blockIdx.x;

    bf16_t* const XB = (bf16_t*)(a.ws + WS_XB);
#define NORM_N1(layer) do { NormP p{a.in[I_XP], a.in[I_XS], nullptr, nullptr, nullptr, nullptr, nullptr, 0, nullptr, modrow(a, layer), D, 0, a.in[I_NMPRE] + (layer) * D, H}; if (EN_MISC) norm_phase(F, p); } while (0)
#define NORM_N2(layer, MPTR) do { NormP p{a.in[I_XP], a.in[I_XS], (layer) == 0 ? nullptr : XB, nullptr, XB, MPTR, modrow(a, layer), 2 * D, a.in[I_NMPOST] + (layer) * D, modrow(a, layer), 4 * D, 3 * D, a.in[I_NFPRE] + (layer) * D, H}; \
        if (EN_MISC) norm_phase(F, p); if (PROBE == 4) { NormP p2 = p; p2.xbout = (bf16_t*)(a.ws + 512 * MiB); p2.H = (bf16_t*)(a.ws + 704 * MiB); norm_phase(F, p2); } } while (0)
#define NORM_N3(layer) do { NormP p{nullptr, nullptr, XB, (layer) + 1 < NLAYER ? nullptr : out, (layer) + 1 < NLAYER ? XB : nullptr, M1, modrow(a, layer), 5 * D, a.in[I_NFPOST] + (layer) * D, modrow(a, (layer) + 1 < NLAYER ? (layer) + 1 : (layer)), D, 0, \
        a.in[I_NMPRE] + ((layer) + 1 < NLAYER ? (layer) + 1 : (layer)) * D, (layer) + 1 < NLAYER ? H : nullptr}; if (EN_MISC) norm_phase(F, p); \
        if (PROBE == 4 && (layer) + 1 < NLAYER) { NormP p2 = p; p2.xbout = (bf16_t*)(a.ws + 512 * MiB); p2.H = (bf16_t*)(a.ws + 704 * MiB); norm_phase(F, p2); } } while (0)
#define GEMM_PHASE(Aptr, Bptr, LDA, LDB, KK, AGRP, MM, NN, Optr, LDC, BIAS, SCALE) do { pg8::Gemm g{Aptr, Bptr, LDA, LDB, KK, AGRP}; pg8::StaticOrder S; S.init(MM, NN, F.G, bx); \
        pg8::EpiBf16 E{Optr, LDC, BIAS, SCALE}; for (int rep8 = 0; rep8 < ((PROBE == 8 && (KK) != DFF) ? 2 : 1); ++rep8) { if (EN_GEMM) pg8::gemm_phase<false, pg8::EpiBf16, pg8::StaticOrder>(F.lds, g, S, E); } } while (0)
#define FFN_LAYER(layer) do { \
        PH_BEGIN for (int rep = 0; rep < (PROBE == 1 ? 2 : 1); ++rep) { pg8::Gemm g{H, (const bf16_t*)(a.ws + WS_WUP), D, D, D, 0}; pg8::StaticOrder S; S.init(T, 2 * DFF, F.G, bx); \
            pg8::EpiGlu E{(bf16_t*)(a.ws + WS_U), (bf16_t*)(a.ws + WS_EA), (bf16_t*)(a.ws + WS_EB), a.in[I_FCW] + (size_t)(layer) * 3 * DFF, a.in[I_FCB] + (size_t)(layer) * DFF, DFF}; \
            if (EN_GEMM) pg8::gemm_phase<true, pg8::EpiGlu, pg8::StaticOrder>(F.lds, g, S, E); } PH_END \
        PH_BEGIN if (EN_MISC) ffn_fix_phase(F, (const bf16_t*)(a.ws + WS_EA), (const bf16_t*)(a.ws + WS_EB), (bf16_t*)(a.ws + WS_U), a.in[I_FCW] + (size_t)(layer) * 3 * DFF, a.in[I_FCB] + (size_t)(layer) * DFF); PH_END \
        PH_BEGIN for (int rep = 0; rep < (PROBE == 1 ? 2 : 1); ++rep) { GEMM_PHASE((const bf16_t*)(a.ws + WS_U), (const bf16_t*)(a.ws + WS_WDN), DFF, DFF, DFF, 0, T, D, M1, D, nullptr, nullptr); } PH_END \
        PH_BEGIN NORM_N3(layer); if ((layer) + 1 < NLAYER) { __syncthreads(); prep_ffn_weights(F, a, (layer) + 1); if (PROBE == 7) prep_ffn_weights(F, a, (layer) + 1); } PH_END \
    } while (0)
#define POOL_LAYER(layer, j) do { \
        PH_BEGIN for (int rep = 0; rep < ((PROBE == 4 || PROBE == 11) ? 2 : 1); ++rep) { if (EN_MISC) pool_phase(F, H, (bf16_t*)(a.ws + WS_P)); } PH_END \
        PH_BEGIN GEMM_PHASE((const bf16_t*)(a.ws + WS_P), (const bf16_t*)(a.ws + WS_POOLW) + (size_t)(j) * D * 512, D, 512, 512, 2, T, D, M1, D, nullptr, a.in[I_POOLS] + (j) * D); PH_END \
    } while (0)

    PH_BEGIN for (int rep = 0; rep < (PROBE == 7 ? 2 : 1); ++rep) { if (EN_MISC) prologue_phase(F, a); __syncthreads(); } PH_END

    PH_BEGIN NORM_N1(0); __syncthreads(); prep_ffn_weights(F, a, 0); if (PROBE == 7) prep_ffn_weights(F, a, 0); PH_END
    POOL_LAYER(0, 0);
    PH_BEGIN NORM_N2(0, M1); PH_END
    FFN_LAYER(0);

    PH_BEGIN { pg8::Gemm g{H, (const bf16_t*)(a.ws + WS_HYWIN), D, D, D, 0}; pg8::StaticOrder S; S.init(T, 3 * D, F.G, bx);
        pg8::EpiHyT E{(bf16_t*)(a.ws + WS_UT), (bf16_t*)(a.ws + WS_EU), a.in[I_HBIN], a.in[I_HCW], a.in[I_HCB], 3 * D};
        for (int rep8 = 0; rep8 < (PROBE == 8 ? 2 : 1); ++rep8) { if (EN_GEMM) pg8::gemm_phase<true, pg8::EpiHyT, pg8::StaticOrder>(F.lds, g, S, E); } } PH_END
    for (int q = 0; q < 4; ++q) {
        PH_BEGIN if (EN_HYA) { if (q == 0) hy_fix_phase(F, a); hy_phase_a(F, a, q); } PH_END
        PH_BEGIN if (EN_HYC) hy_phase_c(F, a, q); PH_END
    }
    PH_BEGIN if (EN_HYA) hy_phase_a(F, a, 4); PH_END
    PH_BEGIN GEMM_PHASE(H, (const bf16_t*)(a.ws + WS_HYWOUT), D, D, D, 0, T, D, (bf16_t*)(a.ws + WS_M1H), D, nullptr, nullptr); PH_END
    PH_BEGIN NORM_N2(1, (const bf16_t*)(a.ws + WS_M1H)); PH_END
    FFN_LAYER(1);

    PH_BEGIN GEMM_PHASE(H, (const bf16_t*)(a.ws + WS_ATQKV), D, D, D, 0, T, 3072, (bf16_t*)(a.ws + WS_QKV), 3072, nullptr, nullptr); PH_END
    PH_BEGIN if (EN_MISC) qk_norm_rope_phase(F, (bf16_t*)(a.ws + WS_QKV), a.in[I_AQG], a.in[I_AKG]); PH_END
    PH_BEGIN for (int rep = 0; rep < (PROBE == 2 ? 2 : 1); ++rep) { if (EN_ATT) attn_phase(F, (const bf16_t*)(a.ws + WS_QKV), (bf16_t*)(a.ws + WS_O)); } PH_END
    PH_BEGIN GEMM_PHASE((const bf16_t*)(a.ws + WS_O), (const bf16_t*)(a.ws + WS_ATWO), D, D, D, 0, T, D, M1, D, nullptr, nullptr); PH_END
    PH_BEGIN NORM_N2(2, M1); PH_END
    FFN_LAYER(2);

    POOL_LAYER(3, 1);
    PH_BEGIN NORM_N2(3, M1); PH_END
    FFN_LAYER(3);
}

__global__ void k_fail_fill(float* out, size_t n) { for (size_t i = (size_t)blockIdx.x * blockDim.x + threadIdx.x; i < n; i += (size_t)gridDim.x * blockDim.x) out[i] = __builtin_nanf(""); }

extern "C" void kernel_launch(void* const* d_in, const int* in_sizes, int n_in, void* d_out, int out_size, void* d_ws, size_t ws_size, hipStream_t stream) {
    static int grid = 0;
    if (grid == 0) {
        int dev = 0, cus = 0, per_cu = 0;
        if (n_in != 32 || out_size != T * D || ws_size < WS_END) {
            fprintf(stderr, "kernel_launch: shape/workspace mismatch: n_in %d out %d ws %zu (need %zu)\n", n_in, out_size, ws_size, (size_t)WS_END); grid = -1; }
        else if (hipGetDevice(&dev) != hipSuccess || hipDeviceGetAttribute(&cus, hipDeviceAttributeMultiprocessorCount, dev) != hipSuccess) grid = -1;
        else if (hipFuncSetAttribute((const void*)fwd_kernel, hipFuncAttributeMaxDynamicSharedMemorySize, LDS_BYTES) != hipSuccess) grid = -1;
        else {
            if (hipOccupancyMaxActiveBlocksPerMultiprocessor(&per_cu, (const void*)fwd_kernel, NTHREADS, LDS_BYTES) != hipSuccess || per_cu < 1)
                fprintf(stderr, "kernel_launch: occupancy query reports %d workgroups per CU\n", per_cu);
            (void)hipGetLastError();
            grid = cus;
        }
    }
    if (grid < 0) { hipLaunchKernelGGL(k_fail_fill, dim3(1024), dim3(256), 0, stream, (float*)d_out, (size_t)out_size); return; }
    (void)hipMemsetAsync((char*)d_ws + WS_CTL, 0, CTL_ZERO_BYTES, stream);
    Args a{};
    for (int i = 0; i < 32; ++i) a.in[i] = (const float*)d_in[i];
    a.out = (float*)d_out; a.ws = (unsigned char*)d_ws;
#if MK_MULTI_LAUNCH
    for (int k = 0; k < NPH; ++k) { a.ph_lo = k; a.ph_hi = k + 1; a.li = k; a.pad = 0;
        hipLaunchKernelGGL(fwd_kernel, dim3(grid), dim3(NTHREADS), LDS_BYTES, stream, a); }
#else
    a.ph_lo = 0; a.ph_hi = NPH; a.li = 0; a.pad = 0;
    hipLaunchKernelGGL(fwd_kernel, dim3(grid), dim3(NTHREADS), LDS_BYTES, stream, a);
#endif
    const hipError_t le = hipPeekAtLastError();
    if (le != hipSuccess) fprintf(stderr, "kernel_launch: launch failed: %s\n", hipGetErrorName(le));
}
```
